# Optimizing an MI355X kernel written in HIP

```python
import math
import jax, jax.numpy as jnp
from jax import lax
import numpy as np

D_MODEL = 1024
BATCH = 2
SEQ = 16384
DEPTH = 2

HEAD_DIM = 64
EPS = 1e-6
S5_WIDTH = 256
S5_GROUP = 16
S5_GROUPS = S5_WIDTH // S5_GROUP
S5_STATE = 64
CONV_WIDTH = D_MODEL - S5_WIDTH
CONV_HEADS = CONV_WIDTH // HEAD_DIM
CONV_K = 3
IN_EVEN = S5_WIDTH + 3 * CONV_WIDTH
MOBA_HEADS = 4
NSA_HEADS = 12
NSA_KV_HEADS = 2
NSA_GROUP = NSA_HEADS // NSA_KV_HEADS
MOBA_W = MOBA_HEADS * HEAD_DIM
NSA_W = NSA_HEADS * HEAD_DIM
KV_W = NSA_KV_HEADS * HEAD_DIM
IN_ODD = 3 * MOBA_W + NSA_W + 6 * KV_W + 3 * NSA_HEADS
MOBA_BLOCK = 256
MOBA_TOPK = 3
CMP_BLOCK = 32
CMP_STRIDE = 16
CMP_HIDDEN = 256
SEL_BLOCK = 64
SEL_TOPK = 8
WINDOW = 512
Q_BLOCK = 64
FORCED_SCORE = 1e4
N_GROUPS = 4
EXPERTS_PER_GROUP = 4
N_EXPERTS = N_GROUPS * EXPERTS_PER_GROUP
EXPERT_TOPK = 2
EXPERT_FF = 256

kernel_name = 'hybrid_s5_conv_moba_nsa_hmoe'


def rms_norm(x, g):
    xf = x.astype(jnp.float32)
    y = xf * lax.rsqrt(jnp.mean(xf * xf, axis=-1, keepdims=True) + EPS)
    return (y * g.astype(jnp.float32)).astype(x.dtype)


def masked_softmax(s, mask):
    s = jnp.where(mask, s.astype(jnp.float32), -jnp.inf)
    m = jnp.max(s, axis=-1, keepdims=True)
    m = jnp.where(jnp.isfinite(m), m, 0.0)
    p = jnp.exp(s - m)
    return p / jnp.maximum(jnp.sum(p, axis=-1, keepdims=True), 1e-30)


def gather_blocks(blocks, idx):
    return jax.vmap(jax.vmap(lambda b, i: b[i]))(blocks, idx)


def s5_mixer(u, lam_re, lam_im, log_dt, b_re, b_im, c_re, c_im, d, w_glu):
    B, L, _ = u.shape
    uf = u.astype(jnp.float32).reshape(B, L, S5_GROUPS, S5_GROUP)
    lr = lam_re.astype(jnp.float32)
    li = lam_im.astype(jnp.float32)
    dt = jnp.exp(log_dt.astype(jnp.float32))[:, None]
    mag = jnp.exp(lr * dt)
    a_re = mag * jnp.cos(li * dt)
    a_im = mag * jnp.sin(li * dt)
    den = lr * lr + li * li
    f_re = ((a_re - 1.0) * lr + a_im * li) / den
    f_im = (a_im * lr - (a_re - 1.0) * li) / den
    br = b_re.astype(jnp.float32)
    bi = b_im.astype(jnp.float32)
    bb_re = f_re[..., None] * br - f_im[..., None] * bi
    bb_im = f_re[..., None] * bi + f_im[..., None] * br
    bu_re = jnp.einsum('blgh,gph->blgp', uf, bb_re)
    bu_im = jnp.einsum('blgh,gph->blgp', uf, bb_im)
    ar = jnp.broadcast_to(a_re, bu_re.shape)
    ai = jnp.broadcast_to(a_im, bu_re.shape)

    def combine(e1, e2):
        a1r, a1i, b1r, b1i = e1
        a2r, a2i, b2r, b2i = e2
        return (a2r * a1r - a2i * a1i, a2r * a1i + a2i * a1r,
                a2r * b1r - a2i * b1i + b2r, a2r * b1i + a2i * b1r + b2i)

    _, _, xr, xi = lax.associative_scan(combine, (ar, ai, bu_re, bu_im), axis=1)
    y = (jnp.einsum('blgp,ghp->blgh', xr, c_re.astype(jnp.float32))
         - jnp.einsum('blgp,ghp->blgh', xi, c_im.astype(jnp.float32))
         + d.astype(jnp.float32).reshape(S5_GROUPS, S5_GROUP) * uf)
    y = jax.nn.gelu(y.reshape(B, L, S5_WIDTH))
    y = y * jax.nn.sigmoid(y @ w_glu.astype(jnp.float32))
    return y.astype(u.dtype)


def short_conv_mixer(xc, gb, gc, conv_w, conv_b):
    z = gc * xc
    w = conv_w.astype(z.dtype)[:, None, :]
    y = lax.conv_general_dilated(z, w, window_strides=(1,), padding=[(CONV_K - 1, 0)],
                                 dimension_numbers=('NWC', 'WIO', 'NWC'),
                                 feature_group_count=CONV_WIDTH) + conv_b
    return gb * y


def even_mixer(h, w_in, w_out, lam_re, lam_im, log_dt, b_re, b_im, c_re, c_im, d, w_glu, conv_w, conv_b):
    proj = h @ w_in
    u, xc, gb, gc = jnp.split(proj, [S5_WIDTH, S5_WIDTH + CONV_WIDTH, S5_WIDTH + 2 * CONV_WIDTH], axis=-1)
    y_a = s5_mixer(u, lam_re, lam_im, log_dt, b_re, b_im, c_re, c_im, d, w_glu)
    y_b = short_conv_mixer(xc, gb, gc, conv_w, conv_b)
    return jnp.concatenate([y_a, y_b.astype(y_a.dtype)], axis=-1) @ w_out


def compress_blocks(k, pe, w1, w2):
    B, L, H, hd = k.shape
    c = k.reshape(B, L // CMP_STRIDE, CMP_STRIDE, H, hd)
    blocks = jnp.concatenate([c[:, :-1], c[:, 1:]], axis=2) + pe[:, None, :]
    flat = blocks.transpose(0, 1, 3, 2, 4).reshape(B, -1, H, CMP_BLOCK * hd)
    return jax.nn.gelu(flat @ w1) @ w2


def odd_mixer(h, w_in, w_out, moba_q_norm, moba_k_norm, nsa_q_norm, nsa_kcmp_norm, nsa_ksel_norm,
              nsa_kwin_norm, cmp_pe_k, cmp_w1_k, cmp_w2_k, cmp_pe_v, cmp_w1_v, cmp_w2_v):
    B, L, _ = h.shape
    hd = HEAD_DIM
    Lp = -(-L // MOBA_BLOCK) * MOBA_BLOCK
    hp = jnp.pad(h, ((0, 0), (0, Lp - L), (0, 0)))
    proj = hp @ w_in
    sizes = [MOBA_W] * 3 + [NSA_W] + [KV_W] * 6 + [3 * NSA_HEADS]
    qm, km, vm, qd, kc, vc, ks, vs, kw, vw, gl = jnp.split(proj, np.cumsum(sizes)[:-1].tolist(), axis=-1)
    qm = rms_norm(qm.reshape(B, Lp, MOBA_HEADS, hd), moba_q_norm)
    km = rms_norm(km.reshape(B, Lp, MOBA_HEADS, hd), moba_k_norm)
    vm = vm.reshape(B, Lp, MOBA_HEADS, hd)
    qd = rms_norm(qd.reshape(B, Lp, NSA_KV_HEADS, NSA_GROUP, hd), nsa_q_norm)
    kv_shape = (B, Lp, NSA_KV_HEADS, hd)
    k_cmp = rms_norm(compress_blocks(kc.reshape(kv_shape), cmp_pe_k, cmp_w1_k, cmp_w2_k), nsa_kcmp_norm)
    v_cmp = compress_blocks(vc.reshape(kv_shape), cmp_pe_v, cmp_w1_v, cmp_w2_v)
    n_cmp = k_cmp.shape[1]
    n_sel = Lp // SEL_BLOCK
    k_sel = rms_norm(ks.reshape(kv_shape), nsa_ksel_norm).reshape(
        B, n_sel, SEL_BLOCK, NSA_KV_HEADS, hd).transpose(0, 3, 1, 2, 4)
    v_sel = vs.reshape(B, n_sel, SEL_BLOCK, NSA_KV_HEADS, hd).transpose(0, 3, 1, 2, 4)
    pad_w = ((0, 0), (WINDOW, 0), (0, 0), (0, 0))
    k_win = jnp.pad(rms_norm(kw.reshape(kv_shape), nsa_kwin_norm), pad_w)
    v_win = jnp.pad(vw.reshape(kv_shape), pad_w)
    gates = jax.nn.sigmoid(gl.astype(jnp.float32)).reshape(B, Lp, 3, NSA_KV_HEADS, NSA_GROUP)
    n_mb = Lp // MOBA_BLOCK
    km_blocks = km.reshape(B, n_mb, MOBA_BLOCK, MOBA_HEADS, hd).transpose(0, 3, 1, 2, 4)
    vm_blocks = vm.reshape(B, n_mb, MOBA_BLOCK, MOBA_HEADS, hd).transpose(0, 3, 1, 2, 4)
    km_mean = jnp.mean(km_blocks.astype(jnp.float32), axis=3)
    k_moba = min(MOBA_TOPK, n_mb)
    k_nsa = min(SEL_TOPK, n_sel)
    scale = hd ** -0.5
    cmp_end = jnp.arange(n_cmp) * CMP_STRIDE + CMP_BLOCK - 1
    blk_ids = jnp.arange(n_sel)
    mb_ids = jnp.arange(n_mb)

    def block(qi):
        s = qi * Q_BLOCK
        t = s + jnp.arange(Q_BLOCK)
        q = lax.dynamic_slice_in_dim(qm, s, Q_BLOCK, axis=1)
        cur = s // MOBA_BLOCK
        k_own = lax.dynamic_slice_in_dim(km, cur * MOBA_BLOCK, MOBA_BLOCK, axis=1)
        v_own = lax.dynamic_slice_in_dim(vm, cur * MOBA_BLOCK, MOBA_BLOCK, axis=1)
        own_pos = cur * MOBA_BLOCK + jnp.arange(MOBA_BLOCK)
        s_own = jnp.einsum('bqhd,bkhd->bhqk', q, k_own) * scale
        m_own = jnp.broadcast_to(own_pos[None, :] <= t[:, None], s_own.shape)
        gate = jnp.einsum('bqhd,bhnd->bhqn', q.astype(jnp.float32), km_mean)
        gate = jnp.where(mb_ids < cur, gate, -jnp.inf)
        g_val, g_idx = lax.top_k(gate, k_moba)
        k_g = gather_blocks(km_blocks, g_idx)
        v_g = gather_blocks(vm_blocks, g_idx)
        s_g = jnp.einsum('bqhd,bhqnsd->bhqns', q, k_g).reshape(
            B, MOBA_HEADS, Q_BLOCK, k_moba * MOBA_BLOCK) * scale
        m_g = jnp.broadcast_to(jnp.isfinite(g_val)[..., None],
                               (B, MOBA_HEADS, Q_BLOCK, k_moba, MOBA_BLOCK)).reshape(s_g.shape)
        p = masked_softmax(jnp.concatenate([s_own, s_g], axis=-1), jnp.concatenate([m_own, m_g], axis=-1))
        o_moba = (jnp.einsum('bhqk,bkhd->bqhd', p[..., :MOBA_BLOCK], v_own)
                  + jnp.einsum('bhqm,bhqmd->bqhd', p[..., MOBA_BLOCK:],
                               v_g.reshape(B, MOBA_HEADS, Q_BLOCK, k_moba * MOBA_BLOCK, hd)))
        qn = lax.dynamic_slice_in_dim(qd, s, Q_BLOCK, axis=1)
        s_c = jnp.einsum('bqhgd,bnhd->bhgqn', qn, k_cmp) * scale
        p_c = masked_softmax(s_c, cmp_end[None, :] <= t[:, None])
        o_c = jnp.einsum('bhgqn,bnhd->bqhgd', p_c, v_cmp)
        imp = jnp.pad(p_c.sum(axis=2), ((0, 0), (0, 0), (0, 0), (0, 1)))
        r = imp.reshape(B, NSA_KV_HEADS, Q_BLOCK, n_sel, SEL_BLOCK // CMP_STRIDE)
        p_slc = r.sum(-1) + jnp.pad(r[..., :-1, -1], ((0, 0), (0, 0), (0, 0), (1, 0)))
        cur_s = (t // SEL_BLOCK)[:, None]
        forced = (blk_ids == 0) | (blk_ids == cur_s) | (blk_ids == cur_s - 1)
        score = jnp.where(forced, FORCED_SCORE, jnp.where(blk_ids < cur_s, p_slc, -jnp.inf))
        s_val, s_idx = lax.top_k(score, k_nsa)
        k_b = gather_blocks(k_sel, s_idx)
        v_b = gather_blocks(v_sel, s_idx)
        pos = s_idx[..., None] * SEL_BLOCK + jnp.arange(SEL_BLOCK)
        m_s = (jnp.isfinite(s_val)[..., None] & (pos <= t[:, None, None])).reshape(
            B, NSA_KV_HEADS, Q_BLOCK, k_nsa * SEL_BLOCK)[:, :, None]
        s_s = jnp.einsum('bqhgd,bhqnsd->bhgqns', qn, k_b).reshape(
            B, NSA_KV_HEADS, NSA_GROUP, Q_BLOCK, k_nsa * SEL_BLOCK) * scale
        o_s = jnp.einsum('bhgqm,bhqmd->bqhgd', masked_softmax(s_s, m_s),
                         v_b.reshape(B, NSA_KV_HEADS, Q_BLOCK, k_nsa * SEL_BLOCK, hd))
        k_w = lax.dynamic_slice_in_dim(k_win, s, Q_BLOCK + WINDOW, axis=1)
        v_w = lax.dynamic_slice_in_dim(v_win, s, Q_BLOCK + WINDOW, axis=1)
        wpos = s - WINDOW + jnp.arange(Q_BLOCK + WINDOW)
        m_w = (wpos[None, :] <= t[:, None]) & (wpos[None, :] > t[:, None] - WINDOW) & (wpos[None, :] >= 0)
        s_w = jnp.einsum('bqhgd,bkhd->bhgqk', qn, k_w) * scale
        o_w = jnp.einsum('bhgqk,bkhd->bqhgd', masked_softmax(s_w, m_w), v_w)
        g = lax.dynamic_slice_in_dim(gates, s, Q_BLOCK, axis=1)
        o_nsa = (g[:, :, 0][..., None] * o_c + g[:, :, 1][..., None] * o_s
                 + g[:, :, 2][..., None] * o_w)
        o = jnp.concatenate([o_moba.reshape(B, Q_BLOCK, MOBA_W),
                             o_nsa.reshape(B, Q_BLOCK, NSA_W)], axis=-1)
        return o.astype(h.dtype)

    out = lax.map(block, jnp.arange(Lp // Q_BLOCK))
    out = out.transpose(1, 0, 2, 3).reshape(B, Lp, D_MODEL)[:, :L]
    return out @ w_out


def hier_moe(h, w_group, b_group, w_expert, b_expert, w_gate, w_up, w_down):
    B, L, D = h.shape
    xt = h.reshape(B * L, D)
    gl = (xt @ w_group).astype(jnp.float32) + b_group.astype(jnp.float32)
    gp = jax.nn.softmax(gl, axis=-1)
    gi = jnp.argmax(gl, axis=-1)
    gw = jnp.take_along_axis(gp, gi[:, None], axis=-1)
    el = ((xt @ w_expert).astype(jnp.float32) + b_expert.astype(jnp.float32)).reshape(
        B * L, N_GROUPS, EXPERTS_PER_GROUP)
    el = jnp.take_along_axis(el, gi[:, None, None], axis=1)[:, 0]
    ev, ei = lax.top_k(jax.nn.softmax(el, axis=-1), EXPERT_TOPK)
    ev = ev / jnp.sum(ev, axis=-1, keepdims=True)
    eidx = gi[:, None] * EXPERTS_PER_GROUP + ei
    gate = jnp.sum(jax.nn.one_hot(eidx, N_EXPERTS, dtype=jnp.float32) * (gw * ev)[..., None], axis=1)
    h1 = jnp.einsum('td,edf->tef', xt, w_gate)
    h3 = jnp.einsum('td,edf->tef', xt, w_up)
    act = jax.nn.silu(h1) * h3 * gate[..., None].astype(h1.dtype)
    y = jnp.einsum('tef,efd->td', act, w_down)
    return y.reshape(B, L, D).astype(h.dtype)


def setup_inputs(seed: int = 0) -> dict:
    key = jax.random.key(seed)
    ks = iter(jax.random.split(key, 64))
    NE = (DEPTH + 1) // 2
    NO = DEPTH // 2

    def nrm(shape, scale):
        return jax.random.normal(next(ks), shape, jnp.float32) * scale

    def gain(shape):
        return 1.0 + nrm(shape, 0.01)

    x = nrm((BATCH, SEQ, D_MODEL), 1.0)
    ev_norm_mix = gain((NE, D_MODEL))
    ev_w_in = nrm((NE, D_MODEL, IN_EVEN), D_MODEL ** -0.5)
    ev_w_out = nrm((NE, D_MODEL, D_MODEL), D_MODEL ** -0.5)
    s5_lam_re = -0.5 * jnp.exp(nrm((NE, S5_GROUPS, S5_STATE), 0.1))
    s5_lam_im = math.pi * jnp.arange(S5_STATE, dtype=jnp.float32) + nrm((NE, S5_GROUPS, S5_STATE), 0.01)
    s5_log_dt = jax.random.uniform(next(ks), (NE, S5_GROUPS), jnp.float32, math.log(1e-3), math.log(1e-1))
    s5_b_re = nrm((NE, S5_GROUPS, S5_STATE, S5_GROUP), (2 * S5_GROUP) ** -0.5)
    s5_b_im = nrm((NE, S5_GROUPS, S5_STATE, S5_GROUP), (2 * S5_GROUP) ** -0.5)
    s5_c_re = nrm((NE, S5_GROUPS, S5_GROUP, S5_STATE), S5_STATE ** -0.5)
    s5_c_im = nrm((NE, S5_GROUPS, S5_GROUP, S5_STATE), S5_STATE ** -0.5)
    s5_d = nrm((NE, S5_WIDTH), 0.5)
    s5_w_glu = nrm((NE, S5_WIDTH, S5_WIDTH), S5_WIDTH ** -0.5)
    conv_w = nrm((NE, CONV_K, CONV_WIDTH), CONV_K ** -0.5)
    conv_b = nrm((NE, CONV_WIDTH), 0.01)
    od_norm_mix = gain((NO, D_MODEL))
    od_w_in = nrm((NO, D_MODEL, IN_ODD), D_MODEL ** -0.5)
    od_w_out = nrm((NO, D_MODEL, D_MODEL), D_MODEL ** -0.5)
    moba_q_norm = gain((NO, HEAD_DIM))
    moba_k_norm = gain((NO, HEAD_DIM))
    nsa_q_norm = gain((NO, HEAD_DIM))
    nsa_kcmp_norm = gain((NO, HEAD_DIM))
    nsa_ksel_norm = gain((NO, HEAD_DIM))
    nsa_kwin_norm = gain((NO, HEAD_DIM))
    cmp_pe_k = nrm((NO, CMP_BLOCK, HEAD_DIM), 0.02)
    cmp_w1_k = nrm((NO, CMP_BLOCK * HEAD_DIM, CMP_HIDDEN), (CMP_BLOCK * HEAD_DIM) ** -0.5)
    cmp_w2_k = nrm((NO, CMP_HIDDEN, HEAD_DIM), CMP_HIDDEN ** -0.5)
    cmp_pe_v = nrm((NO, CMP_BLOCK, HEAD_DIM), 0.02)
    cmp_w1_v = nrm((NO, CMP_BLOCK * HEAD_DIM, CMP_HIDDEN), (CMP_BLOCK * HEAD_DIM) ** -0.5)
    cmp_w2_v = nrm((NO, CMP_HIDDEN, HEAD_DIM), CMP_HIDDEN ** -0.5)
    moe_norm = gain((DEPTH, D_MODEL))
    moe_w_group = nrm((DEPTH, D_MODEL, N_GROUPS), D_MODEL ** -0.5)
    moe_b_group = nrm((DEPTH, N_GROUPS), 0.01)
    moe_w_expert = nrm((DEPTH, D_MODEL, N_EXPERTS), D_MODEL ** -0.5)
    moe_b_expert = nrm((DEPTH, N_EXPERTS), 0.01)
    moe_w_gate = nrm((DEPTH, N_EXPERTS, D_MODEL, EXPERT_FF), D_MODEL ** -0.5)
    moe_w_up = nrm((DEPTH, N_EXPERTS, D_MODEL, EXPERT_FF), D_MODEL ** -0.5)
    moe_w_down = nrm((DEPTH, N_EXPERTS, EXPERT_FF, D_MODEL), EXPERT_FF ** -0.5)
    return {'x': x, 'ev_norm_mix': ev_norm_mix, 'ev_w_in': ev_w_in, 'ev_w_out': ev_w_out,
            's5_lam_re': s5_lam_re, 's5_lam_im': s5_lam_im, 's5_log_dt': s5_log_dt,
            's5_b_re': s5_b_re, 's5_b_im': s5_b_im, 's5_c_re': s5_c_re, 's5_c_im': s5_c_im,
            's5_d': s5_d, 's5_w_glu': s5_w_glu, 'conv_w': conv_w, 'conv_b': conv_b,
            'od_norm_mix': od_norm_mix, 'od_w_in': od_w_in, 'od_w_out': od_w_out,
            'moba_q_norm': moba_q_norm, 'moba_k_norm': moba_k_norm, 'nsa_q_norm': nsa_q_norm,
            'nsa_kcmp_norm': nsa_kcmp_norm, 'nsa_ksel_norm': nsa_ksel_norm, 'nsa_kwin_norm': nsa_kwin_norm,
            'cmp_pe_k': cmp_pe_k, 'cmp_w1_k': cmp_w1_k, 'cmp_w2_k': cmp_w2_k,
            'cmp_pe_v': cmp_pe_v, 'cmp_w1_v': cmp_w1_v, 'cmp_w2_v': cmp_w2_v,
            'moe_norm': moe_norm, 'moe_w_group': moe_w_group, 'moe_b_group': moe_b_group,
            'moe_w_expert': moe_w_expert, 'moe_b_expert': moe_b_expert,
            'moe_w_gate': moe_w_gate, 'moe_w_up': moe_w_up, 'moe_w_down': moe_w_down}


def reference(x, ev_norm_mix, ev_w_in, ev_w_out, s5_lam_re, s5_lam_im, s5_log_dt, s5_b_re, s5_b_im,
              s5_c_re, s5_c_im, s5_d, s5_w_glu, conv_w, conv_b, od_norm_mix, od_w_in, od_w_out,
              moba_q_norm, moba_k_norm, nsa_q_norm, nsa_kcmp_norm, nsa_ksel_norm, nsa_kwin_norm,
              cmp_pe_k, cmp_w1_k, cmp_w2_k, cmp_pe_v, cmp_w1_v, cmp_w2_v,
              moe_norm, moe_w_group, moe_b_group, moe_w_expert, moe_b_expert,
              moe_w_gate, moe_w_up, moe_w_down):
    h = x
    for layer in range(DEPTH):
        i = layer // 2
        if layer % 2 == 0:
            h = h + even_mixer(rms_norm(h, ev_norm_mix[i]), ev_w_in[i], ev_w_out[i],
                               s5_lam_re[i], s5_lam_im[i], s5_log_dt[i], s5_b_re[i], s5_b_im[i],
                               s5_c_re[i], s5_c_im[i], s5_d[i], s5_w_glu[i], conv_w[i], conv_b[i])
        else:
            h = h + odd_mixer(rms_norm(h, od_norm_mix[i]), od_w_in[i], od_w_out[i],
                              moba_q_norm[i], moba_k_norm[i], nsa_q_norm[i], nsa_kcmp_norm[i],
                              nsa_ksel_norm[i], nsa_kwin_norm[i], cmp_pe_k[i], cmp_w1_k[i], cmp_w2_k[i],
                              cmp_pe_v[i], cmp_w1_v[i], cmp_w2_v[i])
        h = h + hier_moe(rms_norm(h, moe_norm[layer]), moe_w_group[layer], moe_b_group[layer],
                         moe_w_expert[layer], moe_b_expert[layer], moe_w_gate[layer],
                         moe_w_up[layer], moe_w_down[layer])
    return h
```

```cpp
#include <hip/hip_runtime.h>
#include <hip/hip_cooperative_groups.h>
#include <cstdio>
namespace cg = cooperative_groups;

#define LAS __attribute__((address_space(3)))
typedef unsigned short bf16_t;
typedef short bf16x8 __attribute__((ext_vector_type(8)));
typedef float f32x4 __attribute__((ext_vector_type(4)));
typedef float f32x2 __attribute__((ext_vector_type(2)));
typedef unsigned u32x4 __attribute__((ext_vector_type(4)));
typedef unsigned u32x2 __attribute__((ext_vector_type(2)));

constexpr int NB = 2, SEQ = 16384, T = NB * SEQ, DM = 1024;
constexpr int IN_EVEN = 2560, IN_ODD = 2340, IN_ODD_P = 2560;
constexpr int NTHREADS = 512, NWAVES = 8;
constexpr int S5_LC = 64, S5_NCH = SEQ / S5_LC;
constexpr int MOE_MAXROWS = T + 24 * 256;

constexpr size_t al256(size_t x) { return (x + 255) & ~(size_t)255; }
constexpr size_t WS_CTL    = 0;
constexpr size_t WS_S5A    = WS_CTL + 65536;
constexpr size_t WS_S5AL   = WS_S5A + 16 * 64 * 8;
constexpr size_t WS_S5BB   = WS_S5AL + 16 * 64 * 8;
constexpr size_t WS_C1B    = WS_S5BB + 16 * 64 * 32 * 4;
constexpr size_t WS_WIN0T  = al256(WS_C1B + 2 * 256 * 4);
constexpr size_t WS_WOUT0T = WS_WIN0T + (size_t)IN_EVEN * DM * 2;
constexpr size_t WS_WIN1T  = WS_WOUT0T + (size_t)DM * DM * 2;
constexpr size_t WS_WOUT1T = WS_WIN1T + (size_t)IN_ODD_P * DM * 2;
constexpr size_t WS_C1T    = WS_WOUT1T + (size_t)DM * DM * 2;
constexpr size_t WS_MW1T   = WS_C1T + (size_t)2 * 256 * 2048 * 2;
constexpr size_t WS_MWDT   = WS_MW1T + (size_t)2 * 16 * 512 * 1024 * 2;
constexpr size_t WS_XN     = WS_MWDT + (size_t)2 * 16 * 1024 * 256 * 2;
constexpr size_t WS_PROJ   = WS_XN + (size_t)T * DM * 2;
constexpr size_t WS_A2     = WS_PROJ + (size_t)T * 2560 * 2;
constexpr size_t WS_S5E    = WS_A2 + (size_t)T * DM * 2;
constexpr size_t WS_TOKI   = WS_S5E + (size_t)NB * S5_NCH * 16 * 64 * 8;
constexpr size_t WS_ROWTOK = WS_TOKI + (size_t)T * 16;
constexpr size_t WS_WROW   = WS_ROWTOK + al256((size_t)MOE_MAXROWS * 4);
constexpr size_t WS_ATT    = WS_WROW + al256((size_t)MOE_MAXROWS * 16);
constexpr size_t WS_END    = WS_ATT + (size_t)149 * 1024 * 1024;
constexpr size_t WS_SS     = WS_END;
constexpr size_t WS_R0     = WS_SS + (size_t)T * 16 * 4;
constexpr size_t WS_C1BP   = WS_R0 + (size_t)T * 4;
constexpr size_t WS_TOTAL  = WS_C1BP + 2 * 4 * 32 * 64 * 4;
static_assert(WS_TOTAL <= (size_t)512 * 1024 * 1024, "workspace exceeds 512 MiB");
constexpr size_t S5_AG   = WS_ATT;
constexpr size_t S5_BG   = S5_AG + (size_t)16 * 512 * 1152 * 2;
constexpr size_t S5_YB   = S5_BG + (size_t)16 * 1024 * 1152 * 2;
constexpr size_t S5_MT   = S5_YB + (size_t)T * 256 * 2;
constexpr size_t S5_AP   = S5_MT + (size_t)16 * 64 * 256 * 4;
constexpr size_t S5_GLUT = S5_AP + (size_t)16 * 65 * 64 * 8;
constexpr size_t S5_SG   = S5_GLUT + 256 * 256 * 2;
static_assert(S5_SG + (size_t)16 * 256 * 1024 * 2 <= WS_END, "S5 buffers");
constexpr int CW_MOEQ = 16;
constexpr int CW_Q15A = 20;
constexpr int CW_Q15B = 21;
constexpr int CW_MOECNT = 64;
constexpr int CW_MOERDY = 256;
constexpr size_t WS_BAR = WS_CTL + 32768;

__device__ __forceinline__ unsigned cvt_pk_bf16(float lo, float hi) { unsigned r; asm volatile("v_cvt_pk_bf16_f32 %0, %1, %2" : "=v"(r) : "v"(lo), "v"(hi)); return r; }
__device__ __forceinline__ float bf_lo(unsigned w) { return __uint_as_float(w << 16); }
__device__ __forceinline__ float bf_hi(unsigned w) { return __uint_as_float(w & 0xffff0000u); }
__device__ __forceinline__ float bf2f(bf16_t b) { return __uint_as_float(((unsigned)b) << 16); }
__device__ __forceinline__ bf16_t f2bf(float f) { return (bf16_t)(cvt_pk_bf16(f, 0.f) & 0xffffu); }
__device__ __forceinline__ float wave_sum(float v) {
#pragma unroll
    for (int o = 1; o < 64; o <<= 1) v += __shfl_xor(v, o);
    return v;
}
__device__ __forceinline__ float wave_max(float v) {
#pragma unroll
    for (int o = 1; o < 64; o <<= 1) v = fmaxf(v, __shfl_xor(v, o));
    return v;
}
__device__ __forceinline__ float gelu_tanh(float x) {
    const float u = 0.7978845608028654f * (x + 0.044715f * x * x * x);
    const float e = __expf(2.f * u);
    const float th = 1.f - 2.f / (e + 1.f);
    return 0.5f * x * (1.f + th);
}
__device__ __forceinline__ float sigmoidf_(float x) { return 1.f / (1.f + __expf(-x)); }

namespace pg8 {
constexpr int BM = 256, BK = 64, HALF = 128, HTB = HALF * BK * 2, STAGE_BYTES = 8 * HTB;
__device__ __forceinline__ int lds_byte(int r, int c) { const int st = (r >> 4) * 2 + (c >> 5), rr = r & 15, cc = c & 31, ob = rr * 64 + cc * 2; return st * 1024 + (ob ^ (((ob >> 9) & 1) << 5)); }
__device__ __forceinline__ void stage_rc(int b, int& R, int& C) { const int st = b / 1024, sb = b % 1024, swz = sb ^ (((sb >> 9) & 1) << 5); R = (st >> 1) * 16 + swz / 64; C = (st & 1) * 32 + (swz % 64) / 2; }
__device__ __forceinline__ int perm32(int rho) { const int n = rho >> 4, i = rho & 15; return 8 * (i >> 2) + 4 * n + (i & 3); }

struct Unit { int arow, pn, b0, b1, nt, aux; };
struct Gemm { const bf16_t* A; const char* Bbase; int lda, ldb, K, ksplit; const int* gather; };

template <class Epi, class Sched, bool GATHER, bool HOOKS = false>
__device__ __forceinline__ void gemm_phase(LAS unsigned char* lds, const Gemm g, const Sched& S, const Epi& E) {
    int tid = threadIdx.x; asm volatile("" : "+v"(tid));
    const int wid = __builtin_amdgcn_readfirstlane(tid >> 6), lane = tid & 63, wr = wid >> 2, wc = wid & 3, fr = lane & 15, fq = lane >> 4;
    unsigned voffA[2], voffB[2];
#pragma unroll
    for (int i = 0; i < 2; ++i) { int R, C; stage_rc(tid * 16 + i * 8192, R, C); const int Rb = Epi::PERM ? ((R & ~31) + perm32(R & 31)) : R;
        voffA[i] = (unsigned)(R * g.lda + C) * 2u; voffB[i] = (unsigned)(Rb * g.ldb + C) * 2u; }
    const size_t kstep = (size_t)(BK * 2);
    const size_t hstepA = (size_t)HALF * g.lda * 2, hstepB = (size_t)HALF * g.ldb * 2;
    const unsigned ldsw = (unsigned)wid * 1024u;
    const int aoff = lds_byte(wr * 64 + fr, fq * 8), boff = lds_byte(wc * 32 + fr, fq * 8);
#define PG8_SA(b, h) (((b) * 2 + (h)) * HTB)
#define PG8_SB(b, h) ((4 + (b) * 2 + (h)) * HTB)
#define PG8_STAGE(bufoff, gbase, voff) do { _Pragma("unroll") for (int _i = 0; _i < 2; ++_i) \
        __builtin_amdgcn_global_load_lds((const unsigned*)((const char*)(gbase) + (voff)[_i]), (LAS unsigned*)(lds + (bufoff) + ldsw + _i * 8192), 16, 0, 0); } while (0)
#define PG8_STAGE_A(bufoff, isnext, h, toff) do { if constexpr (GATHER) { if (isnext) { unsigned _vn[2]; _vn[0] = park[(h) * 2 * 512]; _vn[1] = park[((h) * 2 + 1) * 512]; PG8_STAGE(bufoff, gA + (toff), _vn); } else PG8_STAGE(bufoff, gA + (toff), voC[h]); } \
        else { PG8_STAGE(bufoff, ((isnext) ? nA : cA) + (h) * hstepA + (toff), voffA); } } while (0)
#define PG8_LDA(dst, b, h) do { _Pragma("unroll") for (int m = 0; m < 4; ++m) _Pragma("unroll") for (int k = 0; k < 2; ++k) dst[m][k] = *(const LAS bf16x8*)(lds + PG8_SA(b, h) + aoff + m * 2048 + k * 1024); } while (0)
#define PG8_LDB(dst, b, h) do { _Pragma("unroll") for (int n = 0; n < 2; ++n) _Pragma("unroll") for (int k = 0; k < 2; ++k) dst[n][k] = *(const LAS bf16x8*)(lds + PG8_SB(b, h) + boff + n * 2048 + k * 1024); } while (0)
#define PG8_MMA(ai, bj, At, Bt) do { __builtin_amdgcn_s_setprio(1); _Pragma("unroll") for (int m = 0; m < 4; ++m) _Pragma("unroll") for (int n = 0; n < 2; ++n) _Pragma("unroll") for (int k = 0; k < 2; ++k) \
        acc[ai][bj][m][n] = __builtin_amdgcn_mfma_f32_16x16x32_bf16(Bt[n][k], At[m][k], acc[ai][bj][m][n], 0, 0, 0); __builtin_amdgcn_s_setprio(0); } while (0)
#define PG8_WAIT_V(n) asm volatile("s_waitcnt vmcnt(" #n ")" ::: "memory")
#define PG8_WAIT_L(n) asm volatile("s_waitcnt lgkmcnt(" #n ")" ::: "memory")
#define PG8_BAR __builtin_amdgcn_s_barrier()
#define PG8_SCHED __builtin_amdgcn_sched_barrier(0)
#define PG8_AOFFS(dst, u) do { int _t = threadIdx.x; asm volatile("" : "+v"(_t)); _Pragma("unroll") for (int _h = 0; _h < 2; ++_h) _Pragma("unroll") for (int _i = 0; _i < 2; ++_i) { \
        int _R, _C; stage_rc(_t * 16 + _i * 8192, _R, _C); int _row = g.gather[(u).arow + _h * HALF + _R]; _row = _row < 0 ? 0 : _row; \
        dst[_h][_i] = (unsigned)((size_t)_row * g.lda + _C) * 2u; } \
        asm volatile("" : "+v"(dst[0][0]), "+v"(dst[0][1]), "+v"(dst[1][0]), "+v"(dst[1][1])); } while (0)
    Unit cur, nxt; int ui = 0;
    if (!S.next(0, cur)) return;
    f32x4 acc[2][2][4][2];
#pragma unroll
    for (int a = 0; a < 2; ++a)
#pragma unroll
        for (int b = 0; b < 2; ++b)
#pragma unroll
            for (int m = 0; m < 4; ++m)
#pragma unroll
                for (int n = 0; n < 2; ++n) acc[a][b][m][n] = (f32x4){0.f, 0.f, 0.f, 0.f};
    bf16x8 At[4][2], B0[2][2], B1[2][2];
    unsigned voC[2][2];
    LAS unsigned* park = (LAS unsigned*)(lds + 131072 + 1024) + tid;
    const char* gA = (const char*)g.A;
    const char* cA = gA + (size_t)cur.arow * g.lda * 2; const char* nA = cA;
    if constexpr (GATHER) { PG8_AOFFS(voC, cur); }
    if constexpr (HOOKS) S.a_ready(cur);
#define PG8_BP(u, tile) (g.Bbase + (long)((tile) < g.ksplit ? (u).b0 : (u).b1) + (size_t)(tile) * kstep)
    { const char* b0 = PG8_BP(cur, 0); const char* b1 = PG8_BP(cur, 1);
      PG8_STAGE(PG8_SB(0, 0), b0, voffB); PG8_STAGE_A(PG8_SA(0, 0), false, 0, 0); PG8_STAGE(PG8_SB(0, 1), b0 + hstepB, voffB); PG8_STAGE_A(PG8_SA(0, 1), false, 1, 0);
      if (wr == 1) PG8_BAR;
      PG8_WAIT_V(4); PG8_BAR;
      PG8_STAGE(PG8_SB(1, 0), b1, voffB); PG8_STAGE_A(PG8_SA(1, 0), false, 0, kstep); PG8_STAGE(PG8_SB(1, 1), b1 + hstepB, voffB);
      PG8_WAIT_V(6); PG8_BAR; }
    for (;;) {
        const bool has_next = S.next(ui + 1, nxt);
        if (has_next) { nA = gA + (size_t)nxt.arow * g.lda * 2; if constexpr (GATHER) { unsigned voN[2][2]; PG8_AOFFS(voN, nxt); park[0] = voN[0][0]; park[512] = voN[0][1]; park[1024] = voN[1][0]; park[1536] = voN[1][1]; } }
        else { nA = cA; nxt = cur;
            if constexpr (GATHER) { park[0] = voC[0][0]; park[512] = voC[0][1]; park[1024] = voC[1][0]; park[1536] = voC[1][1]; } }
        const int nt = cur.nt;
#pragma unroll 1
        for (int t = 0; t < nt; t += 2) {
            const bool last = (t == nt - 2);
            if constexpr (HOOKS) { if (last && has_next) S.a_ready(nxt); }
            const size_t o1 = (size_t)(t + 1) * kstep, o2 = last ? 0 : (size_t)(t + 2) * kstep, o3 = o2 + kstep;
            const char* b2 = last ? PG8_BP(nxt, 0) : PG8_BP(cur, t + 2);
            const char* b3 = last ? PG8_BP(nxt, 1) : PG8_BP(cur, t + 3);
            PG8_LDB(B0, 0, 0); PG8_SCHED; PG8_LDA(At, 0, 0); PG8_STAGE_A(PG8_SA(1, 1), false, 1, o1);
            PG8_WAIT_L(8); PG8_BAR; PG8_WAIT_L(0); PG8_MMA(0, 0, At, B0); PG8_BAR; PG8_SCHED;
            PG8_LDB(B1, 0, 1); PG8_STAGE(PG8_SB(0, 0), b2, voffB);
            PG8_BAR; PG8_WAIT_L(0); PG8_MMA(0, 1, At, B1); PG8_BAR;
            PG8_LDA(At, 0, 1); PG8_STAGE_A(PG8_SA(0, 0), last, 0, o2);
            PG8_BAR; PG8_WAIT_L(0); PG8_MMA(1, 0, At, B0); PG8_BAR; PG8_SCHED;
            PG8_STAGE(PG8_SB(0, 1), b2 + hstepB, voffB);
            PG8_WAIT_V(6); PG8_BAR; PG8_MMA(1, 1, At, B1); PG8_BAR;
            PG8_LDB(B0, 1, 0); PG8_SCHED; PG8_LDA(At, 1, 0); PG8_STAGE_A(PG8_SA(0, 1), last, 1, o2);
            PG8_WAIT_L(8); PG8_BAR; PG8_WAIT_L(0); PG8_MMA(0, 0, At, B0); PG8_BAR; PG8_SCHED;
            PG8_LDB(B1, 1, 1); PG8_STAGE(PG8_SB(1, 0), b3, voffB);
            PG8_BAR; PG8_WAIT_L(0); PG8_MMA(0, 1, At, B1); PG8_BAR;
            PG8_LDA(At, 1, 1); PG8_STAGE_A(PG8_SA(1, 0), last, 0, o3);
            PG8_BAR; PG8_WAIT_L(0); PG8_MMA(1, 0, At, B0); PG8_BAR; PG8_SCHED;
            PG8_STAGE(PG8_SB(1, 1), b3 + hstepB, voffB);
            PG8_WAIT_V(6); PG8_BAR; PG8_MMA(1, 1, At, B1); PG8_BAR;
        }
        E(acc, cur, wr, wc, fr, fq);
        if constexpr (HOOKS) S.done(cur);
        if (!has_next) break;
#pragma unroll
        for (int a = 0; a < 2; ++a)
#pragma unroll
            for (int b = 0; b < 2; ++b)
#pragma unroll
                for (int m = 0; m < 4; ++m)
#pragma unroll
                    for (int n = 0; n < 2; ++n) acc[a][b][m][n] = (f32x4){0.f, 0.f, 0.f, 0.f};
        cur = nxt; cA = nA; ++ui;
        if constexpr (GATHER) { voC[0][0] = park[0]; voC[0][1] = park[512]; voC[1][0] = park[1024]; voC[1][1] = park[1536]; }
    }
    PG8_WAIT_V(0);
    if (wr == 0) PG8_BAR;
    PG8_BAR;
#undef PG8_SA
#undef PG8_SB
#undef PG8_STAGE
#undef PG8_STAGE_A
#undef PG8_LDA
#undef PG8_LDB
#undef PG8_MMA
#undef PG8_WAIT_V
#undef PG8_WAIT_L
#undef PG8_BAR
#undef PG8_SCHED
#undef PG8_AOFFS
#undef PG8_BP
}

struct DenseSched {
    int nM, nN, nwg, G, c, btile, nt;
    __device__ void init(int M, int N, int G_, int c_, int ldb, int K) { nM = M / BM; nN = N / BM; nwg = nM * nN; G = G_; c = c_; btile = BM * ldb * 2; nt = K / BK; }
    __device__ bool next(int i, Unit& u) const {
        const long L = (long)i * G + c; if (L >= nwg) return false;
        int wgid = (int)L; { const int q = nwg / 8, r = nwg % 8, xcd = wgid % 8, off = wgid / 8; wgid = (xcd < r ? xcd * (q + 1) : r * (q + 1) + (xcd - r) * q) + off; }
        const int WGM = 8, nig = WGM * nN, gid = wgid / nig, fm = gid * WGM, gsz = (nM - fm) < WGM ? (nM - fm) : WGM;
        u.arow = (fm + ((wgid % nig) % gsz)) * BM; u.pn = (wgid % nig) / gsz;
        u.b0 = u.pn * btile; u.b1 = u.b0; u.nt = nt; return true;
    }
};

struct EpiBf16Plain {
    static constexpr bool PERM = true;
    bf16_t* O; int ldc;
    __device__ __forceinline__ void operator()(const f32x4 (&acc)[2][2][4][2], const Unit& u, int wr, int wc, int fr, int fq) const {
        const int row0 = u.arow + wr * 64 + fr, col0 = u.pn * BM + wc * 32 + 8 * fq;
#pragma unroll
        for (int ai = 0; ai < 2; ++ai)
#pragma unroll
            for (int m = 0; m < 4; ++m) { bf16_t* rowp = O + (size_t)(row0 + ai * HALF + m * 16) * ldc + col0;
#pragma unroll
                for (int bj = 0; bj < 2; ++bj) { const f32x4 v0 = acc[ai][bj][m][0], v1 = acc[ai][bj][m][1];
                    u32x4 w; w.x = cvt_pk_bf16(v0[0], v0[1]); w.y = cvt_pk_bf16(v0[2], v0[3]); w.z = cvt_pk_bf16(v1[0], v1[1]); w.w = cvt_pk_bf16(v1[2], v1[3]);
                    *(u32x4*)(rowp + bj * HALF) = w; } }
    }
};
struct EpiBiasGeluBf16 {
    static constexpr bool PERM = true;
    bf16_t* O; int ldc; const float* bias;
    __device__ __forceinline__ void operator()(const f32x4 (&acc)[2][2][4][2], const Unit& u, int wr, int wc, int fr, int fq) const {
        const int row0 = u.arow + wr * 64 + fr, col0 = u.pn * BM + wc * 32 + 8 * fq;
#pragma unroll
        for (int ai = 0; ai < 2; ++ai)
#pragma unroll
            for (int m = 0; m < 4; ++m) { bf16_t* rowp = O + (size_t)(row0 + ai * HALF + m * 16) * ldc + col0;
#pragma unroll
                for (int bj = 0; bj < 2; ++bj) { f32x4 v0 = acc[ai][bj][m][0], v1 = acc[ai][bj][m][1];
                    const f32x4 b0 = *(const f32x4*)(bias + col0 + bj * HALF), b1 = *(const f32x4*)(bias + col0 + bj * HALF + 4);
#pragma unroll
                    for (int j = 0; j < 4; ++j) { v0[j] = gelu_tanh(v0[j] + b0[j]); v1[j] = gelu_tanh(v1[j] + b1[j]); }
                    u32x4 w; w.x = cvt_pk_bf16(v0[0], v0[1]); w.y = cvt_pk_bf16(v0[2], v0[3]); w.z = cvt_pk_bf16(v1[0], v1[1]); w.w = cvt_pk_bf16(v1[2], v1[3]);
                    *(u32x4*)(rowp + bj * HALF) = w; } }
    }
};
__device__ __forceinline__ float row_sumsq16(const f32x4& a, const f32x4& b, const f32x4& c, const f32x4& d) {
    float s = (a[0] * a[0] + a[1] * a[1]) + (a[2] * a[2] + a[3] * a[3]) + (b[0] * b[0] + b[1] * b[1]) + (b[2] * b[2] + b[3] * b[3])
            + (c[0] * c[0] + c[1] * c[1]) + (c[2] * c[2] + c[3] * c[3]) + (d[0] * d[0] + d[1] * d[1]) + (d[2] * d[2] + d[3] * d[3]);
    s += __shfl_xor(s, 16); s += __shfl_xor(s, 32); return s;
}
__device__ __forceinline__ float rms_from_ss(const float* ssrow) {
    const f32x4 a = *(const f32x4*)ssrow, b = *(const f32x4*)(ssrow + 4), c = *(const f32x4*)(ssrow + 8), d = *(const f32x4*)(ssrow + 12);
    const float s = ((a[0] + a[1]) + (a[2] + a[3])) + ((b[0] + b[1]) + (b[2] + b[3])) + ((c[0] + c[1]) + (c[2] + c[3])) + ((d[0] + d[1]) + (d[2] + d[3]));
    return rsqrtf(s * (1.f / DM) + 1e-6f);
}
template <bool BASE_F32> struct EpiResidualB {
    static constexpr bool PERM = !BASE_F32;
    const float* basef; bf16_t* hb; float* SS;
    __device__ __forceinline__ void operator()(const f32x4 (&acc)[2][2][4][2], const Unit& u, int wr, int wc, int fr, int fq) const {
        const int row0 = u.arow + wr * 64 + fr, col0 = u.pn * BM + wc * 32 + (BASE_F32 ? 4 : 8) * fq;
        if constexpr (!BASE_F32) {
            u32x4 bw[2][4][2]; const char* hbc = (const char*)hb;
#pragma unroll
            for (int ai = 0; ai < 2; ++ai)
#pragma unroll
                for (int m = 0; m < 4; ++m) { const unsigned off = (unsigned)((row0 + ai * HALF + m * 16) * DM + col0) * 2u;
#pragma unroll
                    for (int bj = 0; bj < 2; ++bj) bw[ai][m][bj] = *(const u32x4*)(hbc + (size_t)(off + bj * HALF * 2)); }
#pragma unroll
            for (int ai = 0; ai < 2; ++ai)
#pragma unroll
                for (int m = 0; m < 4; ++m) { const int row = row0 + ai * HALF + m * 16; const unsigned off = (unsigned)(row * DM + col0) * 2u; f32x4 v[2][2];
#pragma unroll
                    for (int bj = 0; bj < 2; ++bj) { const u32x4 w = bw[ai][m][bj];
                        v[bj][0] = (f32x4){bf_lo(w.x), bf_hi(w.x), bf_lo(w.y), bf_hi(w.y)} + acc[ai][bj][m][0]; v[bj][1] = (f32x4){bf_lo(w.z), bf_hi(w.z), bf_lo(w.w), bf_hi(w.w)} + acc[ai][bj][m][1];
                        u32x4 o; o.x = cvt_pk_bf16(v[bj][0][0], v[bj][0][1]); o.y = cvt_pk_bf16(v[bj][0][2], v[bj][0][3]); o.z = cvt_pk_bf16(v[bj][1][0], v[bj][1][1]); o.w = cvt_pk_bf16(v[bj][1][2], v[bj][1][3]);
                        *(u32x4*)((char*)hb + (size_t)(off + bj * HALF * 2)) = o; }
                    const float ss = row_sumsq16(v[0][0], v[0][1], v[1][0], v[1][1]);
                    if (fq == 0) SS[(size_t)row * 16 + u.pn * 4 + wc] = ss; }
        } else {
#pragma unroll
        for (int ai = 0; ai < 2; ++ai) {
            f32x4 bs[4][2][2];
#pragma unroll
            for (int m = 0; m < 4; ++m) { const size_t off = (size_t)(row0 + ai * HALF + m * 16) * DM + col0;
#pragma unroll
                for (int bj = 0; bj < 2; ++bj)
#pragma unroll
                    for (int n = 0; n < 2; ++n) bs[m][bj][n] = *(const f32x4*)(basef + off + bj * HALF + n * 16); }
#pragma unroll
            for (int m = 0; m < 4; ++m) { const int row = row0 + ai * HALF + m * 16; const size_t off = (size_t)row * DM + col0; f32x4 v[2][2];
#pragma unroll
                for (int bj = 0; bj < 2; ++bj)
#pragma unroll
                    for (int n = 0; n < 2; ++n) { v[bj][n] = bs[m][bj][n] + acc[ai][bj][m][n];
                        u32x2 o; o.x = cvt_pk_bf16(v[bj][n][0], v[bj][n][1]); o.y = cvt_pk_bf16(v[bj][n][2], v[bj][n][3]); *(u32x2*)(hb + off + bj * HALF + n * 16) = o; }
                const float ss = row_sumsq16(v[0][0], v[0][1], v[1][0], v[1][1]);
                if (fq == 0) SS[(size_t)row * 16 + u.pn * 4 + wc] = ss; }
            asm volatile("" ::: "memory"); }
        }
    }
};
struct EpiBf16RowScale {
    static constexpr bool PERM = true;
    bf16_t* O; int ldc; const LAS float* rl;
    __device__ __forceinline__ void operator()(const f32x4 (&acc)[2][2][4][2], const Unit& u, int wr, int wc, int fr, int fq) const {
        const int row0 = u.arow + wr * 64 + fr, col0 = u.pn * BM + wc * 32 + 8 * fq; const LAS float* rp = rl + u.aux * 256 + wr * 64 + fr;
#pragma unroll
        for (int ai = 0; ai < 2; ++ai)
#pragma unroll
            for (int m = 0; m < 4; ++m) { const int row = row0 + ai * HALF + m * 16; const float r = rp[ai * HALF + m * 16]; bf16_t* rowp = O + (size_t)row * ldc + col0;
#pragma unroll
                for (int bj = 0; bj < 2; ++bj) { const f32x4 v0 = acc[ai][bj][m][0] * r, v1 = acc[ai][bj][m][1] * r;
                    u32x4 w; w.x = cvt_pk_bf16(v0[0], v0[1]); w.y = cvt_pk_bf16(v0[2], v0[3]); w.z = cvt_pk_bf16(v1[0], v1[1]); w.w = cvt_pk_bf16(v1[2], v1[3]);
                    *(u32x4*)(rowp + bj * HALF) = w; } }
    }
};
struct RowScaleSched : DenseSched {
    const float* SS; LAS float* rl;
    __device__ bool next(int i, Unit& u) const { const bool ok = DenseSched::next(i, u); u.aux = i & 1; return ok; }
    __device__ __forceinline__ void a_ready(const Unit& u) const { const int t = threadIdx.x;
        if (t < 256) rl[u.aux * 256 + t] = rms_from_ss(SS + (size_t)(u.arow + t) * 16); }
    __device__ __forceinline__ void done(const Unit&) const {}
};
struct EpiResidual {
    static constexpr bool PERM = false;
    const float* base; float* out; int ldc;
    __device__ __forceinline__ void operator()(const f32x4 (&acc)[2][2][4][2], const Unit& u, int wr, int wc, int fr, int fq) const {
        const int row0 = u.arow + wr * 64 + fr, col0 = u.pn * BM + wc * 32 + 4 * fq;
#pragma unroll
        for (int ai = 0; ai < 2; ++ai)
#pragma unroll
            for (int m = 0; m < 4; ++m) { const size_t off = (size_t)(row0 + ai * HALF + m * 16) * ldc + col0;
#pragma unroll
                for (int bj = 0; bj < 2; ++bj)
#pragma unroll
                    for (int n = 0; n < 2; ++n) { const f32x4 bs = *(const f32x4*)(base + off + bj * HALF + n * 16); *(f32x4*)(out + off + bj * HALF + n * 16) = bs + acc[ai][bj][m][n]; } }
    }
};
}
#define XB_TMO      128
#define XB_XCNT(j)  (256  + 64 * (j))
#define XB_XSUB(j)  (1280 + 64 * (j))
#define XB_XGEN(j)  (2304 + 64 * (j))
#define XB_TOP      3328
#define XB_TOPGEN   3392
#define XCD_BAR_WORDS 3456
#define XB_SPIN_CAP (1u << 22)
__device__ __forceinline__ unsigned xb_ld(unsigned* p)              { return __hip_atomic_load(p, __ATOMIC_RELAXED, __HIP_MEMORY_SCOPE_AGENT); }
__device__ __forceinline__ unsigned xb_add(unsigned* p, unsigned v) { return __hip_atomic_fetch_add(p, v, __ATOMIC_RELAXED, __HIP_MEMORY_SCOPE_AGENT); }
__device__ __forceinline__ unsigned xb_xcc_id() { return (unsigned)__builtin_amdgcn_s_getreg((3 << 11) | 20) & 0xFu; }
#define XB_SPIN(cond, bar) do { unsigned _sp = 0; while (cond) { __builtin_amdgcn_s_sleep(1); \
    if ((++_sp & 255u) == 0u) { if (xb_ld(&(bar)[XB_TMO])) break; if (_sp > XB_SPIN_CAP) { atomicAdd(&(bar)[XB_TMO], 1u); break; } } } } while (0)
struct XcdBarrier { unsigned* bar; unsigned x; volatile LAS unsigned* st; };
__device__ __forceinline__ XcdBarrier xcd_barrier_post(unsigned* bar, volatile LAS unsigned* st) {
    XcdBarrier b; b.bar = bar; b.x = xb_xcc_id(); b.st = st;
    if (threadIdx.x == 0) (void)xb_add(&bar[XB_XCNT(b.x)], 1u);
    return b;
}
__device__ __forceinline__ void xcd_barrier_complete(unsigned* bar, unsigned x, unsigned& nloc, unsigned& nx) {
    const unsigned G = gridDim.x * gridDim.y * gridDim.z;
    unsigned sum, cnt, mine, sp = 0u;
    for (;;) {
        sum = 0u; cnt = 0u; mine = 0u;
#pragma unroll
        for (unsigned j = 0; j < 16; ++j) { const unsigned c = xb_ld(&bar[XB_XCNT(j)]); sum += c; cnt += (c > 0u) ? 1u : 0u; mine = (j == x) ? c : mine; }
        if (sum == G) break;
        __builtin_amdgcn_s_sleep(1);
        if ((++sp & 255u) == 0u) { if (xb_ld(&bar[XB_TMO])) break; if (sp > XB_SPIN_CAP) { atomicAdd(&bar[XB_TMO], 1u); break; } }
    }
    nloc = mine > 0u ? mine : 1u; nx = cnt > 0u ? cnt : 1u;
}
__device__ __forceinline__ void xcd_barrier(const XcdBarrier& b) {
    asm volatile("s_waitcnt vmcnt(0)" ::: "memory");
    __syncthreads();
    if (threadIdx.x == 0) {
        unsigned* bar = b.bar;
        __builtin_amdgcn_s_waitcnt(0);
        unsigned nloc = b.st[0], nx = b.st[1];
        if (nloc == 0u) { xcd_barrier_complete(bar, b.x, nloc, nx); b.st[0] = nloc; b.st[1] = nx; }
        const unsigned old = xb_add(&bar[XB_XSUB(b.x)], 1u);
        const unsigned gen = old / nloc;
        if (old + 1u == (gen + 1u) * nloc) {
            __builtin_amdgcn_fence(__ATOMIC_RELEASE, "agent");
            asm volatile("s_waitcnt vmcnt(0)" ::: "memory");
            const unsigned og = xb_add(&bar[XB_TOP], 1u);
            const unsigned tg = og / nx;
            if (og + 1u == (tg + 1u) * nx) xb_add(&bar[XB_TOPGEN], 1u);
            else XB_SPIN(xb_ld(&bar[XB_TOPGEN]) == tg, bar);
            __builtin_amdgcn_fence(__ATOMIC_ACQUIRE, "agent");
            xb_add(&bar[XB_XGEN(b.x)], 1u);
            asm volatile("s_waitcnt vmcnt(0)" ::: "memory");
        } else {
            XB_SPIN(xb_ld(&bar[XB_XGEN(b.x)]) == gen, bar);
            __builtin_amdgcn_fence(__ATOMIC_ACQUIRE, "agent");
            asm volatile("s_waitcnt vmcnt(0)" ::: "memory");
        }
    }
    __syncthreads();
}
struct Params { const float* in[38]; float* out; unsigned char* ws; int ph_lo, ph_hi; };
enum { I_X = 0, I_EVNORM, I_EVWIN, I_EVWOUT, I_LAMRE, I_LAMIM, I_LOGDT, I_BRE, I_BIM, I_CRE, I_CIM, I_S5D, I_WGLU, I_CONVW, I_CONVB,
       I_ODNORM, I_ODWIN, I_ODWOUT, I_MQN, I_MKN, I_NQN, I_NKCN, I_NKSN, I_NKWN, I_PEK, I_W1K, I_W2K, I_PEV, I_W1V, I_W2V,
       I_MOENORM, I_WGRP, I_BGRP, I_WEXP, I_BEXP, I_WGATE, I_WUP, I_WDOWN };

struct Ctx {
    LAS unsigned char* lds; int tid, lane, wave, G, bid;
};
#define LDS_WAIT() asm volatile("s_waitcnt lgkmcnt(0)" ::: "memory")

__device__ __forceinline__ void transpose_item(const float* W, int ldw, int Nvalid, bf16_t* WT, int ldt, int mode, int rowoff, LAS float* scr, int kb, int nb, int lane, const float* kgain = nullptr) {
    (void)scr;
    const int kq = lane >> 3, nq = lane & 7, k0 = 64 * kb + 8 * kq, n = 32 * nb + 4 * nq;
    f32x4 a[8];
#pragma unroll
    for (int i = 0; i < 8; ++i) a[i] = n < Nvalid ? *(const f32x4*)(W + (size_t)(k0 + i) * ldw + n) : (f32x4){0.f, 0.f, 0.f, 0.f};
    if (kgain) {
#pragma unroll
        for (int i = 0; i < 8; ++i) a[i] = a[i] * kgain[k0 + i]; }
#pragma unroll
    for (int j = 0; j < 4; ++j) { const int nn = n + j; int row = (mode == 0 ? nn : ((nn >> 7) * 256 + (nn & 127))) + rowoff;
        if (mode == 2) {
            row = nn < 256 ? nn : nn < 1024 ? 256 + ((nn - 256) >> 7) * 256 + ((nn - 256) & 127) : nn < 1792 ? 1792 + (nn - 1024) : 256 + ((nn - 1792) >> 7) * 256 + 128 + ((nn - 1792) & 127); }
        u32x4 o; o.x = cvt_pk_bf16(a[0][j], a[1][j]); o.y = cvt_pk_bf16(a[2][j], a[3][j]); o.z = cvt_pk_bf16(a[4][j], a[5][j]); o.w = cvt_pk_bf16(a[6][j], a[7][j]);
        *(u32x4*)(WT + (size_t)row * ldt + k0) = o; }
}
__device__ __forceinline__ void row_to_bf16_r(const float* xrow, bf16_t* orow, float* rout, int lane) {
    const f32x4* xr = (const f32x4*)xrow + lane;
    f32x4 v[4]; float s = 0.f;
#pragma unroll
    for (int j = 0; j < 4; ++j) { v[j] = xr[64 * j]; s += (v[j].x * v[j].x + v[j].y * v[j].y) + (v[j].z * v[j].z + v[j].w * v[j].w); }
    const float r = rsqrtf(wave_sum(s) * (1.f / DM) + 1e-6f);
    u32x2* o8 = (u32x2*)orow + lane;
#pragma unroll
    for (int j = 0; j < 4; ++j) { u32x2 w; w.x = cvt_pk_bf16(v[j].x, v[j].y); w.y = cvt_pk_bf16(v[j].z, v[j].w); o8[64 * j] = w; }
    if (lane == 0) *rout = r;
}

__device__ __forceinline__ void moe_weight_item(const Params& P, unsigned char* ws, int le, int r, LAS float* scr, int lane) {
    bf16_t* w1t = (bf16_t*)(ws + WS_MW1T) + (size_t)le * 512 * 1024; bf16_t* wdt = (bf16_t*)(ws + WS_MWDT) + (size_t)le * 1024 * 256;
    if (r < 128) transpose_item(P.in[I_WGATE] + (size_t)le * 1024 * 256, 256, 256, w1t, 1024, 1, 0, scr, r / 8, r % 8, lane, P.in[I_MOENORM] + (le >> 4) * DM);
    else if (r < 256) transpose_item(P.in[I_WUP] + (size_t)le * 1024 * 256, 256, 256, w1t, 1024, 1, 128, scr, (r - 128) / 8, (r - 128) % 8, lane, P.in[I_MOENORM] + (le >> 4) * DM);
    else transpose_item(P.in[I_WDOWN] + (size_t)le * 256 * 1024, 1024, 1024, wdt, 256, 0, 0, scr, (r - 256) / 32, (r - 256) % 32, lane);
}
__device__ __forceinline__ void late_weight_items(Ctx& C, const Params& P, int rank, int nranks) {
    unsigned char* ws = P.ws; LAS float* scr = (LAS float*)(C.lds + C.wave * 16384);
    constexpr int IT_MOE0 = 16 * 384, IT_IN1 = 16 * 80, IT_OUT = 16 * 32, IT_C1 = 32 * 8;
    for (int it = rank * NWAVES + C.wave; it < IT_MOE0 + IT_IN1 + IT_OUT + 2 * IT_C1; it += nranks * NWAVES) {
        int r = it;
        if (r < IT_MOE0) { moe_weight_item(P, ws, r / 384, r % 384, scr, C.lane); continue; } r -= IT_MOE0;
        if (r < IT_IN1) { transpose_item(P.in[I_ODWIN], IN_ODD, IN_ODD, (bf16_t*)(ws + WS_WIN1T), DM, 0, 0, scr, r / 80, r % 80, C.lane, P.in[I_ODNORM]); continue; } r -= IT_IN1;
        if (r < IT_OUT) { transpose_item(P.in[I_ODWOUT], DM, DM, (bf16_t*)(ws + WS_WOUT1T), DM, 0, 0, scr, r / 32, r % 32, C.lane); continue; } r -= IT_OUT;
        { const int kv = r >= IT_C1, q = r - kv * IT_C1, hf = q >> 7, kb = (q >> 3) & 15, nb = q & 7;
          transpose_item(P.in[kv ? I_W1V : I_W1K] + (size_t)hf * 1024 * 256, 256, 256, (bf16_t*)(ws + WS_C1T) + (size_t)kv * 512 * 1024, 1024, 0, 256 * hf, scr, kb, nb, C.lane); }
    }
}
__device__ __forceinline__ void cplx_exp(float x, float y, float& re, float& im) {
    const float n = rintf(y * 0.15915494309189535f);
    float r = fmaf(-n, 6.28318548202514648f, y); r = fmaf(-n, -1.7484555e-7f, r);
    const float m = __expf(x); re = m * __cosf(r); im = m * __sinf(r);
}
__device__ __forceinline__ void phase_prep(Ctx& C, const Params& prm) {
    const Params& P = prm; unsigned char* ws = P.ws;
    LAS float* scr = (LAS float*)(C.lds + C.wave * 16384);
    const int gw = C.bid * NWAVES + C.wave, NGW = C.G * NWAVES;
    if (C.bid == 0) for (int i = C.tid; i < 4096; i += NTHREADS) ((unsigned*)(ws + WS_CTL))[i] = 0u;
    constexpr int IT_IN0 = 16 * 80, IT_OUT = 16 * 32, IT_GLU = 4 * 8;
    for (int it = gw; it < IT_IN0 + IT_OUT + IT_GLU; it += NGW) {
        int r = it;
        if (r < IT_IN0) { transpose_item(P.in[I_EVWIN], IN_EVEN, IN_EVEN, (bf16_t*)(ws + WS_WIN0T), DM, 2, 0, scr, r / 80, r % 80, C.lane, P.in[I_EVNORM]); continue; } r -= IT_IN0;
        if (r < IT_OUT) { transpose_item(P.in[I_EVWOUT], DM, DM, (bf16_t*)(ws + WS_WOUT0T), DM, 0, 0, scr, r / 32, r % 32, C.lane); continue; } r -= IT_OUT;
        transpose_item(P.in[I_WGLU], 256, 256, (bf16_t*)(ws + S5_GLUT), 256, 0, 0, scr, r / 8, r % 8, C.lane);
    }
    for (int m = gw; m < T; m += 2 * NGW) {
        const int m2 = m + NGW; const f32x4* xa = (const f32x4*)(P.in[I_X] + (size_t)m * DM) + 2 * C.lane; const f32x4* xb2 = (const f32x4*)(P.in[I_X] + (size_t)m2 * DM) + 2 * C.lane;
        f32x4 va[4], vb[4]; float sa = 0.f, sb = 0.f;
#pragma unroll
        for (int j = 0; j < 2; ++j) { va[2 * j] = xa[128 * j]; va[2 * j + 1] = xa[128 * j + 1]; vb[2 * j] = xb2[128 * j]; vb[2 * j + 1] = xb2[128 * j + 1]; }
#pragma unroll
        for (int j = 0; j < 4; ++j) { sa += (va[j].x * va[j].x + va[j].y * va[j].y) + (va[j].z * va[j].z + va[j].w * va[j].w); sb += (vb[j].x * vb[j].x + vb[j].y * vb[j].y) + (vb[j].z * vb[j].z + vb[j].w * vb[j].w); }
        u32x4* oa = (u32x4*)((bf16_t*)(ws + WS_XN) + (size_t)m * DM) + C.lane; u32x4* ob = (u32x4*)((bf16_t*)(ws + WS_XN) + (size_t)m2 * DM) + C.lane;
#pragma unroll
        for (int j = 0; j < 2; ++j) { u32x4 w; w.x = cvt_pk_bf16(va[2 * j].x, va[2 * j].y); w.y = cvt_pk_bf16(va[2 * j].z, va[2 * j].w); w.z = cvt_pk_bf16(va[2 * j + 1].x, va[2 * j + 1].y); w.w = cvt_pk_bf16(va[2 * j + 1].z, va[2 * j + 1].w); oa[64 * j] = w;
            w.x = cvt_pk_bf16(vb[2 * j].x, vb[2 * j].y); w.y = cvt_pk_bf16(vb[2 * j].z, vb[2 * j].w); w.z = cvt_pk_bf16(vb[2 * j + 1].x, vb[2 * j + 1].y); w.w = cvt_pk_bf16(vb[2 * j + 1].z, vb[2 * j + 1].w); ob[64 * j] = w; }
        sa = wave_sum(sa); sb = wave_sum(sb);
        if (C.lane == 0) { ((float*)(ws + WS_R0))[m] = rsqrtf(sa * (1.f / DM) + 1e-6f); ((float*)(ws + WS_R0))[m2] = rsqrtf(sb * (1.f / DM) + 1e-6f); }
    }
    { const int gt = C.bid * NTHREADS + C.tid;
      if (gt < 1024) { const int g = gt >> 6;
        const float lr = P.in[I_LAMRE][gt], li = P.in[I_LAMIM][gt], dt = __expf(P.in[I_LOGDT][g]);
        float are, aim; cplx_exp(lr * dt, li * dt, are, aim);
        const float den = lr * lr + li * li, fre = ((are - 1.f) * lr + aim * li) / den, fim = (aim * lr - (are - 1.f) * li) / den;
        ((f32x2*)(ws + WS_S5A))[gt] = (f32x2){are, aim};
        float* bb = (float*)(ws + WS_S5BB) + (size_t)gt * 32;
        for (int h = 0; h < 16; ++h) { const float br = P.in[I_BRE][(size_t)gt * 16 + h], bi = P.in[I_BIM][(size_t)gt * 16 + h]; bb[h] = fre * br - fim * bi; bb[16 + h] = fre * bi + fim * br; } }
    }
    for (int it = gw; it < 256; it += NGW) { const int kv = it >> 7, jg = (it >> 5) & 3, sl = it & 31; const float* pe = P.in[kv ? I_PEV : I_PEK] + sl * 64; const float* w1 = P.in[kv ? I_W1V : I_W1K] + (size_t)sl * 64 * 256 + jg * 64 + C.lane;
        float s = 0.f;
#pragma unroll 16
        for (int i = 0; i < 64; ++i) s += pe[i] * w1[(size_t)i * 256];
        ((float*)(ws + WS_C1BP))[((kv * 4 + jg) * 32 + sl) * 64 + C.lane] = s; }
    for (int i = C.bid * NTHREADS + C.tid; i < 16 * 65 * 64; i += C.G * NTHREADS) { const int pp = i & 63, k = (i >> 6) % 65, g = i / (65 * 64);
        const float lr = P.in[I_LAMRE][g * 64 + pp], li = P.in[I_LAMIM][g * 64 + pp], dt = __expf(P.in[I_LOGDT][g]); float re, im; cplx_exp(lr * dt * (float)k, li * dt * (float)k, re, im);
        ((f32x2*)(ws + S5_AP))[i] = (f32x2){re, im}; }
    { int* rt = (int*)(ws + WS_ROWTOK); for (int i = C.bid * NTHREADS + C.tid; i < MOE_MAXROWS; i += C.G * NTHREADS) rt[i] = -1; }
}

__device__ __forceinline__ void s5_load_u(const bf16_t* proj, int tok0, int g, LAS float* ubuf, int lane) {
    { const u32x4* src = (const u32x4*)(proj + (size_t)(tok0 + lane) * IN_EVEN + g * 16); const u32x4 a = src[0], b = src[1];
        LAS f32x4* d = (LAS f32x4*)(ubuf + lane * 16);
        d[0] = (f32x4){bf_lo(a.x), bf_hi(a.x), bf_lo(a.y), bf_hi(a.y)}; d[1] = (f32x4){bf_lo(a.z), bf_hi(a.z), bf_lo(a.w), bf_hi(a.w)};
        d[2] = (f32x4){bf_lo(b.x), bf_hi(b.x), bf_lo(b.y), bf_hi(b.y)}; d[3] = (f32x4){bf_lo(b.z), bf_hi(b.z), bf_lo(b.w), bf_hi(b.w)}; }
    LDS_WAIT();
}
__device__ __forceinline__ void phase_s5a_conv(Ctx& C, const Params& prm, int rank, int nranks) {
    const Params& P = prm; unsigned char* ws = P.ws;
    if (rank == 0) { const float* pp = (const float*)(ws + WS_C1BP) + ((C.tid >> 6) * 32) * 64 + (C.tid & 63); float s = 0.f;
        for (int q = 0; q < 32; ++q) s += pp[q * 64];
        ((float*)(ws + WS_C1B))[C.tid] = s; }
    const bf16_t* proj = (const bf16_t*)(ws + WS_PROJ);
    bf16_t* A2 = (bf16_t*)(ws + WS_A2);
    const float* cw = P.in[I_CONVW]; const float* cb = P.in[I_CONVB];
    for (int it = rank * NTHREADS + C.tid; it < (T / 32) * 96; it += nranks * NTHREADS) {
        const int cg8 = it % 96, tb = it / 96, c0 = cg8 * 8, tok0 = tb * 32, l0 = tok0 % SEQ;
        float w0[8], w1[8], w2[8], bb[8];
#pragma unroll
        for (int j = 0; j < 8; ++j) { w0[j] = cw[c0 + j]; w1[j] = cw[768 + c0 + j]; w2[j] = cw[1536 + c0 + j]; bb[j] = cb[c0 + j]; }
        float zm2[8], zm1[8];
#pragma unroll
        for (int j = 0; j < 8; ++j) { zm2[j] = 0.f; zm1[j] = 0.f; }
#pragma unroll 4
        for (int dt = -2; dt < 32; ++dt) {
            const int l = l0 + dt; if (l < 0) continue;
            const bf16_t* row = proj + (size_t)(tok0 + dt) * 1536;
            const u32x4 zw = *(const u32x4*)(row + c0);
            float z[8]; z[0] = bf_lo(zw.x); z[1] = bf_hi(zw.x); z[2] = bf_lo(zw.y); z[3] = bf_hi(zw.y); z[4] = bf_lo(zw.z); z[5] = bf_hi(zw.z); z[6] = bf_lo(zw.w); z[7] = bf_hi(zw.w);
            if (dt >= 0) { const u32x4 gb = *(const u32x4*)(row + 768 + c0); float gbf[8] = {bf_lo(gb.x), bf_hi(gb.x), bf_lo(gb.y), bf_hi(gb.y), bf_lo(gb.z), bf_hi(gb.z), bf_lo(gb.w), bf_hi(gb.w)};
                float y[8];
#pragma unroll
                for (int j = 0; j < 8; ++j) y[j] = gbf[j] * (w0[j] * zm2[j] + w1[j] * zm1[j] + w2[j] * z[j] + bb[j]);
                u32x4 o; o.x = cvt_pk_bf16(y[0], y[1]); o.y = cvt_pk_bf16(y[2], y[3]); o.z = cvt_pk_bf16(y[4], y[5]); o.w = cvt_pk_bf16(y[6], y[7]);
                *(u32x4*)(A2 + (size_t)(tok0 + dt) * DM + 256 + c0) = o; }
#pragma unroll
            for (int j = 0; j < 8; ++j) { zm2[j] = zm1[j]; zm1[j] = z[j]; }
        }
    }
}

__device__ __forceinline__ int pair_index(int a, int b) { return a == 0 ? (b - 1) : (a == 1 ? (b + 1) : 5); }
__device__ __forceinline__ void phase_moe_route(Ctx& C, const Params& prm, int layer) {
    const Params& P = prm; unsigned char* ws = P.ws;
    const bf16_t* hb = (const bf16_t*)(ws + WS_XN); const float* SS = (const float*)(ws + WS_SS); const float* g = P.in[I_MOENORM] + layer * DM;
    const float* wg = P.in[I_WGRP] + (size_t)layer * DM * 4; const float* we = P.in[I_WEXP] + (size_t)layer * DM * 16;
    const float* bg = P.in[I_BGRP] + layer * 4; const float* be = P.in[I_BEXP] + layer * 16;
    constexpr int RS = 1032;
    LAS bf16_t* Wh = (LAS bf16_t*)C.lds; LAS bf16_t* Wl = Wh + 20 * RS;
    LAS int* hist = (LAS int*)(C.lds + 2 * 20 * RS * 2);
    LAS int* tb = hist + 32;
    LAS int* tp = tb + 128;
    LAS int* gbase = tp + 128;
    const int lane = C.lane;
    { int* rt = (int*)(ws + WS_ROWTOK); for (int i = C.bid * NTHREADS + C.tid; i < MOE_MAXROWS; i += C.G * NTHREADS) rt[i] = -1; }
    for (int i = C.tid; i < DM * 4; i += NTHREADS) { const int k = i >> 2, n = i & 3; const float p = wg[i] * g[k]; const unsigned h = cvt_pk_bf16(p, 0.f) & 0xffffu;
        Wh[(16 + n) * RS + k] = (bf16_t)h; Wl[(16 + n) * RS + k] = (bf16_t)(cvt_pk_bf16(p - bf_lo(h), 0.f) & 0xffffu); }
    for (int i = C.tid; i < DM * 16; i += NTHREADS) { const int k = i >> 4, n = i & 15; const float p = we[i] * g[k]; const unsigned h = cvt_pk_bf16(p, 0.f) & 0xffffu;
        Wh[n * RS + k] = (bf16_t)h; Wl[n * RS + k] = (bf16_t)(cvt_pk_bf16(p - bf_lo(h), 0.f) & 0xffffu); }
    if (C.tid < 32) hist[C.tid] = 0;
    __syncthreads();
    const int rows_per_block = T / C.G;
    const int row0 = C.bid * rows_per_block;
    f32x4* toki = (f32x4*)(ws + WS_TOKI);
    const int fr = lane & 15, fq = lane >> 4;
    for (int rt0 = C.wave * 16; rt0 < rows_per_block; rt0 += NWAVES * 16) {
        const int lr = rt0 + fr, m = row0 + lr;
        const u32x4* xp = (const u32x4*)(hb + (size_t)m * DM) + fq;
        u32x4 xv[32];
#pragma unroll
        for (int kk = 0; kk < 32; ++kk) xv[kk] = xp[kk * 4];
        const f32x4 sq = *(const f32x4*)(SS + (size_t)m * 16 + fq * 4);
        const f32x4 bev = *(const f32x4*)(be + fq * 4);
        const LAS u32x4* whE = (const LAS u32x4*)(Wh + fr * RS) + fq; const LAS u32x4* wlE = (const LAS u32x4*)(Wl + fr * RS) + fq;
        const LAS u32x4* whG = (const LAS u32x4*)(Wh + (16 + (fr & 3)) * RS) + fq; const LAS u32x4* wlG = (const LAS u32x4*)(Wl + (16 + (fr & 3)) * RS) + fq;
        f32x4 aE = {0.f, 0.f, 0.f, 0.f}, aE2 = aE, aG = aE, aG2 = aE;
#pragma unroll
        for (int kk = 0; kk < 32; ++kk) { const bf16x8 xb = __builtin_bit_cast(bf16x8, xv[kk]);
            aE = __builtin_amdgcn_mfma_f32_16x16x32_bf16(__builtin_bit_cast(bf16x8, whE[kk * 4]), xb, aE, 0, 0, 0);
            aE2 = __builtin_amdgcn_mfma_f32_16x16x32_bf16(__builtin_bit_cast(bf16x8, wlE[kk * 4]), xb, aE2, 0, 0, 0);
            aG = __builtin_amdgcn_mfma_f32_16x16x32_bf16(__builtin_bit_cast(bf16x8, whG[kk * 4]), xb, aG, 0, 0, 0);
            aG2 = __builtin_amdgcn_mfma_f32_16x16x32_bf16(__builtin_bit_cast(bf16x8, wlG[kk * 4]), xb, aG2, 0, 0, 0); }
        float ssum = (sq[0] + sq[1]) + (sq[2] + sq[3]); ssum += __shfl_xor(ssum, 16); ssum += __shfl_xor(ssum, 32);
        const float r = rsqrtf(ssum * (1.f / DM) + 1e-6f);
        float gl[4], el[4];
#pragma unroll
        for (int n = 0; n < 4; ++n) { gl[n] = (aG[n] + aG2[n]) * r + bg[n]; el[n] = (aE[n] + aE2[n]) * r + bev[n]; }
        int gi = 0; float gm = gl[0];
#pragma unroll
        for (int n = 1; n < 4; ++n) if (gl[n] > gm) { gm = gl[n]; gi = n; }
        float gs = 0.f;
#pragma unroll
        for (int n = 0; n < 4; ++n) gs += __expf(gl[n] - gm);
        const float gwt = 1.f / gs;
        int e1 = 0; float v1 = el[0];
#pragma unroll
        for (int n = 1; n < 4; ++n) if (el[n] > v1) { v1 = el[n]; e1 = n; }
        int e2 = -1; float v2 = -3.0e38f;
#pragma unroll
        for (int n = 0; n < 4; ++n) if (n != e1 && (e2 < 0 || el[n] > v2)) { e2 = n; v2 = el[n]; }
        const float p2 = __expf(v2 - v1), w1 = gwt / (1.f + p2), w2 = gwt * p2 / (1.f + p2);
        const int ea = e1 < e2 ? e1 : e2, eb = e1 < e2 ? e2 : e1; const float wa = e1 < e2 ? w1 : w2, wb = e1 < e2 ? w2 : w1;
        if (fq == gi) {
            const int bucket = gi * 6 + pair_index(ea, eb);
            const int lp = __hip_atomic_fetch_add(&hist[bucket], 1, __ATOMIC_RELAXED, __HIP_MEMORY_SCOPE_WORKGROUP); tb[lr] = bucket; tp[lr] = lp;
            toki[m] = (f32x4){__int_as_float(bucket), 0.f, wa, wb}; ((float*)(ws + WS_R0))[m] = r; }
    }
    __syncthreads();
    unsigned* cnt = (unsigned*)(ws + WS_CTL) + CW_MOECNT + layer * 32;
    if (C.tid < 24) gbase[C.tid] = (int)atomicAdd(&cnt[C.tid], (unsigned)hist[C.tid]);
    __syncthreads();
    for (int lr = C.tid; lr < rows_per_block; lr += NTHREADS) ((int*)(toki + row0 + lr))[1] = gbase[tb[lr]] + tp[lr];
    __syncthreads();
}
struct MoeTab { int tiles_before[25]; };
__device__ __forceinline__ void moe_load_tab(const unsigned* cnt, LAS int* tabl, int tid) {
    if (tid < 64) { int tiles = 0; if (tid < 24) tiles = (int)((__hip_atomic_load(cnt + tid, __ATOMIC_RELAXED, __HIP_MEMORY_SCOPE_AGENT) + 255u) >> 8);
        int pre = tiles;
#pragma unroll
        for (int d = 1; d < 32; d <<= 1) { const int o = __shfl_up(pre, d); if ((tid & 63) >= d) pre += o; }
        if (tid < 24) tabl[tid] = pre - tiles;
        if (tid == 23) tabl[24] = pre; }
}
__device__ __forceinline__ void phase_moe_scatter(Ctx& C, const Params& prm, int layer) {
    const Params& P = prm; unsigned char* ws = P.ws;
    LAS int* tabl = (LAS int*)C.lds;
    moe_load_tab((const unsigned*)(ws + WS_CTL) + CW_MOECNT + layer * 32, tabl, C.tid);
    __syncthreads();
    const f32x4* toki = (const f32x4*)(ws + WS_TOKI); int* rt = (int*)(ws + WS_ROWTOK); f32x4* wrow = (f32x4*)(ws + WS_WROW); const float* rr = (const float*)(ws + WS_R0);
    for (int t = C.bid * NTHREADS + C.tid; t < T; t += C.G * NTHREADS) { const f32x4 ti = toki[t]; const int bucket = __float_as_int(ti.x), pos = __float_as_int(ti.y);
        const int r = tabl[bucket] * 256 + pos; rt[r] = t; wrow[r] = (f32x4){ti.z, ti.w, rr[t], 0.f}; }
    __syncthreads();
}
namespace pg8 {
struct MoeSched {
    const LAS int* tabl; int G, c, mode; unsigned* ready;
    unsigned* q; LAS int* tk;
    __device__ bool decode(int L, Unit& u) const {
        const int tile = L >> 2, pn = L & 3; int b = 0;
        for (int qq = 1; qq < 24; ++qq) if (tile >= tabl[qq]) b = qq;
        const int grp = b / 6, pr = b % 6; const int ea = pr < 3 ? 0 : (pr < 5 ? 1 : 2), eb = pr < 3 ? pr + 1 : (pr < 5 ? pr - 1 : 3);
        u.arow = tile * 256; u.pn = pn; u.nt = mode == 0 ? 16 : 8;
        if (mode == 0) { const int e = grp * 4 + (pn < 2 ? ea : eb); u.b0 = (e * 512 + (pn & 1) * 256) * 1024 * 2; u.b1 = u.b0; }
        else { u.b0 = ((grp * 4 + ea) * 1024 + pn * 256) * 256 * 2; u.b1 = ((grp * 4 + eb) * 1024 + pn * 256) * 256 * 2 - 4 * 128; }
        return true;
    }
    __device__ bool next(int i, Unit& u) const {
        const int nun = tabl[24] * 4; int s;
        if (i == 0 && mode == 1) s = tk[1];
        else { if (threadIdx.x == 0) tk[0] = (int)atomicAdd(q, 1u);
               asm volatile("s_waitcnt lgkmcnt(0)" ::: "memory"); __builtin_amdgcn_s_barrier(); asm volatile("" ::: "memory"); s = tk[0]; }
        s = __builtin_amdgcn_readfirstlane(s);
        const int L = s - mode * nun;
        if (L >= nun) { if (threadIdx.x == 0) tk[1] = s; asm volatile("s_waitcnt lgkmcnt(0)" ::: "memory"); return false; }
        return decode(L, u);
    }
    __device__ __forceinline__ void done(const Unit& u) const {
        if (mode == 0) { asm volatile("s_waitcnt vmcnt(0)" ::: "memory");
            if ((threadIdx.x & 63) == 0) __hip_atomic_fetch_add(ready + (u.arow >> 8), 1u, __ATOMIC_RELAXED, __HIP_MEMORY_SCOPE_AGENT); } }
    __device__ __forceinline__ void a_ready(const Unit& u) const {
        if (mode == 1) {
            if (threadIdx.x < 64) {
                unsigned spins = 0;
                while ((unsigned)__builtin_amdgcn_readfirstlane((int)__hip_atomic_load(ready + (u.arow >> 8), __ATOMIC_RELAXED, __HIP_MEMORY_SCOPE_AGENT)) < 32u) { __builtin_amdgcn_s_sleep(2); if (++spins > (1u << 24)) break; }
                __builtin_amdgcn_fence(__ATOMIC_ACQUIRE, "agent");
                asm volatile("s_waitcnt vmcnt(0)" ::: "memory");
            }
            asm volatile("" ::: "memory"); __builtin_amdgcn_s_barrier(); asm volatile("" ::: "memory");
        } }
};
struct EpiSwiGLU {
    static constexpr bool PERM = true;
    bf16_t* H; const f32x4* wrow;
    __device__ __forceinline__ void operator()(const f32x4 (&acc)[2][2][4][2], const Unit& u, int wr, int wc, int fr, int fq) const {
        const int row0 = u.arow + wr * 64 + fr, slot = u.pn >> 1, col0 = slot * 256 + (u.pn & 1) * 128 + wc * 32 + 8 * fq;
        float wtv[2][4], rsv[2][4];
#pragma unroll
        for (int ai = 0; ai < 2; ++ai)
#pragma unroll
            for (int m = 0; m < 4; ++m) { const f32x4 w2 = wrow[row0 + ai * HALF + m * 16]; wtv[ai][m] = slot ? w2.y : w2.x; rsv[ai][m] = w2.z; }
#pragma unroll
        for (int ai = 0; ai < 2; ++ai)
#pragma unroll
            for (int m = 0; m < 4; ++m) { const int row = row0 + ai * HALF + m * 16; const float wt = wtv[ai][m], rs = rsv[ai][m];
                float o[8];
#pragma unroll
                for (int n = 0; n < 2; ++n)
#pragma unroll
                    for (int j = 0; j < 4; ++j) { const float gv = acc[ai][0][m][n][j] * rs, uv = acc[ai][1][m][n][j] * rs; o[4 * n + j] = gv * sigmoidf_(gv) * uv * wt; }
                u32x4 w; w.x = cvt_pk_bf16(o[0], o[1]); w.y = cvt_pk_bf16(o[2], o[3]); w.z = cvt_pk_bf16(o[4], o[5]); w.w = cvt_pk_bf16(o[6], o[7]);
                unsigned long long* hp = (unsigned long long*)(H + (size_t)row * 512 + col0);
                __hip_atomic_store(hp, ((unsigned long long)w.y << 32) | w.x, __ATOMIC_RELAXED, __HIP_MEMORY_SCOPE_AGENT); __hip_atomic_store(hp + 1, ((unsigned long long)w.w << 32) | w.z, __ATOMIC_RELAXED, __HIP_MEMORY_SCOPE_AGENT); }
    }
};
template <bool FINAL> struct EpiScatterResB;
template <> struct EpiScatterResB<false> {
    static constexpr bool PERM = true;
    float* outf; bf16_t* hb; float* SS; const int* rowtok;
    __device__ __forceinline__ void operator()(const f32x4 (&acc)[2][2][4][2], const Unit& u, int wr, int wc, int fr, int fq) const {
        const int row0 = u.arow + wr * 64 + fr, col0 = u.pn * BM + wc * 32 + 8 * fq;
        int toks[2][4];
#pragma unroll
        for (int ai = 0; ai < 2; ++ai)
#pragma unroll
            for (int m = 0; m < 4; ++m) toks[ai][m] = rowtok[row0 + ai * HALF + m * 16];
        u32x4 bw[2][4][2];
#pragma unroll
        for (int ai = 0; ai < 2; ++ai)
#pragma unroll
            for (int m = 0; m < 4; ++m) { const int tk = toks[ai][m] < 0 ? 0 : toks[ai][m]; const size_t off = (size_t)tk * DM + col0;
#pragma unroll
                for (int bj = 0; bj < 2; ++bj) bw[ai][m][bj] = *(const u32x4*)(hb + off + bj * HALF); }
#pragma unroll
        for (int ai = 0; ai < 2; ++ai)
#pragma unroll
            for (int m = 0; m < 4; ++m) { const int tok = toks[ai][m]; const int tk = tok < 0 ? 0 : tok; const size_t off = (size_t)tk * DM + col0; f32x4 v[2][2];
#pragma unroll
                for (int bj = 0; bj < 2; ++bj) { const u32x4 w = bw[ai][m][bj];
                    v[bj][0] = (f32x4){bf_lo(w.x), bf_hi(w.x), bf_lo(w.y), bf_hi(w.y)} + acc[ai][bj][m][0]; v[bj][1] = (f32x4){bf_lo(w.z), bf_hi(w.z), bf_lo(w.w), bf_hi(w.w)} + acc[ai][bj][m][1];
                    if (tok >= 0) { u32x4 o; o.x = cvt_pk_bf16(v[bj][0][0], v[bj][0][1]); o.y = cvt_pk_bf16(v[bj][0][2], v[bj][0][3]); o.z = cvt_pk_bf16(v[bj][1][0], v[bj][1][1]); o.w = cvt_pk_bf16(v[bj][1][2], v[bj][1][3]);
                        *(u32x4*)(hb + off + bj * HALF) = o; } }
                const float ss = row_sumsq16(v[0][0], v[0][1], v[1][0], v[1][1]); if (fq == 0 && tok >= 0) SS[(size_t)tok * 16 + u.pn * 4 + wc] = ss; }
    }
};
template <> struct EpiScatterResB<true> {
    static constexpr bool FINAL = true;
    static constexpr bool PERM = false;
    float* outf; bf16_t* hb; float* SS; const int* rowtok;
    __device__ __forceinline__ void operator()(const f32x4 (&acc)[2][2][4][2], const Unit& u, int wr, int wc, int fr, int fq) const {
        const int row0 = u.arow + wr * 64 + fr, col0 = u.pn * BM + wc * 32 + 4 * fq;
        int toks[2][4];
#pragma unroll
        for (int ai = 0; ai < 2; ++ai)
#pragma unroll
            for (int m = 0; m < 4; ++m) toks[ai][m] = rowtok[row0 + ai * HALF + m * 16];
        u32x2 bw[2][4][2][2];
#pragma unroll
        for (int ai = 0; ai < 2; ++ai)
#pragma unroll
            for (int m = 0; m < 4; ++m) { const int tk = toks[ai][m] < 0 ? 0 : toks[ai][m]; const size_t off = (size_t)tk * DM + col0;
#pragma unroll
                for (int bj = 0; bj < 2; ++bj)
#pragma unroll
                    for (int n = 0; n < 2; ++n) bw[ai][m][bj][n] = *(const u32x2*)(hb + off + bj * HALF + n * 16); }
#pragma unroll
        for (int ai = 0; ai < 2; ++ai)
#pragma unroll
            for (int m = 0; m < 4; ++m) { const int tok = toks[ai][m]; const int tk = tok < 0 ? 0 : tok; const size_t off = (size_t)tk * DM + col0; f32x4 v[2][2];
#pragma unroll
                for (int bj = 0; bj < 2; ++bj)
#pragma unroll
                    for (int n = 0; n < 2; ++n) { const u32x2 w = bw[ai][m][bj][n]; v[bj][n] = (f32x4){bf_lo(w.x), bf_hi(w.x), bf_lo(w.y), bf_hi(w.y)} + acc[ai][bj][m][n];
                        if (tok >= 0) { if (FINAL) *(f32x4*)(outf + off + bj * HALF + n * 16) = v[bj][n];
                            else { u32x2 o; o.x = cvt_pk_bf16(v[bj][n][0], v[bj][n][1]); o.y = cvt_pk_bf16(v[bj][n][2], v[bj][n][3]); *(u32x2*)(hb + off + bj * HALF + n * 16) = o; } } }
                if (!FINAL) { const float ss = row_sumsq16(v[0][0], v[0][1], v[1][0], v[1][1]); if (fq == 0 && tok >= 0) SS[(size_t)tok * 16 + u.pn * 4 + wc] = ss; } }
    }
};
}
constexpr size_t HD_PLANE = (size_t)SEQ * 64 * 2;
constexpr size_t AT_QM   = WS_ATT;
constexpr size_t AT_KM   = AT_QM + 8 * HD_PLANE;
constexpr size_t AT_VM   = AT_KM + 8 * HD_PLANE;
constexpr size_t AT_KSEL = AT_VM + 8 * HD_PLANE;
constexpr size_t AT_VSEL = AT_KSEL + 4 * HD_PLANE;
constexpr size_t AT_KWIN = AT_VSEL + 4 * HD_PLANE;
constexpr size_t AT_VWIN = AT_KWIN + 4 * HD_PLANE;
constexpr size_t AT_KC   = AT_VWIN + 4 * HD_PLANE;
constexpr size_t AT_VC   = AT_KC + (size_t)(4096 + 8) * 2048;
constexpr size_t AT_GATES= AT_VC + (size_t)(4096 + 8) * 2048;
constexpr size_t AT_KMSUM= AT_GATES + (size_t)T * 36 * 4;
constexpr size_t AT_KMMEAN = AT_KMSUM + (size_t)NB * 4 * 256 * 64 * 4;
constexpr size_t AT_HC   = AT_KMMEAN + (size_t)NB * 4 * 64 * 64 * 4;
constexpr size_t AT_KCMP = AT_HC + (size_t)2 * (4096 + 8) * 512 * 2;
constexpr size_t AT_VCMP = AT_KCMP + (size_t)4 * 1024 * 64 * 2;
constexpr size_t AT_VMT  = AT_VCMP + (size_t)4 * 1024 * 64 * 2;
constexpr size_t AT_VSELT= AT_VMT + 8 * HD_PLANE;
constexpr size_t AT_VWINT= AT_VSELT + 4 * HD_PLANE;
constexpr size_t AT_VCMPT= AT_VWINT + 4 * HD_PLANE;
constexpr size_t AT_END  = AT_VCMPT + (size_t)4 * 16 * 64 * 64 * 2;
constexpr size_t AT_KMB    = AT_END;
constexpr size_t AT_SELIDX = AT_KMB + (size_t)NB * 4 * 64 * 64 * 2;
constexpr size_t AT_END2   = AT_SELIDX + (size_t)NB * 2 * SEQ * 8;
static_assert(AT_END2 <= WS_END, "workspace");
static_assert(AT_END <= WS_END, "attention tensors overflow the workspace plan");

__device__ __forceinline__ int odd_slice_mode(int s) { return s < 8 ? 2 : s < 12 ? 0 : s < 24 ? 2 : s < 28 ? 1 : s < 30 ? 2 : s < 32 ? 0 : s < 34 ? 2 : 0; }
namespace pg8 {
struct EpiOdd {
    static constexpr bool PERM = true;
    bf16_t* O; int ldc; const LAS float* rl; LAS float* xl; unsigned char* ws; unsigned char* outb;
    const float* gMQ; const float* gMK; const float* gNQ; const float* gKS; const float* gKW;
    __device__ __forceinline__ void operator()(const f32x4 (&acc)[2][2][4][2], const Unit& u, int wr, int wc, int fr, int fq) const {
        asm volatile("" : "+v"(fr), "+v"(fq));
        const int lr0 = wr * 64 + fr, c64 = (wc & 1) * 32 + 8 * fq; const LAS float* rp = rl + u.aux * 256 + lr0;
        const int b = u.arow / SEQ, lu = u.arow % SEQ;
#pragma unroll
        for (int bj = 0; bj < 2; ++bj) { const int s = u.pn * 4 + bj * 2 + (wc >> 1);
            if (odd_slice_mode(s) == 2) {
#pragma unroll
                for (int ai = 0; ai < 2; ++ai)
#pragma unroll
                    for (int m = 0; m < 4; ++m) { const int lrow = lr0 + ai * HALF + m * 16; const float r = rp[ai * HALF + m * 16]; const f32x4 v0 = acc[ai][bj][m][0] * r, v1 = acc[ai][bj][m][1] * r;
                        float ss = ((v0[0] * v0[0] + v0[1] * v0[1]) + (v0[2] * v0[2] + v0[3] * v0[3])) + ((v1[0] * v1[0] + v1[1] * v1[1]) + (v1[2] * v1[2] + v1[3] * v1[3]));
                        ss += __shfl_xor(ss, 16); ss += __shfl_xor(ss, 32);
                        if (fq == 0) xl[(lrow * 2 + bj) * 4 + wc] = ss; __builtin_amdgcn_sched_barrier(0); } } }
        asm volatile("s_waitcnt lgkmcnt(0)" ::: "memory"); __builtin_amdgcn_s_barrier(); asm volatile("" ::: "memory");
#pragma unroll
        for (int bj = 0; bj < 2; ++bj) { const int s = u.pn * 4 + bj * 2 + (wc >> 1), mode = odd_slice_mode(s);
            if (mode == 0) {
#pragma unroll
                for (int ai = 0; ai < 2; ++ai)
#pragma unroll
                    for (int m = 0; m < 4; ++m) { const int row = u.arow + lr0 + ai * HALF + m * 16; float r = rp[ai * HALF + m * 16]; asm volatile("" : "+v"(r)); const f32x4 v0 = acc[ai][bj][m][0] * r, v1 = acc[ai][bj][m][1] * r;
                        u32x4 w; w.x = cvt_pk_bf16(v0[0], v0[1]); w.y = cvt_pk_bf16(v0[2], v0[3]); w.z = cvt_pk_bf16(v1[0], v1[1]); w.w = cvt_pk_bf16(v1[2], v1[3]);
                        *(u32x4*)(O + (size_t)row * ldc + u.pn * BM + bj * HALF + wc * 32 + 8 * fq) = w; __builtin_amdgcn_sched_barrier(0); }
            } else {
                unsigned char* sbase; size_t pitch = 128; const float* gain = nullptr; float extra = 1.f;
                if (s < 4) { sbase = ws + AT_QM + ((size_t)(b * 4 + s) * SEQ + lu) * 128; gain = gMQ; extra = 0.125f * 1.4426950408889634f; }
                else if (s < 8) { sbase = ws + AT_KM + ((size_t)(b * 4 + (s - 4)) * SEQ + lu) * 128; gain = gMK; }
                else if (s < 24) { const int hg = s - 12, hk = hg / 6, g = hg % 6; sbase = outb + (((size_t)(b * 2 + hk) * SEQ + lu) * 6 + g) * 128; pitch = 768; gain = gNQ; extra = 0.125f * 1.4426950408889634f; }
                else { const int kind = (s - 24) >> 1, hk = (s - 24) & 1; const size_t po = ((size_t)(b * 2 + hk) * SEQ + lu) * 128;
                    sbase = ws + (kind == 0 ? AT_KC : kind == 1 ? AT_VC : kind == 2 ? AT_KSEL : AT_KWIN) + po; gain = kind == 2 ? gKS : kind == 4 ? gKW : nullptr; }
                f32x4 g0 = (f32x4){1.f, 1.f, 1.f, 1.f}, g1 = g0;
                if (mode == 2) { g0 = *(const f32x4*)(gain + c64) * extra; g1 = *(const f32x4*)(gain + c64 + 4) * extra; }
#pragma unroll
                for (int ai = 0; ai < 2; ++ai) { f32x4 cs0 = (f32x4){0.f, 0.f, 0.f, 0.f}, cs1 = cs0;
#pragma unroll
                    for (int m = 0; m < 4; ++m) { const int lrow = lr0 + ai * HALF + m * 16; float r = rp[ai * HALF + m * 16]; asm volatile("" : "+v"(r));
                        f32x4 v0 = acc[ai][bj][m][0] * r, v1 = acc[ai][bj][m][1] * r;
                        if (mode == 2) { const float tot = xl[(lrow * 2 + bj) * 4 + (wc & 2)] + xl[(lrow * 2 + bj) * 4 + (wc & 2) + 1]; const float rs = rsqrtf(tot * (1.f / 64.f) + 1e-6f);
                            v0 = v0 * rs * g0; v1 = v1 * rs * g1; }
                        u32x4 w; w.x = cvt_pk_bf16(v0[0], v0[1]); w.y = cvt_pk_bf16(v0[2], v0[3]); w.z = cvt_pk_bf16(v1[0], v1[1]); w.w = cvt_pk_bf16(v1[2], v1[3]);
                        *(u32x4*)(sbase + (size_t)lrow * pitch + c64 * 2) = w;
                        cs0 += v0; cs1 += v1; __builtin_amdgcn_sched_barrier(0); }
                    if (s >= 4 && s < 8) {
#pragma unroll
                        for (int e = 0; e < 4; ++e) { float a0 = cs0[e], a1 = cs1[e];
                            a0 += __shfl_xor(a0, 1); a0 += __shfl_xor(a0, 2); a0 += __shfl_xor(a0, 4); a0 += __shfl_xor(a0, 8);
                            a1 += __shfl_xor(a1, 1); a1 += __shfl_xor(a1, 2); a1 += __shfl_xor(a1, 4); a1 += __shfl_xor(a1, 8); cs0[e] = a0; cs1[e] = a1; }
                        if (fr == 0) { float* kp = (float*)(ws + AT_KMSUM) + ((size_t)(b * 4 + (s - 4)) * 256 + ((lu + wr * 64 + ai * HALF) >> 6)) * 64 + c64; *(f32x4*)kp = cs0; *(f32x4*)(kp + 4) = cs1; } } }
            } }
    }
};
}
__device__ __forceinline__ void load_slice(const bf16_t* p, float (&v)[64]) {
    const u32x4* s = (const u32x4*)p;
#pragma unroll
    for (int q = 0; q < 8; ++q) { const u32x4 w = s[q]; v[8 * q] = bf_lo(w.x); v[8 * q + 1] = bf_hi(w.x); v[8 * q + 2] = bf_lo(w.y); v[8 * q + 3] = bf_hi(w.y); v[8 * q + 4] = bf_lo(w.z); v[8 * q + 5] = bf_hi(w.z); v[8 * q + 6] = bf_lo(w.w); v[8 * q + 7] = bf_hi(w.w); }
}
__device__ __forceinline__ void store_slice(bf16_t* p, const float (&v)[64]) {
    u32x4* d = (u32x4*)p;
#pragma unroll
    for (int q = 0; q < 8; ++q) { u32x4 w; w.x = cvt_pk_bf16(v[8 * q], v[8 * q + 1]); w.y = cvt_pk_bf16(v[8 * q + 2], v[8 * q + 3]); w.z = cvt_pk_bf16(v[8 * q + 4], v[8 * q + 5]); w.w = cvt_pk_bf16(v[8 * q + 6], v[8 * q + 7]); d[q] = w; }
}
__device__ __forceinline__ void head_norm(float (&v)[64], const float* gain, float extra) {
    { int z = 0; asm volatile("" : "+v"(z)); gain += z; }
    float s = 0.f;
#pragma unroll
    for (int i = 0; i < 64; ++i) s += v[i] * v[i];
    const float r = rsqrtf(s * (1.f / 64.f) + 1e-6f) * extra;
#pragma unroll
    for (int i = 0; i < 64; ++i) v[i] = v[i] * r * gain[i];
}
__device__ __forceinline__ void phase_post1(Ctx& C, const Params& prm, int rank, int nranks) {
    unsigned char* ws = prm.ws; const bf16_t* proj = (const bf16_t*)(ws + WS_PROJ);
    const int gw = rank * NWAVES + C.wave, NGW = nranks * NWAVES, lane = C.lane, rr = lane >> 3, c = lane & 7;
    LAS bf16_t* tl = (LAS bf16_t*)(C.lds + C.wave * 9216);
    for (int it = gw; it < (T / 64) * 9; it += NGW) {
        const int q9 = it % 9, s = q9 < 4 ? 8 + q9 : (q9 < 6 ? 26 + q9 : (q9 < 8 ? 28 + q9 : 36)), ci = it / 9, tok0 = ci * 64, b = tok0 / SEQ, l0 = tok0 % SEQ;
        if (s == 36) {
            const int tok = tok0 + lane; const u32x4* gp = (const u32x4*)(proj + (size_t)tok * IN_ODD_P + 2304); float g[40];
#pragma unroll
            for (int q = 0; q < 5; ++q) { const u32x4 w = gp[q]; g[8 * q] = bf_lo(w.x); g[8 * q + 1] = bf_hi(w.x); g[8 * q + 2] = bf_lo(w.y); g[8 * q + 3] = bf_hi(w.y); g[8 * q + 4] = bf_lo(w.z); g[8 * q + 5] = bf_hi(w.z); g[8 * q + 6] = bf_lo(w.w); g[8 * q + 7] = bf_hi(w.w); }
            f32x4* o = (f32x4*)((float*)(ws + AT_GATES) + (size_t)tok * 36);
#pragma unroll
            for (int q = 0; q < 9; ++q) o[q] = (f32x4){sigmoidf_(g[4 * q]), sigmoidf_(g[4 * q + 1]), sigmoidf_(g[4 * q + 2]), sigmoidf_(g[4 * q + 3])};
            continue;
        }
        size_t dst = 0; size_t pitch = 128; const float* gain = nullptr; float extra = 1.f; bool qn = false, tr = false;
        if (s < 4) { dst = AT_QM + ((size_t)(b * 4 + s) * SEQ + l0) * 128; gain = prm.in[I_MQN]; extra = 0.125f * 1.4426950408889634f; }
        else if (s < 8) { dst = AT_KM + ((size_t)(b * 4 + (s - 4)) * SEQ + l0) * 128; gain = prm.in[I_MKN]; }
        else if (s < 12) { dst = AT_VMT + ((size_t)(b * 4 + (s - 8)) * 256 + (l0 >> 6)) * 8192; tr = true; }
        else if (s < 24) { const int hg = s - 12, hk = hg / 6, g = hg % 6; dst = (((size_t)(b * 2 + hk) * SEQ + l0) * 6 + g) * 128; pitch = 768; qn = true; gain = prm.in[I_NQN]; extra = 0.125f * 1.4426950408889634f; }
        else { const int kind = (s - 24) >> 1, hk = (s - 24) & 1; const size_t po = ((size_t)(b * 2 + hk) * SEQ + l0) * 128, tb = ((size_t)(b * 2 + hk) * 256 + (l0 >> 6)) * 8192;
            if (kind == 0) dst = AT_KC + po; else if (kind == 1) dst = AT_VC + po; else if (kind == 2) { dst = AT_KSEL + po; gain = prm.in[I_NKSN]; }
            else if (kind == 3) { dst = AT_VSELT + tb; tr = true; } else if (kind == 4) { dst = AT_KWIN + po; gain = prm.in[I_NKWN]; } else { dst = AT_VWINT + tb; tr = true; } }
        float v[8][8];
        { const bf16_t* src = proj + (size_t)(tok0 + rr) * IN_ODD_P + 64 * s + 8 * c;
#pragma unroll
          for (int i = 0; i < 8; ++i) { const u32x4 w = *(const u32x4*)(src + (size_t)i * 8 * IN_ODD_P);
              v[i][0] = bf_lo(w.x); v[i][1] = bf_hi(w.x); v[i][2] = bf_lo(w.y); v[i][3] = bf_hi(w.y); v[i][4] = bf_lo(w.z); v[i][5] = bf_hi(w.z); v[i][6] = bf_lo(w.w); v[i][7] = bf_hi(w.w); } }
        if (gain) { float gg[8];
#pragma unroll
            for (int e = 0; e < 8; ++e) gg[e] = gain[8 * c + e] * extra;
#pragma unroll
            for (int i = 0; i < 8; ++i) { float ss = 0.f;
#pragma unroll
                for (int e = 0; e < 8; ++e) ss += v[i][e] * v[i][e];
                ss += __shfl_xor(ss, 1); ss += __shfl_xor(ss, 2); ss += __shfl_xor(ss, 4);
                const float rs = rsqrtf(ss * (1.f / 64.f) + 1e-6f);
#pragma unroll
                for (int e = 0; e < 8; ++e) v[i][e] = v[i][e] * rs * gg[e]; } }
        unsigned char* obase = (qn ? (unsigned char*)prm.out : ws) + dst;
        if (!tr) {
#pragma unroll
            for (int i = 0; i < 8; ++i) { u32x4 w; w.x = cvt_pk_bf16(v[i][0], v[i][1]); w.y = cvt_pk_bf16(v[i][2], v[i][3]); w.z = cvt_pk_bf16(v[i][4], v[i][5]); w.w = cvt_pk_bf16(v[i][6], v[i][7]);
                *(u32x4*)(obase + (size_t)(i * 8 + rr) * pitch + 16 * c) = w; }
        } else {
            LDS_WAIT();
#pragma unroll
            for (int i = 0; i < 8; ++i)
#pragma unroll
                for (int e = 0; e < 8; ++e) tl[(8 * c + e) * 72 + i * 8 + rr] = f2bf(v[i][e]);
            LDS_WAIT();
#pragma unroll
            for (int i = 0; i < 8; ++i) { const int d = i * 8 + rr; const u32x4 w = *(const LAS u32x4*)(tl + d * 72 + 8 * c); *(u32x4*)(obase + (size_t)d * 128 + 16 * c) = w; }
        }
        if (s >= 4 && s < 8) {
            float cs[8];
#pragma unroll
            for (int e = 0; e < 8; ++e) { float a = 0.f;
#pragma unroll
                for (int i = 0; i < 8; ++i) a += v[i][e];
                a += __shfl_xor(a, 8); a += __shfl_xor(a, 16); a += __shfl_xor(a, 32); cs[e] = a; }
            if (rr == 0) { float* kp = (float*)(ws + AT_KMSUM) + ((size_t)(b * 4 + (s - 4)) * 256 + (l0 >> 6)) * 64 + 8 * c;
                *(f32x4*)kp = (f32x4){cs[0], cs[1], cs[2], cs[3]}; *(f32x4*)(kp + 4) = (f32x4){cs[4], cs[5], cs[6], cs[7]}; }
        }
    }
    for (int i = rank * NTHREADS + C.tid; i < 2 * 8 * 1024 / 2; i += nranks * NTHREADS) { const int kv = i / (8 * 512), o = i % (8 * 512);
        ((unsigned*)(ws + (kv ? AT_VC : AT_KC) + (size_t)4096 * 2048))[o] = 0u; }
}
__device__ __forceinline__ void kmmean_items(Ctx& C, const Params& prm) {
    unsigned char* ws = prm.ws; const float* ks = (const float*)(ws + AT_KMSUM); float* km = (float*)(ws + AT_KMMEAN);
    for (int i = C.bid * NTHREADS + C.tid; i < NB * 4 * 64 * 64; i += C.G * NTHREADS) { const int d = i & 63, j = (i >> 6) & 63, bh = i >> 12;
        const float* p = ks + ((size_t)bh * 256 + 4 * j) * 64 + d; const float mv = ((p[0] + p[64]) + (p[128] + p[192])) * (1.f / 256.f); km[i] = mv; ((bf16_t*)(ws + AT_KMB))[i] = f2bf(mv); }
}
namespace pg8 {
struct C1Sched { int G, c;
    __device__ bool next(int i, Unit& u) const { const int L = i * G + c; if (L >= 64) return false; const int kv = L >> 5, tile = (L >> 1) & 15, pn = L & 1;
        u.arow = kv * (4096 + 8) + tile * 256; u.pn = pn; u.b0 = (kv * 512 + pn * 256) * 1024 * 2; u.b1 = u.b0; u.nt = 16; return true; } };
}
__device__ __forceinline__ void phase_c2(Ctx& C, const Params& prm) {
    unsigned char* ws = prm.ws; const int lane = C.lane, fr = lane & 15, fq = lane >> 4, tile = C.bid * NWAVES + C.wave;
    if (C.bid >= 64) return;
    const int kv = C.bid >> 5;
    constexpr int WS2 = 264;
    LAS bf16_t* w2t = (LAS bf16_t*)C.lds;
    { const float* w2 = prm.in[kv ? I_W2V : I_W2K];
      for (int i = C.tid; i < 256 * 64; i += NTHREADS) { const int k = i >> 6, n = i & 63; w2t[n * WS2 + k] = f2bf(w2[i]); } }
    __syncthreads();
    const int r0 = tile * 16, rr0 = r0 & 4095, row = rr0 + fr, n = row & 1023;
    const bf16_t* p0 = (const bf16_t*)(ws + AT_HC) + ((size_t)kv * (4096 + 8) + row) * 512 + fq * 8; const bf16_t* p1 = p0 + 512 + 256;
    const float* b1 = (const float*)(ws + WS_C1B) + kv * 256 + fq * 8;
    u32x4 ha[8], hc[8];
#pragma unroll
    for (int kk = 0; kk < 8; ++kk) { ha[kk] = *(const u32x4*)(p0 + kk * 32); hc[kk] = *(const u32x4*)(p1 + kk * 32); }
    f32x4 acc[4];
#pragma unroll
    for (int nt = 0; nt < 4; ++nt) acc[nt] = (f32x4){0.f, 0.f, 0.f, 0.f};
#pragma unroll
    for (int kk = 0; kk < 8; ++kk) {
        const f32x4 ba = *(const f32x4*)(b1 + kk * 32), bb = *(const f32x4*)(b1 + kk * 32 + 4); const u32x4 a = ha[kk], c = hc[kk];
        u32x4 hw;
        hw.x = cvt_pk_bf16(gelu_tanh(bf_lo(a.x) + bf_lo(c.x) + ba.x), gelu_tanh(bf_hi(a.x) + bf_hi(c.x) + ba.y));
        hw.y = cvt_pk_bf16(gelu_tanh(bf_lo(a.y) + bf_lo(c.y) + ba.z), gelu_tanh(bf_hi(a.y) + bf_hi(c.y) + ba.w));
        hw.z = cvt_pk_bf16(gelu_tanh(bf_lo(a.z) + bf_lo(c.z) + bb.x), gelu_tanh(bf_hi(a.z) + bf_hi(c.z) + bb.y));
        hw.w = cvt_pk_bf16(gelu_tanh(bf_lo(a.w) + bf_lo(c.w) + bb.z), gelu_tanh(bf_hi(a.w) + bf_hi(c.w) + bb.w));
        const bf16x8 hb8 = __builtin_bit_cast(bf16x8, hw);
#pragma unroll
        for (int nt = 0; nt < 4; ++nt) { const bf16x8 wf = *(const LAS bf16x8*)(w2t + (nt * 16 + fr) * WS2 + kk * 32 + fq * 8);
            acc[nt] = __builtin_amdgcn_mfma_f32_16x16x32_bf16(wf, hb8, acc[nt], 0, 0, 0); }
    }
    if (n == 1023) return;
    if (kv == 0) { float ss = 0.f;
#pragma unroll
        for (int nt = 0; nt < 4; ++nt) ss += (acc[nt][0] * acc[nt][0] + acc[nt][1] * acc[nt][1]) + (acc[nt][2] * acc[nt][2] + acc[nt][3] * acc[nt][3]);
        ss += __shfl_xor(ss, 16); ss += __shfl_xor(ss, 32);
        const float rs = rsqrtf(ss * (1.f / 64.f) + 1e-6f);
#pragma unroll
        for (int nt = 0; nt < 4; ++nt) { const f32x4 gn = *(const f32x4*)(prm.in[I_NKCN] + nt * 16 + 4 * fq); const f32x4 v = acc[nt] * rs * gn;
            u32x2 o; o.x = cvt_pk_bf16(v[0], v[1]); o.y = cvt_pk_bf16(v[2], v[3]); *(u32x2*)((bf16_t*)(ws + AT_KCMP) + (size_t)row * 64 + nt * 16 + 4 * fq) = o; } }
    else { bf16_t* vt = (bf16_t*)(ws + AT_VCMPT) + (((size_t)(row >> 10) * 16 + (n >> 6)) * 64) * 64 + (n & 63);
#pragma unroll
        for (int nt = 0; nt < 4; ++nt)
#pragma unroll
            for (int j = 0; j < 4; ++j) vt[(size_t)(nt * 16 + 4 * fq + j) * 64] = f2bf(acc[nt][j]); }
}

__device__ __forceinline__ float exp2f_(float x) { return __builtin_amdgcn_exp2f(x); }
template <int NH> struct AttnState { float m[NH], l[NH], o[NH]; };
template <int NH> __device__ __forceinline__ void attn_init(AttnState<NH>& st) {
#pragma unroll
    for (int h = 0; h < NH; ++h) { st.m[h] = -1e30f; st.l[h] = 0.f; st.o[h] = 0.f; } }
template <int NH> __device__ __forceinline__ void qk_scores(const bf16_t* krow, const LAS float* q_, float (&s)[NH]) {
    unsigned qa = (unsigned)(size_t)q_;
    const u32x4* kp = (const u32x4*)krow; u32x4 kw[8];
#pragma unroll
    for (int i = 0; i < 8; ++i) kw[i] = kp[i];
#pragma unroll
    for (int h = 0; h < NH; ++h) s[h] = 0.f;
#pragma unroll
    for (int i = 0; i < 8; ++i) { const u32x4 w = kw[i];
        asm volatile("" : "+v"(qa), "+v"(s[0]));
        const LAS float* q = (const LAS float*)(size_t)qa;
        const float k0 = bf_lo(w.x), k1 = bf_hi(w.x), k2 = bf_lo(w.y), k3 = bf_hi(w.y), k4 = bf_lo(w.z), k5 = bf_hi(w.z), k6 = bf_lo(w.w), k7 = bf_hi(w.w);
#pragma unroll
        for (int h = 0; h < NH; ++h) { const LAS f32x4* qp = (const LAS f32x4*)(q + h * 64 + 8 * i); const f32x4 q0 = qp[0], q1 = qp[1];
            s[h] += k0 * q0.x + k1 * q0.y + k2 * q0.z + k3 * q0.w + k4 * q1.x + k5 * q1.y + k6 * q1.z + k7 * q1.w; } }
}
template <int NH> __device__ __forceinline__ void pv_accum(const bf16_t* Vbase, int vrow, int nk, const float (&p)[NH], float (&o)[NH], int lane) {
#pragma unroll 4
    for (int j = 0; j < nk; ++j) { const int r = __builtin_amdgcn_readlane(vrow, j); const float v = bf2f(Vbase[(size_t)r * 64 + lane]);
#pragma unroll
        for (int h = 0; h < NH; ++h) o[h] += __builtin_bit_cast(float, __builtin_amdgcn_readlane(__builtin_bit_cast(int, p[h]), j)) * v; }
}
template <int NH> __device__ __forceinline__ void attn_chunk(const bf16_t* Kbase, const bf16_t* Vbase, int row, bool valid, int nk, const LAS float* q, AttnState<NH>& st, int lane) {
    float s[NH]; qk_scores<NH>(Kbase + (size_t)row * 64, q, s);
    float p[NH];
#pragma unroll
    for (int h = 0; h < NH; ++h) { const float sv = valid ? s[h] : -1e30f; const float mn = fmaxf(st.m[h], wave_max(sv));
        const float alpha = exp2f_(st.m[h] - mn); p[h] = valid ? exp2f_(sv - mn) : 0.f;
        st.l[h] = st.l[h] * alpha + wave_sum(p[h]); st.o[h] *= alpha; st.m[h] = mn; }
    pv_accum<NH>(Vbase, row, nk, p, st.o, lane);
}
__device__ __forceinline__ void wave_argmax(float& v, int& i) {
#pragma unroll
    for (int o = 1; o < 64; o <<= 1) { const float ov = __shfl_xor(v, o); const int oi = __shfl_xor(i, o); if (ov > v || (ov == v && oi < i)) { v = ov; i = oi; } }
}

__device__ __forceinline__ void phase_attn_baseline(Ctx& C, const Params& prm) {
    unsigned char* ws = prm.ws; const int gw = C.bid * NWAVES + C.wave, NGW = C.G * NWAVES, lane = C.lane;
    LAS float* qs = (LAS float*)(C.lds + C.wave * 4096); LAS float* pslc = qs + 6 * 64;
    bf16_t* A2 = (bf16_t*)(ws + WS_A2);
    const float NEG = -1e30f;
    for (int it = gw; it < NB * 4 * SEQ; it += NGW) {
        const int l = it % SEQ, bh = it / SEQ, b = bh >> 2, h = bh & 3, tok = b * SEQ + l;
        { const bf16_t* qp = (const bf16_t*)(ws + AT_QM) + ((size_t)bh * SEQ + l) * 64; qs[lane] = bf2f(qp[lane]); }
        LDS_WAIT();
        const int cur = l >> 8;
        float gate = NEG;
        if (lane < cur) { const f32x4* mp = (const f32x4*)((const float*)(ws + AT_KMMEAN) + ((size_t)bh * 64 + lane) * 64); const LAS f32x4* qp = (const LAS f32x4*)qs; float a = 0.f;
#pragma unroll
            for (int i = 0; i < 16; ++i) { const f32x4 m = mp[i], q = qp[i]; a += m.x * q.x + m.y * q.y + m.z * q.z + m.w * q.w; }
            gate = a; }
        int sel[3]; bool selv[3];
#pragma unroll
        for (int r = 0; r < 3; ++r) { float bv = gate; int bi = lane; wave_argmax(bv, bi); sel[r] = bi; selv[r] = bv > -1e29f; if (lane == bi) gate = -3e38f; }
        AttnState<1> st; attn_init<1>(st);
        const bf16_t* Km = (const bf16_t*)(ws + AT_KM) + (size_t)bh * SEQ * 64; const bf16_t* Vm = (const bf16_t*)(ws + AT_VM) + (size_t)bh * SEQ * 64;
#pragma unroll 1
        for (int p0 = cur * 256; p0 <= l; p0 += 64) { const int pos = p0 + lane; const int nk = (l - p0 + 1) < 64 ? (l - p0 + 1) : 64;
            attn_chunk<1>(Km, Vm, pos <= l ? pos : l, pos <= l, nk, qs, st, lane); }
#pragma unroll 1
        for (int r = 0; r < 3; ++r) { int sj = sel[0]; bool sv = selv[0];
#pragma unroll
            for (int q = 1; q < 3; ++q) { sj = (r == q) ? sel[q] : sj; sv = (r == q) ? selv[q] : sv; }
            if (!sv) continue;
            for (int c = 0; c < 4; ++c) attn_chunk<1>(Km, Vm, sj * 256 + c * 64 + lane, true, 64, qs, st, lane); }
        A2[(size_t)tok * DM + h * 64 + lane] = f2bf(st.l[0] > 0.f ? st.o[0] / st.l[0] : 0.f);
        LDS_WAIT();
    }
}
typedef float f32x16 __attribute__((ext_vector_type(16)));
constexpr int KL_STRIDE = 144, VL_STRIDE = 136, KL_BYTES = 64 * KL_STRIDE, VL_BYTES = 64 * VL_STRIDE, KV_BYTES = KL_BYTES + VL_BYTES;
struct RowTile { f32x16 O[2]; float m, l; bf16x8 Q[4]; };
__device__ __forceinline__ void rt_init(RowTile& R) {
#pragma unroll
    for (int i = 0; i < 16; ++i) { R.O[0][i] = 0.f; R.O[1][i] = 0.f; }
    R.m = 0.f; R.l = 0.f;
}
__device__ __forceinline__ void rt_load_q(RowTile& R, const bf16_t* qrow, int lane) {
    const int h = lane >> 5;
#pragma unroll
    for (int ks = 0; ks < 4; ++ks) R.Q[ks] = *(const bf16x8*)(qrow + ks * 16 + h * 8);
}
__device__ __forceinline__ float max3f(float a, float b, float c) { float r; asm("v_max3_f32 %0, %1, %2, %3" : "=v"(r) : "v"(a), "v"(b), "v"(c)); return r; }
template <bool MASK>
__device__ __forceinline__ void flash_step_(RowTile& R, const LAS unsigned char* Kl, const LAS unsigned char* Vl, int kidx0, int lo, int hi, int lane) {
    const int r = lane & 31, h = lane >> 5;
    f32x16 S[2];
    const float nm = -R.m;
#pragma unroll
    for (int kt = 0; kt < 2; ++kt) {
#pragma unroll
        for (int i = 0; i < 16; ++i) S[kt][i] = nm;
#pragma unroll
        for (int ks = 0; ks < 4; ++ks) { const bf16x8 a = *(const LAS bf16x8*)(Kl + (kt * 32 + r) * KL_STRIDE + ks * 32 + h * 16);
            S[kt] = __builtin_amdgcn_mfma_f32_32x32x16_bf16(a, R.Q[ks], S[kt], 0, 0, 0); } }
    if (MASK) { const int lo2 = lo - kidx0 - 4 * h, hi2 = hi - kidx0 - 4 * h;
#pragma unroll
        for (int kt = 0; kt < 2; ++kt)
#pragma unroll
            for (int i = 0; i < 16; ++i) { const int c = kt * 32 + (i & 3) + 8 * (i >> 2); S[kt][i] = (c > lo2 && c <= hi2) ? S[kt][i] : -1e30f; } }
    float mx = max3f(S[0][0], S[0][1], S[0][2]);
#pragma unroll
    for (int i = 3; i < 15; i += 2) mx = max3f(mx, S[0][i], S[0][i + 1]);
    mx = max3f(mx, S[0][15], S[1][0]);
#pragma unroll
    for (int i = 1; i < 15; i += 2) mx = max3f(mx, S[1][i], S[1][i + 1]);
    mx = fmaxf(mx, S[1][15]);
    mx = fmaxf(mx, __shfl_xor(mx, 32));
    const bool fresh = R.l == 0.f, live = mx > -1e29f;
    if (__any(live && (mx > 8.f || (fresh && mx < -8.f)))) {
        const float d = live ? (fresh ? mx : fmaxf(mx, 0.f)) : 0.f, alpha = exp2f_(-d);
        R.m += d; R.l *= alpha;
#pragma unroll
        for (int i = 0; i < 16; ++i) { R.O[0][i] *= alpha; R.O[1][i] *= alpha; S[0][i] -= d; S[1][i] -= d; } }
    f32x2 sum2 = (f32x2){0.f, 0.f};
#pragma unroll
    for (int kt = 0; kt < 2; ++kt)
#pragma unroll
        for (int i = 0; i < 16; i += 2) { const float p0 = exp2f_(S[kt][i]), p1 = exp2f_(S[kt][i + 1]); S[kt][i] = p0; S[kt][i + 1] = p1; sum2 += (f32x2){p0, p1}; }
    float sum = sum2.x + sum2.y;
    sum += __shfl_xor(sum, 32);
    R.l += sum;
#pragma unroll
    for (int kt = 0; kt < 2; ++kt)
#pragma unroll
        for (int s = 0; s < 2; ++s) {
            u32x4 pw; pw.x = cvt_pk_bf16(S[kt][8 * s + 0], S[kt][8 * s + 1]); pw.y = cvt_pk_bf16(S[kt][8 * s + 2], S[kt][8 * s + 3]);
            pw.z = cvt_pk_bf16(S[kt][8 * s + 4], S[kt][8 * s + 5]); pw.w = cvt_pk_bf16(S[kt][8 * s + 6], S[kt][8 * s + 7]);
            const bf16x8 pb = __builtin_bit_cast(bf16x8, pw);
#pragma unroll
            for (int dt = 0; dt < 2; ++dt) { const LAS unsigned char* vp = Vl + (dt * 32 + r) * VL_STRIDE + (kt * 32 + 16 * s + 4 * h) * 2;
                const u32x2 v0 = *(const LAS u32x2*)vp, v1 = *(const LAS u32x2*)(vp + 16);
                u32x4 vw; vw.x = v0.x; vw.y = v0.y; vw.z = v1.x; vw.w = v1.y;
                R.O[dt] = __builtin_amdgcn_mfma_f32_32x32x16_bf16(__builtin_bit_cast(bf16x8, vw), pb, R.O[dt], 0, 0, 0); } }
}
template <bool MASK>
__device__ __forceinline__ void flash_step(RowTile& R, const LAS unsigned char* Kl, const LAS unsigned char* Vl, int kidx0, int lo, int hi, int lane) {
    if (MASK) { if (__all((kidx0 > lo) && (kidx0 + 63 <= hi))) flash_step_<false>(R, Kl, Vl, kidx0, lo, hi, lane); else flash_step_<true>(R, Kl, Vl, kidx0, lo, hi, lane); }
    else flash_step_<false>(R, Kl, Vl, kidx0, lo, hi, lane);
}
struct KVRegs { u32x4 k, v; };
template <int NT> __device__ __forceinline__ void kv_issue(KVRegs& g, const bf16_t* ktile, const bf16_t* vtile, int t) {
    g.k = *(const u32x4*)((const char*)ktile + t * 16); g.v = *(const u32x4*)((const char*)vtile + t * 16);
}
__device__ __forceinline__ void kv_commit(const KVRegs& g, LAS unsigned char* Kl, LAS unsigned char* Vl, int t) {
    const int row = t >> 3, c16 = t & 7;
    *(LAS u32x4*)(Kl + row * KL_STRIDE + c16 * 16) = g.k;
    LAS u32x2* vp = (LAS u32x2*)(Vl + row * VL_STRIDE + c16 * 16); vp[0] = (u32x2){g.v.x, g.v.y}; vp[1] = (u32x2){g.v.z, g.v.w};
}

constexpr size_t PS_O   = WS_PROJ;
constexpr size_t PS_LSE = PS_O + (size_t)NB * 2 * SEQ * 30 * 64;
static_assert(PS_LSE + (size_t)NB * 2 * SEQ * 30 * 4 <= WS_A2, "partials overflow the projection buffer");
__device__ __forceinline__ unsigned pack_fp8x4(float a, float b, float c, float d) { int w = __builtin_amdgcn_cvt_pk_fp8_f32(a, b, 0, false); w = __builtin_amdgcn_cvt_pk_fp8_f32(c, d, w, true); return (unsigned)w; }
__device__ __forceinline__ void unpack_fp8x4(unsigned w, float (&o)[4]) { const f32x2 lo = __builtin_amdgcn_cvt_pk_f32_fp8((int)w, false), hi = __builtin_amdgcn_cvt_pk_f32_fp8((int)w, true); o[0] = lo.x; o[1] = lo.y; o[2] = hi.x; o[3] = hi.y; }
__device__ __forceinline__ void store_partial(const RowTile& R, unsigned char* po, float* plse, size_t row, bool active, int lane) {
    const int h = lane >> 5; const float inv = 1.f / R.l;
    if (active) {
#pragma unroll
        for (int dt = 0; dt < 2; ++dt)
#pragma unroll
            for (int q4 = 0; q4 < 4; ++q4) *(unsigned*)(po + row * 64 + dt * 32 + 8 * q4 + 4 * h) = pack_fp8x4(R.O[dt][4 * q4] * inv, R.O[dt][4 * q4 + 1] * inv, R.O[dt][4 * q4 + 2] * inv, R.O[dt][4 * q4 + 3] * inv);
        if (h == 0) plse[row] = R.m + __builtin_amdgcn_logf(R.l); }
}
template <int NS>
__device__ __forceinline__ void merge_partials(RowTile& R, const unsigned char* po, const float* plse, size_t row0, size_t rstride, unsigned have, int lane) {
    const int h = lane >> 5; float lp[NS]; unsigned w[NS][8];
#pragma unroll
    for (int k = 0; k < NS; ++k) { const bool on = (have >> k) & 1u; const size_t row = row0 + (on ? (size_t)k * rstride : 0);
        lp[k] = on ? plse[row] : -1e30f;
#pragma unroll
        for (int dt = 0; dt < 2; ++dt)
#pragma unroll
            for (int q4 = 0; q4 < 4; ++q4) { const unsigned x = *(const unsigned*)(po + row * 64 + dt * 32 + 8 * q4 + 4 * h); w[k][dt * 4 + q4] = on ? x : 0u; } }
    float mn = R.m;
#pragma unroll
    for (int k = 0; k < NS; ++k) mn = fmaxf(mn, lp[k]);
    const float a = exp2f_(R.m - mn); R.l *= a; R.m = mn;
#pragma unroll
    for (int i = 0; i < 16; ++i) { R.O[0][i] *= a; R.O[1][i] *= a; }
#pragma unroll
    for (int k = 0; k < NS; ++k) { const float bsc = exp2f_(lp[k] - mn);
        R.l += bsc;
#pragma unroll
        for (int dt = 0; dt < 2; ++dt)
#pragma unroll
            for (int q4 = 0; q4 < 4; ++q4) { float v[4]; unpack_fp8x4(w[k][dt * 4 + q4], v);
#pragma unroll
                for (int j = 0; j < 4; ++j) R.O[dt][4 * q4 + j] += v[j] * bsc; } }
}

__device__ __forceinline__ void nsa_gather_item(int it, int& bh, int& j, int& s0, int& tmin) {
    bh = it / 628; const int f = it - bh * 628;
    const int seg = (f >= 61) + (f >= 186) + (f >= 375);
    const int pre = seg == 0 ? 0 : seg == 1 ? 61 : seg == 2 ? 186 : 375;
    j = 1 + (f - pre); s0 = seg * 4096; tmin = 64 * (j + 2);
}
__device__ __forceinline__ void phase_nsa_gather(Ctx& C, const Params& prm) {
    unsigned char* ws = prm.ws; const int lane = C.lane, r = lane & 31, w = C.wave, tid = C.tid;
    constexpr int SLOT = KV_BYTES + 16384;
    LAS unsigned* cnts = (LAS unsigned*)(C.lds + 2 * SLOT);
    const int nit = 4 * 628;
    unsigned* qctr = (unsigned*)(ws + WS_CTL) + CW_Q15A; LAS int* tkt = (LAS int*)(cnts + 4);
    if (tid == 0) { tkt[0] = (int)atomicAdd(qctr, 1u); tkt[1] = (int)atomicAdd(qctr, 1u); }
    if (tid < 3) cnts[tid] = 0u;
    __syncthreads();
    int it = __builtin_amdgcn_readfirstlane(tkt[0]), itn = __builtin_amdgcn_readfirstlane(tkt[1]);
    KVRegs gr; unsigned long long pks[8]; int bh, j, s0, tmin;
#define NSG_ISSUE(it_) do { nsa_gather_item(it_, bh, j, s0, tmin); \
        kv_issue<512>(gr, (const bf16_t*)(ws + AT_KSEL) + ((size_t)bh * SEQ + (size_t)j * 64) * 64, (const bf16_t*)(ws + AT_VSELT) + ((size_t)bh * 256 + j) * 4096, tid); \
        const unsigned char* _sx = (const unsigned char*)(ws + AT_SELIDX) + (size_t)bh * SEQ * 8; \
        _Pragma("unroll") for (int k_ = 0; k_ < 8; ++k_) pks[k_] = *(const unsigned long long*)(_sx + (size_t)(s0 + tid + 512 * k_) * 8); } while (0)
    if (it < nit) NSG_ISSUE(it);
    __syncthreads();
    for (int kk = 0; it < nit; ++kk) {
        LAS unsigned char* slot = C.lds + (kk & 1) * SLOT; LAS unsigned* list = (LAS unsigned*)(slot + KV_BYTES); LAS unsigned* cnt = cnts + (kk % 3);
        const int cbh = bh, cj = j;
        int tnew = 0; if (tid == 0) tnew = (int)atomicAdd(qctr, 1u);
        kv_commit(gr, slot, slot + KL_BYTES, tid);
        { int sl8[8]; int mine = 0; unsigned long long mk[8];
#pragma unroll
          for (int k = 0; k < 8; ++k) { const int t = s0 + tid + 512 * k; int sl = -1;
              if (t >= tmin) {
#pragma unroll
                  for (int x = 0; x < 5; ++x) if ((int)((pks[k] >> (8 * x)) & 0xffull) == cj) sl = x; }
              sl8[k] = sl; mk[k] = __ballot(sl >= 0); mine += __popcll(mk[k]); }
          unsigned base = 0u;
          if (lane == 0 && mine > 0) base = __hip_atomic_fetch_add(cnt, (unsigned)mine, __ATOMIC_RELAXED, __HIP_MEMORY_SCOPE_WORKGROUP);
          base = (unsigned)__builtin_amdgcn_readfirstlane((int)base);
#pragma unroll
          for (int k = 0; k < 8; ++k) { if (sl8[k] >= 0) list[base + __popcll(mk[k] & ((1ull << lane) - 1ull))] = (unsigned)(s0 + tid + 512 * k) | ((unsigned)sl8[k] << 16); base += __popcll(mk[k]); } }
        if (itn < nit) NSG_ISSUE(itn);
        if (tid == 0) { cnts[(kk + 1) % 3] = 0u; tkt[(kk + 2) % 3] = tnew; }
        __syncthreads();
        const int n = (int)*cnt, ntile = (n + 4) / 5;
        for (int tile = w; tile < ntile; tile += NWAVES) {
            const int e5 = r / 6, gg = r - 6 * e5, e = tile * 5 + (e5 < 5 ? e5 : 0); const bool active = (r < 30) && (e < n);
            const unsigned ent = list[active ? e : tile * 5]; const int t = (int)(ent & 0xffffu), sl = (int)(ent >> 16), g = active ? gg : 0;
            RowTile R; rt_init(R); rt_load_q(R, (const bf16_t*)prm.out + (((size_t)cbh * SEQ + t) * 6 + g) * 64, lane);
            flash_step<false>(R, slot, slot + KL_BYTES, 0, 0, 0, lane);
            store_partial(R, ws + PS_O, (float*)(ws + PS_LSE), ((size_t)cbh * SEQ + t) * 30 + sl * 6 + g, active, lane);
        }
        it = itn; itn = __builtin_amdgcn_readfirstlane(tkt[(kk + 2) % 3]);
    }
#undef NSG_ISSUE
}

__device__ __forceinline__ void nsa_out_add(const RowTile& R, bf16_t* orow, float scale, int h) {
#pragma unroll
    for (int dt = 0; dt < 2; ++dt)
#pragma unroll
        for (int q4 = 0; q4 < 4; ++q4) { u32x2* pp = (u32x2*)(orow + dt * 32 + 8 * q4 + 4 * h); const u32x2 old = *pp;
            u32x2 nw; nw.x = cvt_pk_bf16(bf_lo(old.x) + scale * R.O[dt][4 * q4 + 0], bf_hi(old.x) + scale * R.O[dt][4 * q4 + 1]);
            nw.y = cvt_pk_bf16(bf_lo(old.y) + scale * R.O[dt][4 * q4 + 2], bf_hi(old.y) + scale * R.O[dt][4 * q4 + 3]); *pp = nw; }
}
__device__ __forceinline__ void phase_nsa_dense(Ctx& C, const Params& prm) {
    unsigned char* ws = prm.ws; const int lane = C.lane, r = lane & 31, h = lane >> 5, w = C.wave, hk = w >> 2, wq = w & 3;
    const int t256 = C.tid & 255, shk = C.tid >> 8;
    bf16_t* A2 = (bf16_t*)(ws + WS_A2);
    for (int u = C.bid; u < NB * (SEQ / 64); u += C.G) {
        const int b = u / (SEQ / 64), qi = u % (SEQ / 64), t0 = qi * 64;
        const int tile_lo = qi >= 8 ? qi - 8 : 0, nwin = qi - tile_lo + 1, nf = qi >= 2 ? 3 : qi + 1, nseq = nwin + nf;
        const size_t plane = (size_t)(b * 2 + shk) * SEQ * 64;
        const bf16_t* Kw = (const bf16_t*)(ws + AT_KWIN) + plane; const bf16_t* Vw = (const bf16_t*)(ws + AT_VWINT) + plane;
        const bf16_t* Ks = (const bf16_t*)(ws + AT_KSEL) + plane; const bf16_t* Vs = (const bf16_t*)(ws + AT_VSELT) + plane;
#define NSA_SEQ_TILE(i) ((i) < nwin ? tile_lo + (i) : ((i) == nwin ? 0 : ((i) == nseq - 1 ? qi : qi - 1)))
#define NSA_SEQ_ISSUE(i) do { const int _t = NSA_SEQ_TILE(i); const bf16_t* _k = ((i) < nwin ? Kw : Ks) + (size_t)_t * 4096; const bf16_t* _v = ((i) < nwin ? Vw : Vs) + (size_t)_t * 4096; \
            kv_issue<256>(g0, _k, _v, t256); kv_issue<256>(g1, _k, _v, t256 + 256); } while (0)
#pragma unroll 1
        for (int pass = 0; pass < 3; ++pass) {
            const int rt = wq * 3 + pass, g = rt >> 1, half = rt & 1, l = t0 + half * 32 + r, tok = b * SEQ + l;
            RowTile R; rt_init(R); rt_load_q(R, (const bf16_t*)prm.out + (((size_t)(b * 2 + hk) * SEQ + l) * 6 + g) * 64, lane);
            const float* gt = (const float*)(ws + AT_GATES) + (size_t)tok * 36 + hk * 6 + g;
            bf16_t* orow = A2 + (size_t)tok * DM + 256 + (hk * 6 + g) * 64;
            KVRegs g0, g1;
            __syncthreads();
            NSA_SEQ_ISSUE(0);
            { LAS unsigned char* base = C.lds + shk * KV_BYTES; kv_commit(g0, base, base + KL_BYTES, t256); kv_commit(g1, base, base + KL_BYTES, t256 + 256); }
            __syncthreads();
#pragma unroll 1
            for (int i = 0; i < nseq; ++i) {
                const bool more = i + 1 < nseq;
                if (more) NSA_SEQ_ISSUE(i + 1);
                const LAS unsigned char* cb = C.lds + ((i & 1) * 2 + hk) * KV_BYTES;
                if (i == nwin) { nsa_out_add(R, orow, gt[24] / R.l, h); rt_init(R); }
                const int tile = NSA_SEQ_TILE(i);
                flash_step<true>(R, cb, cb + KL_BYTES, tile * 64, i < nwin ? l - 512 : -(1 << 30), l, lane);
                if (more) { LAS unsigned char* nb = C.lds + (((i + 1) & 1) * 2 + shk) * KV_BYTES; kv_commit(g0, nb, nb + KL_BYTES, t256); kv_commit(g1, nb, nb + KL_BYTES, t256 + 256); }
                __syncthreads();
            }
            { const unsigned long long pk = *(const unsigned long long*)((const unsigned char*)(ws + AT_SELIDX) + ((size_t)(b * 2 + hk) * SEQ + l) * 8); unsigned have = 0u;
#pragma unroll
              for (int sl = 0; sl < 5; ++sl) have |= (((pk >> (8 * sl)) & 0xffull) != 0ull) ? (1u << sl) : 0u;
              merge_partials<5>(R, ws + PS_O, (const float*)(ws + PS_LSE), ((size_t)(b * 2 + hk) * SEQ + l) * 30 + g, 6, have, lane); }
            nsa_out_add(R, orow, gt[12] / R.l, h);
        }
#undef NSA_SEQ_TILE
#undef NSA_SEQ_ISSUE
    }
}

constexpr int PSLC_LD = 257;
__device__ __forceinline__ void qk_tile(f32x16 (&S)[2], const RowTile& R, float init, const LAS unsigned char* Kl, int lane) {
    const int r = lane & 31, h = lane >> 5;
#pragma unroll
    for (int kt = 0; kt < 2; ++kt) {
#pragma unroll
        for (int i = 0; i < 16; ++i) S[kt][i] = init;
#pragma unroll
        for (int ks = 0; ks < 4; ++ks) { const bf16x8 a = *(const LAS bf16x8*)(Kl + (kt * 32 + r) * KL_STRIDE + ks * 32 + h * 16);
            S[kt] = __builtin_amdgcn_mfma_f32_32x32x16_bf16(a, R.Q[ks], S[kt], 0, 0, 0); } }
}
__device__ __forceinline__ void cmp_stats_step(RowTile& R, const LAS unsigned char* Kl, int kidx0, int hi, int lane) {
    const int h = lane >> 5; f32x16 S[2]; qk_tile(S, R, -R.m, Kl, lane);
    const bool full = __all(kidx0 + 63 <= hi);
    if (!full) {
#pragma unroll
        for (int kt = 0; kt < 2; ++kt)
#pragma unroll
            for (int i = 0; i < 16; ++i) { const int kidx = kidx0 + kt * 32 + (i & 3) + 8 * (i >> 2) + 4 * h; S[kt][i] = kidx <= hi ? S[kt][i] : -1e30f; } }
    float mx = max3f(S[0][0], S[0][1], S[0][2]);
#pragma unroll
    for (int i = 3; i < 15; i += 2) mx = max3f(mx, S[0][i], S[0][i + 1]);
    mx = max3f(mx, S[0][15], S[1][0]);
#pragma unroll
    for (int i = 1; i < 15; i += 2) mx = max3f(mx, S[1][i], S[1][i + 1]);
    mx = fmaxf(mx, S[1][15]);
    mx = fmaxf(mx, __shfl_xor(mx, 32));
    const bool fresh = R.l == 0.f, live = mx > -1e29f;
    if (__any(live && (mx > 8.f || (fresh && mx < -8.f)))) {
        const float d = live ? (fresh ? mx : fmaxf(mx, 0.f)) : 0.f; R.m += d; R.l *= exp2f_(-d);
#pragma unroll
        for (int i = 0; i < 16; ++i) { S[0][i] -= d; S[1][i] -= d; } }
    f32x2 sum2 = (f32x2){0.f, 0.f};
#pragma unroll
    for (int kt = 0; kt < 2; ++kt)
#pragma unroll
        for (int i = 0; i < 16; i += 2) sum2 += (f32x2){exp2f_(S[kt][i]), exp2f_(S[kt][i + 1])};
    float sum = sum2.x + sum2.y; sum += __shfl_xor(sum, 32);
    R.l += sum;
}
__device__ __forceinline__ void cmp_norm_step(RowTile& R, float inv_l, const LAS unsigned char* Kl, const LAS unsigned char* Vl, int kidx0, int hi, LAS unsigned* prow, int lane) {
    const int r = lane & 31, h = lane >> 5; f32x16 S[2]; qk_tile(S, R, -R.m, Kl, lane);
    const bool full = __all(kidx0 + 63 <= hi);
#pragma unroll
    for (int kt = 0; kt < 2; ++kt)
#pragma unroll
        for (int i = 0; i < 16; ++i) { const int kidx = kidx0 + kt * 32 + (i & 3) + 8 * (i >> 2) + 4 * h; S[kt][i] = (full || kidx <= hi) ? exp2f_(S[kt][i]) : 0.f; }
    const float fx = inv_l * 16777216.f;
#pragma unroll
    for (int kt = 0; kt < 2; ++kt)
#pragma unroll
        for (int c = 0; c < 4; ++c) { const int jb = (kidx0 >> 2) + kt * 8 + 2 * c + h; const float s4 = (S[kt][4 * c] + S[kt][4 * c + 1]) + (S[kt][4 * c + 2] + S[kt][4 * c + 3]);
            __hip_atomic_fetch_add(prow + jb, (unsigned)(s4 * fx + 0.5f), __ATOMIC_RELAXED, __HIP_MEMORY_SCOPE_WORKGROUP);
            if (jb + 1 < 256) __hip_atomic_fetch_add(prow + jb + 1, (unsigned)(S[kt][4 * c + 3] * fx + 0.5f), __ATOMIC_RELAXED, __HIP_MEMORY_SCOPE_WORKGROUP); }
#pragma unroll
    for (int kt = 0; kt < 2; ++kt)
#pragma unroll
        for (int s = 0; s < 2; ++s) {
            u32x4 pw; pw.x = cvt_pk_bf16(S[kt][8 * s + 0], S[kt][8 * s + 1]); pw.y = cvt_pk_bf16(S[kt][8 * s + 2], S[kt][8 * s + 3]);
            pw.z = cvt_pk_bf16(S[kt][8 * s + 4], S[kt][8 * s + 5]); pw.w = cvt_pk_bf16(S[kt][8 * s + 6], S[kt][8 * s + 7]);
            const bf16x8 pb = __builtin_bit_cast(bf16x8, pw);
#pragma unroll
            for (int dt = 0; dt < 2; ++dt) { const LAS unsigned char* vp = Vl + (dt * 32 + r) * VL_STRIDE + (kt * 32 + 16 * s + 4 * h) * 2;
                const u32x2 v0 = *(const LAS u32x2*)vp, v1 = *(const LAS u32x2*)(vp + 16);
                u32x4 vw; vw.x = v0.x; vw.y = v0.y; vw.z = v1.x; vw.w = v1.y;
                R.O[dt] = __builtin_amdgcn_mfma_f32_32x32x16_bf16(__builtin_bit_cast(bf16x8, vw), pb, R.O[dt], 0, 0, 0); } }
}
__device__ __forceinline__ float rowmax32(const f32x16 (&S)[2]) {
    float mx = max3f(S[0][0], S[0][1], S[0][2]);
#pragma unroll
    for (int i = 3; i < 15; i += 2) mx = max3f(mx, S[0][i], S[0][i + 1]);
    mx = max3f(mx, S[0][15], S[1][0]);
#pragma unroll
    for (int i = 1; i < 15; i += 2) mx = max3f(mx, S[1][i], S[1][i + 1]);
    return fmaxf(mx, S[1][15]);
}
__device__ __forceinline__ void cmp_stats_step2(RowTile& Ra, RowTile& Rb, const LAS unsigned char* Kl, int kidx0, int hia, int hib, int lane) {
    const int r = lane & 31, h = lane >> 5; f32x16 Sa[2], Sb[2];
    const float nma = -Ra.m, nmb = -Rb.m;
#pragma unroll
    for (int kt = 0; kt < 2; ++kt) {
#pragma unroll
        for (int i = 0; i < 16; ++i) { Sa[kt][i] = nma; Sb[kt][i] = nmb; }
#pragma unroll
        for (int ks = 0; ks < 4; ++ks) { const bf16x8 a = *(const LAS bf16x8*)(Kl + (kt * 32 + r) * KL_STRIDE + ks * 32 + h * 16);
            Sa[kt] = __builtin_amdgcn_mfma_f32_32x32x16_bf16(a, Ra.Q[ks], Sa[kt], 0, 0, 0); Sb[kt] = __builtin_amdgcn_mfma_f32_32x32x16_bf16(a, Rb.Q[ks], Sb[kt], 0, 0, 0); } }
    if (!__all(kidx0 + 63 <= hia && kidx0 + 63 <= hib)) {
#pragma unroll
        for (int kt = 0; kt < 2; ++kt)
#pragma unroll
            for (int i = 0; i < 16; ++i) { const int kidx = kidx0 + kt * 32 + (i & 3) + 8 * (i >> 2) + 4 * h; Sa[kt][i] = kidx <= hia ? Sa[kt][i] : -1e30f; Sb[kt][i] = kidx <= hib ? Sb[kt][i] : -1e30f; } }
    float mxa = rowmax32(Sa), mxb = rowmax32(Sb);
    mxa = fmaxf(mxa, __shfl_xor(mxa, 32)); mxb = fmaxf(mxb, __shfl_xor(mxb, 32));
    const bool fa = Ra.l == 0.f, la = mxa > -1e29f, fb = Rb.l == 0.f, lb = mxb > -1e29f;
    if (__any((la && (mxa > 8.f || (fa && mxa < -8.f))) || (lb && (mxb > 8.f || (fb && mxb < -8.f))))) {
        const float da = la ? (fa ? mxa : fmaxf(mxa, 0.f)) : 0.f, db = lb ? (fb ? mxb : fmaxf(mxb, 0.f)) : 0.f;
        Ra.m += da; Ra.l *= exp2f_(-da); Rb.m += db; Rb.l *= exp2f_(-db);
#pragma unroll
        for (int i = 0; i < 16; ++i) { Sa[0][i] -= da; Sa[1][i] -= da; Sb[0][i] -= db; Sb[1][i] -= db; } }
    f32x2 s2a = (f32x2){0.f, 0.f}, s2b = (f32x2){0.f, 0.f};
#pragma unroll
    for (int kt = 0; kt < 2; ++kt)
#pragma unroll
        for (int i = 0; i < 16; i += 2) { s2a += (f32x2){exp2f_(Sa[kt][i]), exp2f_(Sa[kt][i + 1])}; s2b += (f32x2){exp2f_(Sb[kt][i]), exp2f_(Sb[kt][i + 1])}; }
    float sa = s2a.x + s2a.y, sb = s2b.x + s2b.y; sa += __shfl_xor(sa, 32); sb += __shfl_xor(sb, 32);
    Ra.l += sa; Rb.l += sb;
}
__device__ __forceinline__ void phase_nsa_cmp(Ctx& C, const Params& prm) {
    unsigned char* ws = prm.ws; const int w = C.wave;
    LAS unsigned* pslc = (LAS unsigned*)(C.lds + 2 * KV_BYTES);
    bf16_t* A2 = (bf16_t*)(ws + WS_A2);
    for (int u = C.bid; u < NB * 2 * (SEQ / 64); u += C.G) {
        int tid = C.tid; asm volatile("" : "+v"(tid));
        const int lane = tid & 63, r = lane & 31, h = lane >> 5;
        const int bh = u / (SEQ / 64), qr = u % (SEQ / 64), qi = (bh & 1) ? (SEQ / 64 - 1 - qr) : qr, b = bh >> 1, hk = bh & 1, t0 = qi * 64;
        const int nt = ((4 * qi + 2) >> 6) + 1;
        const bf16_t* Kc = (const bf16_t*)(ws + AT_KCMP) + (size_t)bh * 1024 * 64; const bf16_t* Vc = (const bf16_t*)(ws + AT_VCMPT) + (size_t)bh * 16 * 4096;
        __syncthreads();
        for (int i = tid; i < 64 * PSLC_LD; i += NTHREADS) pslc[i] = 0u;
        const int gA = w % 6, hA = w / 6, gB = (2 + w) % 6;
        {
            RowTile R0, R1; R0.m = 0.f; R0.l = 0.f; R1.m = 0.f; R1.l = 0.f;
            const int l0 = t0 + hA * 32 + r, l1 = t0 + 32 + r;
            rt_load_q(R0, (const bf16_t*)prm.out + (((size_t)bh * SEQ + l0) * 6 + gA) * 64, lane);
            if (w < 4) rt_load_q(R1, (const bf16_t*)prm.out + (((size_t)bh * SEQ + l1) * 6 + gB) * 64, lane);
            {
                KVRegs gr;
                __syncthreads();
                kv_issue<512>(gr, Kc, Vc, tid); kv_commit(gr, C.lds, C.lds + KL_BYTES, tid);
                __syncthreads();
#pragma unroll 1
                for (int i = 0; i < nt; ++i) {
                    const bool more = i + 1 < nt;
                    if (more) kv_issue<512>(gr, Kc + (size_t)(i + 1) * 4096, Vc + (size_t)(i + 1) * 4096, tid);
                    const LAS unsigned char* cb = C.lds + (i & 1) * KV_BYTES;
                    if (w < 4) cmp_stats_step2(R0, R1, cb, i * 64, (l0 - 31) >> 4, (l1 - 31) >> 4, lane); else cmp_stats_step(R0, cb, i * 64, (l0 - 31) >> 4, lane);
                    if (more) { LAS unsigned char* nb = C.lds + ((i + 1) & 1) * KV_BYTES; kv_commit(gr, nb, nb + KL_BYTES, tid); }
                    __syncthreads();
                }
            }
#pragma unroll 1
            for (int half = 0; half < 2; ++half) {
                RowTile R; R.m = half ? R1.m : R0.m; R.l = 0.f;
#pragma unroll
                for (int q = 0; q < 4; ++q) R.Q[q] = half ? R1.Q[q] : R0.Q[q];
#pragma unroll
                for (int q = 0; q < 16; ++q) { R.O[0][q] = 0.f; R.O[1][q] = 0.f; }
                const float lsum = half ? R1.l : R0.l, il = lsum > 0.f ? 1.f / lsum : 0.f;
                const int l = half ? l1 : l0, tok = b * SEQ + l, hi = (l - 31) >> 4, g = half ? gB : gA; const bool act = half == 0 || w < 4;
                KVRegs gr;
                __syncthreads();
                kv_issue<512>(gr, Kc, Vc, tid); kv_commit(gr, C.lds, C.lds + KL_BYTES, tid);
                __syncthreads();
#pragma unroll 1
                for (int i = 0; i < nt; ++i) {
                    const bool more = i + 1 < nt;
                    if (more) kv_issue<512>(gr, Kc + (size_t)(i + 1) * 4096, Vc + (size_t)(i + 1) * 4096, tid);
                    const LAS unsigned char* cb = C.lds + (i & 1) * KV_BYTES;
                    if (act) cmp_norm_step(R, il, cb, cb + KL_BYTES, i * 64, hi, pslc + (l - t0) * PSLC_LD, lane);
                    if (more) { LAS unsigned char* nb = C.lds + ((i + 1) & 1) * KV_BYTES; kv_commit(gr, nb, nb + KL_BYTES, tid); }
                    __syncthreads();
                }
                if (act) {
                    const float gc = ((const float*)(ws + AT_GATES))[(size_t)tok * 36 + hk * 6 + g] * il;
                    bf16_t* orow = A2 + (size_t)tok * DM + 256 + (hk * 6 + g) * 64;
#pragma unroll
                    for (int dt = 0; dt < 2; ++dt)
#pragma unroll
                        for (int q4 = 0; q4 < 4; ++q4) { u32x2 nw; nw.x = cvt_pk_bf16(gc * R.O[dt][4 * q4 + 0], gc * R.O[dt][4 * q4 + 1]); nw.y = cvt_pk_bf16(gc * R.O[dt][4 * q4 + 2], gc * R.O[dt][4 * q4 + 3]);
                            *(u32x2*)(orow + dt * 32 + 8 * q4 + 4 * h) = nw; }
                }
            }
        }
        {
            LAS float* tk = (LAS float*)(C.lds);
            float v0 = -1e30f, v1 = -1e30f, v2 = -1e30f, v3 = -1e30f, v4 = -1e30f; int i0 = 0, i1 = 0, i2 = 0, i3 = 0, i4 = 0;
#define TOPK_INSERT(a_, j_) do { const float _a = (a_); const int _j = (j_);     \
            const bool _c0 = _a > v0, _c1 = _a > v1, _c2 = _a > v2, _c3 = _a > v3, _c4 = _a > v4; \
            v4 = _c3 ? v3 : (_c4 ? _a : v4); i4 = _c3 ? i3 : (_c4 ? _j : i4); v3 = _c2 ? v2 : (_c3 ? _a : v3); i3 = _c2 ? i2 : (_c3 ? _j : i3); \
            v2 = _c1 ? v1 : (_c2 ? _a : v2); i2 = _c1 ? i1 : (_c2 ? _j : i2); v1 = _c0 ? v0 : (_c1 ? _a : v1); i1 = _c0 ? i0 : (_c1 ? _j : i1); \
            v0 = _c0 ? _a : v0; i0 = _c0 ? _j : i0; } while (0)
            const int jlo = w * 32 < 1 ? 1 : w * 32, jhi = (w * 32 + 31) < (qi - 2) ? (w * 32 + 31) : (qi - 2);
            for (int j = jlo; j <= jhi; ++j) TOPK_INSERT((float)pslc[lane * PSLC_LD + j], j);
            __syncthreads();
            tk[((w * 5 + 0) * 2 + 0) * 64 + lane] = v0; tk[((w * 5 + 0) * 2 + 1) * 64 + lane] = __int_as_float(i0);
            tk[((w * 5 + 1) * 2 + 0) * 64 + lane] = v1; tk[((w * 5 + 1) * 2 + 1) * 64 + lane] = __int_as_float(i1);
            tk[((w * 5 + 2) * 2 + 0) * 64 + lane] = v2; tk[((w * 5 + 2) * 2 + 1) * 64 + lane] = __int_as_float(i2);
            tk[((w * 5 + 3) * 2 + 0) * 64 + lane] = v3; tk[((w * 5 + 3) * 2 + 1) * 64 + lane] = __int_as_float(i3);
            tk[((w * 5 + 4) * 2 + 0) * 64 + lane] = v4; tk[((w * 5 + 4) * 2 + 1) * 64 + lane] = __int_as_float(i4);
            __syncthreads();
            if (w == 0) {
                for (int ww = 1; ww < 8; ++ww)
#pragma unroll
                    for (int q = 0; q < 5; ++q) { const float a = tk[((ww * 5 + q) * 2 + 0) * 64 + lane]; const int j = __float_as_int(tk[((ww * 5 + q) * 2 + 1) * 64 + lane]); TOPK_INSERT(a, j); }
                unsigned long long packed = 0ull;
                if (v0 > -1e29f) packed |= (unsigned long long)(unsigned)i0;
                if (v1 > -1e29f) packed |= (unsigned long long)(unsigned)i1 << 8;
                if (v2 > -1e29f) packed |= (unsigned long long)(unsigned)i2 << 16;
                if (v3 > -1e29f) packed |= (unsigned long long)(unsigned)i3 << 24;
                if (v4 > -1e29f) packed |= (unsigned long long)(unsigned)i4 << 32;
                *(unsigned long long*)((unsigned char*)(ws + AT_SELIDX) + ((size_t)bh * SEQ + t0 + lane) * 8) = packed;
            }
#undef TOPK_INSERT
        }
    }
}

constexpr size_t PM_O     = PS_LSE + (size_t)NB * 2 * SEQ * 30 * 4;
static_assert(PM_O + (size_t)NB * 4 * SEQ * 3 * 64 <= WS_A2, "MoBA partials overflow the projection buffer");
constexpr size_t PM_LSE   = AT_END2;
constexpr size_t AT_MIDX  = PM_LSE + (size_t)NB * 4 * SEQ * 4 * 4;
constexpr size_t AT_END3  = AT_MIDX + (size_t)NB * 4 * SEQ * 4;
static_assert(AT_END3 <= WS_END, "workspace");
__device__ __forceinline__ void moba_gate_items(Ctx& C, const Params& prm) {
    unsigned char* ws = prm.ws; const int gw = C.bid * NWAVES + C.wave, NGW = C.G * NWAVES, lane = C.lane, r = lane & 31, h = lane >> 5;
    for (int it = gw; it < NB * 4 * (SEQ / 64); it += NGW) {
        const int c64 = it % (SEQ / 64), bh = it / (SEQ / 64), cur = (c64 * 64) >> 8;
        unsigned* out = (unsigned*)(ws + AT_MIDX) + (size_t)bh * SEQ + c64 * 64;
        if (cur == 0) { out[lane] = 0xffffffffu; continue; }
        const bf16_t* km = (const bf16_t*)(ws + AT_KMB) + (size_t)bh * 64 * 64;
#pragma unroll 1
        for (int tt = 0; tt < 2; ++tt) {
            const bf16_t* qrow = (const bf16_t*)(ws + AT_QM) + ((size_t)bh * SEQ + c64 * 64 + tt * 32 + r) * 64;
            bf16x8 qf[4];
#pragma unroll
            for (int ks = 0; ks < 4; ++ks) qf[ks] = *(const bf16x8*)(qrow + ks * 16 + h * 8);
            float v0 = -3e38f, v1 = -3e38f, v2 = -3e38f; int i0 = 255, i1 = 255, i2 = 255;
#define GATE_INS(a_, j_) do { const float _a = (a_); const int _j = (j_);     \
            const bool _c0 = _a > v0 || (_a == v0 && _j < i0), _c1 = _a > v1 || (_a == v1 && _j < i1), _c2 = _a > v2 || (_a == v2 && _j < i2); \
            v2 = _c1 ? v1 : (_c2 ? _a : v2); i2 = _c1 ? i1 : (_c2 ? _j : i2); v1 = _c0 ? v0 : (_c1 ? _a : v1); i1 = _c0 ? i0 : (_c1 ? _j : i1); v0 = _c0 ? _a : v0; i0 = _c0 ? _j : i0; } while (0)
#pragma unroll
            for (int jt = 0; jt < 2; ++jt) {
                if (jt * 32 < cur) {
                    f32x16 S;
#pragma unroll
                    for (int i = 0; i < 16; ++i) S[i] = 0.f;
#pragma unroll
                    for (int ks = 0; ks < 4; ++ks) { const bf16x8 a = *(const bf16x8*)(km + (size_t)(jt * 32 + r) * 64 + ks * 16 + h * 8);
                        S = __builtin_amdgcn_mfma_f32_32x32x16_bf16(a, qf[ks], S, 0, 0, 0); }
#pragma unroll
                    for (int i = 0; i < 16; ++i) { const int j = jt * 32 + (i & 3) + 8 * (i >> 2) + 4 * h; if (j < cur) GATE_INS(S[i], j); }
                }
            }
            { const float pv0 = __shfl_xor(v0, 32), pv1 = __shfl_xor(v1, 32), pv2 = __shfl_xor(v2, 32); const int pi0 = __shfl_xor(i0, 32), pi1 = __shfl_xor(i1, 32), pi2 = __shfl_xor(i2, 32);
              if (pi0 != 255) GATE_INS(pv0, pi0); if (pi1 != 255) GATE_INS(pv1, pi1); if (pi2 != 255) GATE_INS(pv2, pi2); }
            if (h == 0) out[tt * 32 + r] = (unsigned)i0 | ((unsigned)i1 << 8) | ((unsigned)i2 << 16) | 0xff000000u;
#undef GATE_INS
        }
    }
}
__device__ __forceinline__ void moba_gather_item(int it, int& bh, int& j, int& s0, int& tmin) {
    bh = it / 280; const int f = it - bh * 280;
    const int seg = (f >= 7) + (f >= 22) + (f >= 45) + (f >= 76) + (f >= 115) + (f >= 162) + (f >= 217);
    const int pre = seg == 0 ? 0 : seg == 1 ? 7 : seg == 2 ? 22 : seg == 3 ? 45 : seg == 4 ? 76 : seg == 5 ? 115 : seg == 6 ? 162 : 217;
    j = f - pre; s0 = seg * 2048; tmin = 256 * (j + 1);
}
__device__ __forceinline__ void phase_moba_gather(Ctx& C, const Params& prm) {
    unsigned char* ws = prm.ws; const int lane = C.lane, r = lane & 31, w = C.wave, tid = C.tid;
    constexpr int MKV = 4 * KV_BYTES, SLOT = MKV + 8192;
    LAS unsigned* cnts = (LAS unsigned*)(C.lds + 2 * SLOT); LAS int* tkt = (LAS int*)(cnts + 4);
    const int nit = 8 * 280;
    unsigned* qctr = (unsigned*)(ws + WS_CTL) + CW_Q15B;
    if (tid == 0) { tkt[0] = (int)atomicAdd(qctr, 1u); tkt[1] = (int)atomicAdd(qctr, 1u); }
    if (tid < 3) cnts[tid] = 0u;
    __syncthreads();
    int it = __builtin_amdgcn_readfirstlane(tkt[0]), itn = __builtin_amdgcn_readfirstlane(tkt[1]);
    KVRegs g0, g1, g2, g3; unsigned pks[4]; int bh, j, s0, tmin;
#define MBG_ISSUE(it_) do { moba_gather_item(it_, bh, j, s0, tmin); \
        const bf16_t* _km = (const bf16_t*)(ws + AT_KM) + ((size_t)bh * SEQ + (size_t)(4 * j) * 64) * 64; const bf16_t* _vm = (const bf16_t*)(ws + AT_VMT) + ((size_t)bh * 256 + 4 * j) * 4096; \
        kv_issue<512>(g0, _km, _vm, tid); kv_issue<512>(g1, _km + 4096, _vm + 4096, tid); kv_issue<512>(g2, _km + 2 * 4096, _vm + 2 * 4096, tid); kv_issue<512>(g3, _km + 3 * 4096, _vm + 3 * 4096, tid); \
        const unsigned* _mx = (const unsigned*)(ws + AT_MIDX) + (size_t)bh * SEQ; \
        _Pragma("unroll") for (int k_ = 0; k_ < 4; ++k_) pks[k_] = _mx[s0 + tid + 512 * k_]; } while (0)
    if (it < nit) MBG_ISSUE(it);
    __syncthreads();
    for (int kk = 0; it < nit; ++kk) {
        LAS unsigned char* slot = C.lds + (kk & 1) * SLOT; LAS unsigned* list = (LAS unsigned*)(slot + MKV); LAS unsigned* cnt = cnts + (kk % 3);
        const int cbh = bh, cj = j;
        int tnew = 0; if (tid == 0) tnew = (int)atomicAdd(qctr, 1u);
        kv_commit(g0, slot, slot + KL_BYTES, tid); kv_commit(g1, slot + KV_BYTES, slot + KV_BYTES + KL_BYTES, tid);
        kv_commit(g2, slot + 2 * KV_BYTES, slot + 2 * KV_BYTES + KL_BYTES, tid); kv_commit(g3, slot + 3 * KV_BYTES, slot + 3 * KV_BYTES + KL_BYTES, tid);
#pragma unroll
        for (int k = 0; k < 4; ++k) { const int t = s0 + tid + 512 * k;
            if (t >= tmin) {
#pragma unroll
                for (int sl = 0; sl < 3; ++sl) if ((int)((pks[k] >> (8 * sl)) & 0xffu) == cj) { const unsigned pos = __hip_atomic_fetch_add(cnt, 1u, __ATOMIC_RELAXED, __HIP_MEMORY_SCOPE_WORKGROUP); list[pos] = (unsigned)t | ((unsigned)sl << 16); } } }
        if (itn < nit) MBG_ISSUE(itn);
        if (tid == 0) { cnts[(kk + 1) % 3] = 0u; tkt[(kk + 2) % 3] = tnew; }
        __syncthreads();
        const int n = (int)*cnt, ntile = (n + 31) >> 5;
        for (int tile = w; tile < ntile; tile += NWAVES) {
            const int e = tile * 32 + r; const bool active = e < n;
            const unsigned ent = list[active ? e : tile * 32]; const int t = (int)(ent & 0xffffu), sl = (int)(ent >> 16);
            RowTile R; rt_init(R); rt_load_q(R, (const bf16_t*)(ws + AT_QM) + ((size_t)cbh * SEQ + t) * 64, lane);
#pragma unroll 1
            for (int kt = 0; kt < 4; ++kt) flash_step<false>(R, slot + kt * KV_BYTES, slot + kt * KV_BYTES + KL_BYTES, 0, 0, 0, lane);
            store_partial(R, ws + PM_O, (float*)(ws + PM_LSE), ((size_t)cbh * SEQ + t) * 3 + sl, active, lane);
        }
        it = itn; itn = __builtin_amdgcn_readfirstlane(tkt[(kk + 2) % 3]);
    }
#undef MBG_ISSUE
}
__device__ __forceinline__ void phase_moba_dense(Ctx& C, const Params& prm) {
    unsigned char* ws = prm.ws; const int lane = C.lane, r = lane & 31, h = lane >> 5, w = C.wave, tid = C.tid;
    bf16_t* A2 = (bf16_t*)(ws + WS_A2);
    for (int u = C.bid; u < NB * 4 * 64; u += C.G) {
        const int blk = u & 63, bh = u >> 6, b = bh >> 2, hd = bh & 3, l = blk * 256 + w * 32 + r, tok = b * SEQ + l;
        const bf16_t* Km = (const bf16_t*)(ws + AT_KM) + ((size_t)bh * SEQ + (size_t)blk * 256) * 64; const bf16_t* Vm = (const bf16_t*)(ws + AT_VMT) + ((size_t)bh * 256 + 4 * blk) * 4096;
        RowTile R; rt_init(R); rt_load_q(R, (const bf16_t*)(ws + AT_QM) + ((size_t)bh * SEQ + l) * 64, lane);
        KVRegs gr;
        __syncthreads();
        kv_issue<512>(gr, Km, Vm, tid); kv_commit(gr, C.lds, C.lds + KL_BYTES, tid);
        __syncthreads();
#pragma unroll 1
        for (int i = 0; i < 4; ++i) {
            const bool more = i + 1 < 4;
            if (more) kv_issue<512>(gr, Km + (size_t)(i + 1) * 4096, Vm + (size_t)(i + 1) * 4096, tid);
            const LAS unsigned char* cb = C.lds + (i & 1) * KV_BYTES;
            if (i <= (w >> 1)) flash_step<true>(R, cb, cb + KL_BYTES, blk * 256 + i * 64, -(1 << 30), l, lane);
            if (more) { LAS unsigned char* nb = C.lds + ((i + 1) & 1) * KV_BYTES; kv_commit(gr, nb, nb + KL_BYTES, tid); }
            __syncthreads();
        }
        { const unsigned pk = ((const unsigned*)(ws + AT_MIDX))[(size_t)bh * SEQ + l]; unsigned have = 0u;
#pragma unroll
          for (int sl = 0; sl < 3; ++sl) have |= (((pk >> (8 * sl)) & 0xffu) != 0xffu) ? (1u << sl) : 0u;
          merge_partials<3>(R, ws + PM_O, (const float*)(ws + PM_LSE), ((size_t)bh * SEQ + l) * 3, 1, have, lane); }
        const float inv = 1.f / R.l;
        bf16_t* orow = A2 + (size_t)tok * DM + hd * 64;
#pragma unroll
        for (int dt = 0; dt < 2; ++dt)
#pragma unroll
            for (int q4 = 0; q4 < 4; ++q4) { u32x2 nw; nw.x = cvt_pk_bf16(inv * R.O[dt][4 * q4 + 0], inv * R.O[dt][4 * q4 + 1]); nw.y = cvt_pk_bf16(inv * R.O[dt][4 * q4 + 2], inv * R.O[dt][4 * q4 + 3]);
                *(u32x2*)(orow + dt * 32 + 8 * q4 + 4 * h) = nw; }
    }
}
__device__ __forceinline__ void s5_mtable_items(Ctx& C, const Params& prm) {
    unsigned char* ws = prm.ws; const float* cre = prm.in[I_CRE]; const float* cim = prm.in[I_CIM];
    const f32x2* AP = (const f32x2*)(ws + S5_AP); const float* BB = (const float*)(ws + WS_S5BB); float* MT = (float*)(ws + S5_MT);
    LAS f32x2* cl = (LAS f32x2*)C.lds;
    LAS f32x2* bl = cl + 1024;
    LAS f32x2* al = bl + 1024;
    for (int it = C.bid; it < 16 * 16; it += C.G) { const int g = it >> 4, k0 = (it & 15) * 4;
        __syncthreads();
        for (int i = C.tid; i < 1024; i += NTHREADS) { cl[i] = (f32x2){cre[(size_t)g * 1024 + i], cim[(size_t)g * 1024 + i]};
            const int p = i >> 4, hi = i & 15; bl[i] = (f32x2){BB[(size_t)(g * 64 + p) * 32 + hi], BB[(size_t)(g * 64 + p) * 32 + 16 + hi]}; }
        if (C.tid < 256) al[C.tid] = AP[(g * 65 + k0 + (C.tid >> 6)) * 64 + (C.tid & 63)];
        __syncthreads();
#pragma unroll
        for (int q = 0; q < 2; ++q) { const int o = C.tid + q * NTHREADS, hi = o & 15, ho = (o >> 4) & 15, kk = o >> 8;
            float acc = 0.f;
#pragma unroll 8
            for (int p = 0; p < 64; ++p) { const f32x2 a = al[kk * 64 + p], bb = bl[p * 16 + hi], cc = cl[ho * 64 + p];
                const float wr = a.x * bb.x - a.y * bb.y, wi = a.x * bb.y + a.y * bb.x; acc += cc.x * wr - cc.y * wi; }
            MT[((size_t)(g * 64 + k0 + kk) * 16 + ho) * 16 + hi] = acc; }
    }
    __syncthreads();
}
__device__ __forceinline__ void s5_bg_items(Ctx& C, const Params& prm, int rank, int nranks) {
    unsigned char* ws = prm.ws; const float* cre = prm.in[I_CRE]; const float* cim = prm.in[I_CIM];
    const f32x2* AP = (const f32x2*)(ws + S5_AP); const float* MT = (const float*)(ws + S5_MT); bf16_t* BG = (bf16_t*)(ws + S5_BG);
    for (int i = rank * NTHREADS + C.tid; i < 16 * 1024 * 144; i += nranks * NTHREADS) { const int kc = i % 144, n = (i / 144) & 1023, g = i / (144 * 1024), t = n >> 4, ho = n & 15;
        float v[8];
        if (kc < 16) { const int p0 = (kc & 7) * 8; const bool imag = kc >= 8;
            const f32x4* ap = (const f32x4*)(AP + (g * 65 + t + 1) * 64 + p0); const f32x4* crp = (const f32x4*)(cre + (size_t)g * 1024 + ho * 64 + p0); const f32x4* cip = (const f32x4*)(cim + (size_t)g * 1024 + ho * 64 + p0);
            const f32x4 a0 = ap[0], a1 = ap[1], a2 = ap[2], a3 = ap[3], cr0 = crp[0], cr1 = crp[1], ci0 = cip[0], ci1 = cip[1];
            const float ar[8] = {a0[0], a0[2], a1[0], a1[2], a2[0], a2[2], a3[0], a3[2]}, ai[8] = {a0[1], a0[3], a1[1], a1[3], a2[1], a2[3], a3[1], a3[3]};
            const float cr[8] = {cr0[0], cr0[1], cr0[2], cr0[3], cr1[0], cr1[1], cr1[2], cr1[3]}, ci[8] = {ci0[0], ci0[1], ci0[2], ci0[3], ci1[0], ci1[1], ci1[2], ci1[3]};
#pragma unroll
            for (int j = 0; j < 8; ++j) v[j] = imag ? -(cr[j] * ai[j] + ci[j] * ar[j]) : (cr[j] * ar[j] - ci[j] * ai[j]); }
        else { const int kk = (kc - 16) * 8, s = kk >> 4, hi0 = kk & 15;
            if (s <= t) { const f32x4* mp = (const f32x4*)(MT + ((g * 64 + (t - s)) * 16 + ho) * 16 + hi0); const f32x4 m0 = mp[0], m1 = mp[1];
                v[0] = m0[0]; v[1] = m0[1]; v[2] = m0[2]; v[3] = m0[3]; v[4] = m1[0]; v[5] = m1[1]; v[6] = m1[2]; v[7] = m1[3]; }
            else {
#pragma unroll
                for (int j = 0; j < 8; ++j) v[j] = 0.f; } }
        u32x4 o; o.x = cvt_pk_bf16(v[0], v[1]); o.y = cvt_pk_bf16(v[2], v[3]); o.z = cvt_pk_bf16(v[4], v[5]); o.w = cvt_pk_bf16(v[6], v[7]);
        *(u32x4*)(BG + ((size_t)(g * 1024 + n) * 1152 + kc * 8)) = o; }
}
__device__ __forceinline__ void s5_sg_items(Ctx& C, const Params& prm) {
    unsigned char* ws = prm.ws; const f32x2* AP = (const f32x2*)(ws + S5_AP); const float* BB = (const float*)(ws + WS_S5BB); bf16_t* SG = (bf16_t*)(ws + S5_SG);
    for (int i = C.bid * NTHREADS + C.tid; i < 16 * 128 * 128; i += C.G * NTHREADS) { const int kc = i & 127, n = (i >> 7) & 127, g = i >> 14, p = n & 63, s = kc >> 1, hi0 = (kc & 1) * 8;
        const f32x2 a = AP[(g * 65 + (63 - s)) * 64 + p]; const float* bb = BB + (size_t)(g * 64 + p) * 32 + hi0; float v[8];
#pragma unroll
        for (int j = 0; j < 8; ++j) { const float br = bb[j], bi = bb[16 + j]; v[j] = n < 64 ? (a.x * br - a.y * bi) : (a.x * bi + a.y * br); }
        u32x4 o; o.x = cvt_pk_bf16(v[0], v[1]); o.y = cvt_pk_bf16(v[2], v[3]); o.z = cvt_pk_bf16(v[4], v[5]); o.w = cvt_pk_bf16(v[6], v[7]);
        *(u32x4*)(SG + ((size_t)(g * 256 + n) * 1024 + kc * 8)) = o; }
}
__device__ __forceinline__ void s5_chunkscan_wave(Ctx& C, const Params& prm, int b, int g) {
    unsigned char* ws = prm.ws; const int lane = C.lane;
    const f32x2 aL = ((const f32x2*)(ws + S5_AP))[(g * 65 + 64) * 64 + lane];
    const f32x2* E = (const f32x2*)(ws + WS_S5E) + ((size_t)(b * S5_NCH) * 16 + g) * 64 + lane;
    bf16_t* ag = (bf16_t*)(ws + S5_AG) + (size_t)(g * 512 + b * 256) * 1152 + lane;
    float xr = 0.f, xi = 0.f;
    for (int c = 0; c < S5_NCH; c += 32) { f32x2 e[32];
#pragma unroll
        for (int q = 0; q < 32; ++q) e[q] = E[(size_t)(c + q) * 16 * 64];
#pragma unroll
        for (int q = 0; q < 32; ++q) { ag[(size_t)(c + q) * 1152] = f2bf(xr); ag[(size_t)(c + q) * 1152 + 64] = f2bf(xi);
            const float nr = aL.x * xr - aL.y * xi + e[q].x, ni = aL.x * xi + aL.y * xr + e[q].y; xr = nr; xi = ni; } }
}
namespace pg8 {
struct EpiProj0 {
    static constexpr bool PERM = true;
    bf16_t* O; int ldc; bf16_t* AG; const float* R0;
    __device__ __forceinline__ void operator()(const f32x4 (&acc)[2][2][4][2], const Unit& u, int wr, int wc, int fr, int fq) const {
        const int row0 = u.arow + wr * 64 + fr, cw = wc * 32 + 8 * fq;
        float rsv[2][4];
#pragma unroll
        for (int ai = 0; ai < 2; ++ai)
#pragma unroll
            for (int m = 0; m < 4; ++m) rsv[ai][m] = R0[row0 + ai * HALF + m * 16];
#pragma unroll
        for (int ai = 0; ai < 2; ++ai)
#pragma unroll
            for (int m = 0; m < 4; ++m) { const int row = row0 + ai * HALF + m * 16; const float rs = rsv[ai][m];
                if (u.pn >= 1 && u.pn <= 6) { const float r2 = rs * rs; const f32x4 v0 = acc[ai][0][m][0] * acc[ai][1][m][0] * r2, v1 = acc[ai][0][m][1] * acc[ai][1][m][1] * r2;
                    u32x4 w; w.x = cvt_pk_bf16(v0[0], v0[1]); w.y = cvt_pk_bf16(v0[2], v0[3]); w.z = cvt_pk_bf16(v1[0], v1[1]); w.w = cvt_pk_bf16(v1[2], v1[3]);
                    *(u32x4*)(O + (size_t)row * ldc + (u.pn - 1) * 128 + cw) = w; }
                else {
#pragma unroll
                    for (int bj = 0; bj < 2; ++bj) { const f32x4 v0 = acc[ai][bj][m][0] * rs, v1 = acc[ai][bj][m][1] * rs;
                        u32x4 w; w.x = cvt_pk_bf16(v0[0], v0[1]); w.y = cvt_pk_bf16(v0[2], v0[3]); w.z = cvt_pk_bf16(v1[0], v1[1]); w.w = cvt_pk_bf16(v1[2], v1[3]);
                        if (u.pn == 0) { const int ch = cw + bj * HALF, g = ch >> 4, b = row / SEQ, l = row % SEQ;
                            *(u32x4*)(AG + ((size_t)(g * 512 + b * 256 + (l >> 6)) * 1152 + 128 + (l & 63) * 16 + (ch & 15))) = w; }
                        else *(u32x4*)(O + (size_t)row * ldc + 768 + (u.pn - 7) * 256 + bj * HALF + cw) = w; } } }
    }
};
struct S5ESched { int G, c;
    __device__ bool next(int i, Unit& u) const { const int L = i * G + c; if (L >= 32) return false; const int g = L >> 1, mt = L & 1;
        u.arow = g * 512 + mt * 256; u.pn = 0; u.b0 = g * 256 * 1024 * 2; u.b1 = u.b0; u.nt = 16; return true; } };
struct EpiS5E {
    static constexpr bool PERM = true;
    float* E;
    __device__ __forceinline__ void operator()(const f32x4 (&acc)[2][2][4][2], const Unit& u, int wr, int wc, int fr, int fq) const {
        const int g = u.arow >> 9, row0 = (u.arow & 511) + wr * 64 + fr, n0 = wc * 32 + 8 * fq, im = n0 >> 6, p0 = n0 & 63;
#pragma unroll
        for (int ai = 0; ai < 2; ++ai)
#pragma unroll
            for (int m = 0; m < 4; ++m) { const int rg = row0 + ai * HALF + m * 16; float* e = E + (((size_t)rg * 16 + g) * 64 + p0) * 2 + im;
                const f32x4 v0 = acc[ai][0][m][0], v1 = acc[ai][0][m][1];
                e[0] = v0[0]; e[2] = v0[1]; e[4] = v0[2]; e[6] = v0[3]; e[8] = v1[0]; e[10] = v1[1]; e[12] = v1[2]; e[14] = v1[3]; }
    }
};
struct S5Sched { int G, c;
    __device__ bool next(int i, Unit& u) const { const int L = i * G + c; if (L >= 128) return false; const int g = L >> 3, mt = (L >> 2) & 1, pn = L & 3;
        u.arow = g * 512 + mt * 256; u.pn = pn; u.b0 = (g * 1024 + pn * 256) * 1152 * 2; u.b1 = u.b0; u.nt = 2 + 4 * (pn + 1); return true; } };
struct EpiS5 {
    static constexpr bool PERM = true;
    const bf16_t* AG; bf16_t* YB; const float* dvec;
    __device__ __forceinline__ void operator()(const f32x4 (&acc)[2][2][4][2], const Unit& u, int wr, int wc, int fr, int fq) const {
        const int g = u.arow >> 9, row0 = u.arow + wr * 64 + fr, col0 = u.pn * BM + wc * 32 + 8 * fq;
        f32x4 dd[2][2];
#pragma unroll
        for (int bj = 0; bj < 2; ++bj) { const int ho = (col0 + bj * HALF) & 15; dd[bj][0] = *(const f32x4*)(dvec + g * 16 + ho); dd[bj][1] = *(const f32x4*)(dvec + g * 16 + ho + 4); }
#pragma unroll
        for (int ai = 0; ai < 2; ++ai) { u32x4 uw[4][2];
#pragma unroll
            for (int m = 0; m < 4; ++m)
#pragma unroll
                for (int bj = 0; bj < 2; ++bj) uw[m][bj] = *(const u32x4*)(AG + (size_t)(row0 + ai * HALF + m * 16) * 1152 + 128 + col0 + bj * HALF);
#pragma unroll
            for (int m = 0; m < 4; ++m) { const int row = row0 + ai * HALF + m * 16, rg = row & 511;
#pragma unroll
                for (int bj = 0; bj < 2; ++bj) { const int col = col0 + bj * HALF, t = col >> 4, ho = col & 15; const size_t tok = (size_t)(rg >> 8) * SEQ + (size_t)(rg & 255) * 64 + t;
                    const u32x4 w4 = uw[m][bj]; const f32x4 d0 = dd[bj][0], d1 = dd[bj][1], v0 = acc[ai][bj][m][0], v1 = acc[ai][bj][m][1];
                    float y[8]; y[0] = v0[0] + d0[0] * bf_lo(w4.x); y[1] = v0[1] + d0[1] * bf_hi(w4.x); y[2] = v0[2] + d0[2] * bf_lo(w4.y); y[3] = v0[3] + d0[3] * bf_hi(w4.y);
                    y[4] = v1[0] + d1[0] * bf_lo(w4.z); y[5] = v1[1] + d1[1] * bf_hi(w4.z); y[6] = v1[2] + d1[2] * bf_lo(w4.w); y[7] = v1[3] + d1[3] * bf_hi(w4.w);
#pragma unroll
                    for (int j = 0; j < 8; ++j) y[j] = gelu_tanh(y[j]);
                    u32x4 w; w.x = cvt_pk_bf16(y[0], y[1]); w.y = cvt_pk_bf16(y[2], y[3]); w.z = cvt_pk_bf16(y[4], y[5]); w.w = cvt_pk_bf16(y[6], y[7]);
                    *(u32x4*)(YB + tok * 256 + g * 16 + ho) = w; } }
            asm volatile("" ::: "memory"); }
    }
};
struct EpiGLU {
    static constexpr bool PERM = true;
    const bf16_t* YB; bf16_t* O;
    __device__ __forceinline__ void operator()(const f32x4 (&acc)[2][2][4][2], const Unit& u, int wr, int wc, int fr, int fq) const {
        const int row0 = u.arow + wr * 64 + fr, col0 = wc * 32 + 8 * fq;
#pragma unroll
        for (int ai = 0; ai < 2; ++ai) { u32x4 yv[4][2];
#pragma unroll
            for (int m = 0; m < 4; ++m)
#pragma unroll
                for (int bj = 0; bj < 2; ++bj) yv[m][bj] = *(const u32x4*)(YB + (size_t)(row0 + ai * HALF + m * 16) * 256 + col0 + bj * HALF);
#pragma unroll
            for (int m = 0; m < 4; ++m) { const size_t row = (size_t)(row0 + ai * HALF + m * 16);
#pragma unroll
                for (int bj = 0; bj < 2; ++bj) { const int col = col0 + bj * HALF; const u32x4 yw = yv[m][bj]; const f32x4 v0 = acc[ai][bj][m][0], v1 = acc[ai][bj][m][1];
                    u32x4 w; w.x = cvt_pk_bf16(bf_lo(yw.x) * sigmoidf_(v0[0]), bf_hi(yw.x) * sigmoidf_(v0[1])); w.y = cvt_pk_bf16(bf_lo(yw.y) * sigmoidf_(v0[2]), bf_hi(yw.y) * sigmoidf_(v0[3]));
                    w.z = cvt_pk_bf16(bf_lo(yw.z) * sigmoidf_(v1[0]), bf_hi(yw.z) * sigmoidf_(v1[1])); w.w = cvt_pk_bf16(bf_lo(yw.w) * sigmoidf_(v1[2]), bf_hi(yw.w) * sigmoidf_(v1[3]));
                    *(u32x4*)(O + row * DM + col) = w; } }
            asm volatile("" ::: "memory"); }
    }
};
}
constexpr int LDS_BYTES = 160 * 1024;
constexpr int N_PHASES_A = 19;
#ifndef ONLY
#define ONLY -1
#endif
constexpr bool ph_on(int k) { return ONLY < 0 || ONLY == k; }
__global__ void __launch_bounds__(NTHREADS, 2) fwd_kernel(Params prm_) {
    extern __shared__ __attribute__((aligned(16))) unsigned char lds_raw[];
    cg::grid_group grid = cg::this_grid();
    const int ph_lo = prm_.ph_lo, ph_hi = prm_.ph_hi;
    volatile LAS unsigned* bst = (volatile LAS unsigned*)((LAS unsigned char*)lds_raw + LDS_BYTES - 16);
    if (threadIdx.x < 4) bst[threadIdx.x] = 0u;
    __syncthreads();
    XcdBarrier bar = xcd_barrier_post((unsigned*)(prm_.ws + WS_BAR), bst);
    if (ph_hi < 0) grid.sync();
#ifndef PROBE_MASK
#define PROBE_MASK 0u
#endif
    for (int pi = ph_lo; pi < ph_hi; ++pi) {
      const int ph = pi < 3 ? pi : (pi == 3 ? 22 : (pi == 4 ? 23 : (pi <= 8 ? pi - 1 : (pi == 9 ? 10 : pi + 2))));
      const int nrep = ((PROBE_MASK >> ph) & 1u) ? 2 : 1;
      for (int rep = 0; rep < nrep; ++rep) {
        const __attribute__((address_space(4))) Params* kp = (const __attribute__((address_space(4))) Params*)__builtin_amdgcn_kernarg_segment_ptr();
        asm volatile("" : "+s"(kp));
        const Params& prm = *(const Params*)kp;
        int tid_ = threadIdx.x, bid_ = blockIdx.x, G_ = gridDim.x; asm volatile("" : "+v"(tid_)); asm volatile("" : "+s"(bid_), "+s"(G_));
        Ctx C; C.lds = (LAS unsigned char*)lds_raw; C.tid = tid_; C.lane = tid_ & 63; C.wave = __builtin_amdgcn_readfirstlane(tid_ >> 6); C.G = G_; C.bid = bid_;
        unsigned char* ws = prm.ws;
        switch (ph) {
        case 0: if constexpr (ph_on(0)) { phase_prep(C, prm); } break;
        case 1: if constexpr (ph_on(1)) { pg8::Gemm g{(const bf16_t*)(ws + WS_XN), (const char*)(ws + WS_WIN0T), DM, DM, DM, 1 << 30, nullptr}; pg8::DenseSched S; S.init(T, IN_EVEN, C.G, C.bid, DM, DM);
                  s5_mtable_items(C, prm); s5_sg_items(C, prm);
                  pg8::EpiProj0 E{(bf16_t*)(ws + WS_PROJ), 1536, (bf16_t*)(ws + S5_AG), (const float*)(ws + WS_R0)}; pg8::gemm_phase<pg8::EpiProj0, pg8::DenseSched, false>(C.lds, g, S, E); } break;
        case 2: if constexpr (ph_on(2)) {
                  if (C.G > 64 && C.bid < 32) { pg8::Gemm g{(const bf16_t*)(ws + S5_AG) + 128, (const char*)(ws + S5_SG), 1152, 1024, 1024, 1 << 30, nullptr}; pg8::S5ESched S{32, C.bid};
                      pg8::EpiS5E E{(float*)(ws + WS_S5E)}; pg8::gemm_phase<pg8::EpiS5E, pg8::S5ESched, false>(C.lds, g, S, E);
                      asm volatile("s_waitcnt vmcnt(0)" ::: "memory"); __syncthreads(); if (C.wave == 0) { __builtin_amdgcn_fence(__ATOMIC_ACQUIRE, "agent"); s5_chunkscan_wave(C, prm, C.bid & 1, C.bid >> 1); } }
                  else if (C.G > 64) { phase_s5a_conv(C, prm, C.bid - 32, C.G - 32); s5_bg_items(C, prm, C.bid - 32, C.G - 32); }
                  else { pg8::Gemm g{(const bf16_t*)(ws + S5_AG) + 128, (const char*)(ws + S5_SG), 1152, 1024, 1024, 1 << 30, nullptr}; pg8::S5ESched S{C.G, C.bid};
                      pg8::EpiS5E E{(float*)(ws + WS_S5E)}; pg8::gemm_phase<pg8::EpiS5E, pg8::S5ESched, false>(C.lds, g, S, E); __syncthreads(); phase_s5a_conv(C, prm, C.bid, C.G); s5_bg_items(C, prm, C.bid, C.G); } } break;
        case 3: if constexpr (ph_on(3)) { if (C.G <= 64) { const int gw = C.bid * NWAVES + C.wave; if (gw < NB * 16) s5_chunkscan_wave(C, prm, gw >> 4, gw & 15); } } break;
        case 22: if constexpr (ph_on(22)) { pg8::Gemm g{(const bf16_t*)(ws + S5_AG), (const char*)(ws + S5_BG), 1152, 1152, 1152, 1 << 30, nullptr}; pg8::S5Sched S{C.G, C.bid};
                  pg8::EpiS5 E{(const bf16_t*)(ws + S5_AG), (bf16_t*)(ws + S5_YB), prm.in[I_S5D]}; pg8::gemm_phase<pg8::EpiS5, pg8::S5Sched, false>(C.lds, g, S, E);
                  if (C.G > 128) { if (C.bid >= 128) late_weight_items(C, prm, C.bid - 128, C.G - 128); } else { __syncthreads(); late_weight_items(C, prm, C.bid, C.G); } } break;
        case 23: if constexpr (ph_on(23)) { pg8::Gemm g{(const bf16_t*)(ws + S5_YB), (const char*)(ws + S5_GLUT), 256, 256, 256, 1 << 30, nullptr}; pg8::DenseSched S; S.init(T, 256, C.G, C.bid, 256, 256);
                  pg8::EpiGLU E{(const bf16_t*)(ws + S5_YB), (bf16_t*)(ws + WS_A2)}; pg8::gemm_phase<pg8::EpiGLU, pg8::DenseSched, false>(C.lds, g, S, E); } break;
        case 4: if constexpr (ph_on(4)) { pg8::Gemm g{(const bf16_t*)(ws + WS_A2), (const char*)(ws + WS_WOUT0T), DM, DM, DM, 1 << 30, nullptr}; pg8::DenseSched S; S.init(T, DM, C.G, C.bid, DM, DM);
                  pg8::EpiResidualB<false> E{nullptr, (bf16_t*)(ws + WS_XN), (float*)(ws + WS_SS)}; pg8::gemm_phase<pg8::EpiResidualB<false>, pg8::DenseSched, false>(C.lds, g, S, E); } break;
#define MOE_PHASES(P0, LAYER) \
        case P0: if constexpr (ph_on(P0)) { phase_moe_route(C, prm, LAYER); } break; \
        case P0 + 1: if constexpr (ph_on(P0 + 1)) { phase_moe_scatter(C, prm, LAYER); } break; \
        case P0 + 2: if constexpr (ph_on(P0 + 2)) { LAS int* tabl = (LAS int*)(C.lds + 131072); moe_load_tab((const unsigned*)(ws + WS_CTL) + CW_MOECNT + LAYER * 32, tabl, C.tid); __syncthreads(); \
                  unsigned* rdy = (unsigned*)(ws + WS_CTL) + CW_MOERDY + LAYER * 256; unsigned* qctr = (unsigned*)(ws + WS_CTL) + CW_MOEQ + LAYER; LAS int* tk = tabl + 32; \
                  { pg8::Gemm g{(const bf16_t*)(ws + WS_XN), (const char*)(ws + WS_MW1T) + (size_t)LAYER * 16 * 512 * 1024 * 2, DM, DM, DM, 1 << 30, (const int*)(ws + WS_ROWTOK)}; \
                    pg8::MoeSched S{tabl, C.G, C.bid, 0, rdy, qctr, tk}; \
                    pg8::EpiSwiGLU E{(bf16_t*)(ws + WS_PROJ), (const f32x4*)(ws + WS_WROW)}; pg8::gemm_phase<pg8::EpiSwiGLU, pg8::MoeSched, true, true>(C.lds, g, S, E); } \
                  __syncthreads(); \
                    \
                  { pg8::Gemm g{(const bf16_t*)(ws + WS_PROJ), (const char*)(ws + WS_MWDT) + (size_t)LAYER * 16 * 1024 * 256 * 2, 512, 256, 512, 4, nullptr}; \
                    pg8::MoeSched S{tabl, C.G, C.bid, 1, rdy, qctr, tk}; \
                    pg8::EpiScatterResB<(LAYER == 1)> E{prm.out, (bf16_t*)(ws + WS_XN), (float*)(ws + WS_SS), (const int*)(ws + WS_ROWTOK)}; pg8::gemm_phase<pg8::EpiScatterResB<(LAYER == 1)>, pg8::MoeSched, false, true>(C.lds, g, S, E); } \
                  if (LAYER == 0) {   \
                      __syncthreads(); LAS float* scr = (LAS float*)(C.lds + C.wave * 16384); const int nun = tabl[24] * 4; \
                      for (int s = __builtin_amdgcn_readfirstlane(tk[1]);;) { const int cg = s - 2 * nun; if (cg >= 768) break; \
                          const int it = cg * NWAVES + C.wave; moe_weight_item(prm, ws, 16 + it / 384, it % 384, scr, C.lane); \
                          __syncthreads(); if (C.tid == 0) tk[0] = (int)atomicAdd(qctr, 1u); __syncthreads(); s = __builtin_amdgcn_readfirstlane(tk[0]); } } } break; \
        case P0 + 3: break;
        MOE_PHASES(5, 0)
        case 9: break;
        case 10: if constexpr (ph_on(10)) { pg8::Gemm g{(const bf16_t*)(ws + WS_XN), (const char*)(ws + WS_WIN1T), DM, DM, DM, 1 << 30, nullptr};
                  LAS float* rl = (LAS float*)(C.lds + 131072 + 16384);
                  pg8::RowScaleSched S; S.init(T, IN_ODD_P, C.G, C.bid, DM, DM); S.SS = (const float*)(ws + WS_SS); S.rl = rl;
                  pg8::EpiOdd E{(bf16_t*)(ws + WS_PROJ), IN_ODD_P, rl, (LAS float*)(C.lds + 131072 + 20480), ws, (unsigned char*)prm.out, prm.in[I_MQN], prm.in[I_MKN], prm.in[I_NQN], prm.in[I_NKSN], prm.in[I_NKWN]};
                  pg8::gemm_phase<pg8::EpiOdd, pg8::RowScaleSched, false, true>(C.lds, g, S, E); } break;
        case 12: if constexpr (ph_on(12)) { kmmean_items(C, prm);
                  if (C.G > 64 && C.bid >= 64) phase_post1(C, prm, C.bid - 64, C.G - 64);
                  else { pg8::Gemm g{(const bf16_t*)(ws + AT_KC), (const char*)(ws + WS_C1T), 1024, 1024, 1024, 1 << 30, nullptr}; pg8::C1Sched S{C.G, C.bid};
                      pg8::EpiBf16Plain E{(bf16_t*)(ws + AT_HC), 512}; pg8::gemm_phase<pg8::EpiBf16Plain, pg8::C1Sched, false>(C.lds, g, S, E);
                      if (C.G <= 64) { __syncthreads(); phase_post1(C, prm, C.bid, C.G); } } } break;
        case 13: if constexpr (ph_on(13)) { phase_c2(C, prm); moba_gate_items(C, prm); } break;
        case 14: if constexpr (ph_on(14)) { phase_nsa_cmp(C, prm); } break;
        case 15: if constexpr (ph_on(15)) {
#ifdef REP_NSAG
                  phase_nsa_gather(C, prm); __syncthreads();
#endif
#ifdef REP_MOBAG
                  phase_moba_gather(C, prm); __syncthreads();
#endif
                  phase_nsa_gather(C, prm); __syncthreads(); phase_moba_gather(C, prm); } break;
        case 16: if constexpr (ph_on(16)) {
#ifdef REP_MOBAD
                  phase_moba_dense(C, prm); __syncthreads();
#endif
                  phase_nsa_dense(C, prm); __syncthreads(); phase_moba_dense(C, prm); } break;
        case 17: if constexpr (ph_on(17)) { pg8::Gemm g{(const bf16_t*)(ws + WS_A2), (const char*)(ws + WS_WOUT1T), DM, DM, DM, 1 << 30, nullptr}; pg8::DenseSched S; S.init(T, DM, C.G, C.bid, DM, DM);
                  pg8::EpiResidualB<false> E{nullptr, (bf16_t*)(ws + WS_XN), (float*)(ws + WS_SS)}; pg8::gemm_phase<pg8::EpiResidualB<false>, pg8::DenseSched, false>(C.lds, g, S, E); } break;
        MOE_PHASES(18, 1)
        default: break;
        }
        if (pi + 1 < ph_hi || rep + 1 < nrep) xcd_barrier(bar);
      }
    }
}

extern "C" void kernel_launch(void* const* d_in, const int* in_sizes, int n_in, void* d_out, int out_size, void* d_ws, size_t ws_size, hipStream_t stream) {
    static int grid_blocks = 0;
    if (!grid_blocks) {
        int dev = 0, cus = 0, per_cu = 0;
        (void)hipGetDevice(&dev);
        (void)hipDeviceGetAttribute(&cus, hipDeviceAttributeMultiprocessorCount, dev);
        (void)hipFuncSetAttribute((const void*)fwd_kernel, hipFuncAttributeMaxDynamicSharedMemorySize, LDS_BYTES);
        (void)hipOccupancyMaxActiveBlocksPerMultiprocessor(&per_cu, fwd_kernel, NTHREADS, LDS_BYTES);
        if (per_cu < 1) fprintf(stderr, "occupancy query says %d blocks/CU\n", per_cu);
        grid_blocks = cus;
        fprintf(stderr, "cus=%d per_cu=%d grid=%d ws=%zu need=%zu\n", cus, per_cu, grid_blocks, ws_size, (size_t)WS_TOTAL);
    }
    (void)hipMemsetAsync((char*)d_ws + WS_BAR, 0, XCD_BAR_WORDS * 4, stream);
    Params p{};
    for (int i = 0; i < 38; ++i) p.in[i] = (const float*)d_in[i];
    p.out = (float*)d_out; p.ws = (unsigned char*)d_ws; p.ph_lo = 0; p.ph_hi = N_PHASES_A;
    void* args[] = {&p};
    hipError_t e = hipLaunchCooperativeKernel((void*)fwd_kernel, dim3(grid_blocks), dim3(NTHREADS), args, LDS_BYTES, stream);
    if (e != hipSuccess) fprintf(stderr, "cooperative launch failed: %s (grid %d)\n", hipGetErrorString(e), grid_blocks);
}
```

```cpp
#include <hip/hip_runtime.h>
#include <hip/hip_cooperative_groups.h>
#include <cstdio>
namespace cg = cooperative_groups;

#define LAS __attribute__((address_space(3)))
typedef unsigned short bf16_t;
typedef short bf16x8 __attribute__((ext_vector_type(8)));
typedef float f32x4 __attribute__((ext_vector_type(4)));
typedef float f32x2 __attribute__((ext_vector_type(2)));
typedef unsigned u32x4 __attribute__((ext_vector_type(4)));
typedef unsigned u32x2 __attribute__((ext_vector_type(2)));

constexpr int NB = 2, SEQ = 16384, T = NB * SEQ, DM = 1024;
constexpr int IN_EVEN = 2560, IN_ODD = 2340, IN_ODD_P = 2560;
constexpr int NTHREADS = 512, NWAVES = 8;
constexpr int S5_LC = 64, S5_NCH = SEQ / S5_LC;
constexpr int MOE_MAXROWS = T + 24 * 256;

constexpr size_t al256(size_t x) { return (x + 255) & ~(size_t)255; }
constexpr size_t WS_CTL    = 0;
constexpr size_t WS_S5A    = WS_CTL + 65536;
constexpr size_t WS_S5AL   = WS_S5A + 16 * 64 * 8;
constexpr size_t WS_S5BB   = WS_S5AL + 16 * 64 * 8;
constexpr size_t WS_C1B    = WS_S5BB + 16 * 64 * 32 * 4;
constexpr size_t WS_WIN0T  = al256(WS_C1B + 2 * 256 * 4);
constexpr size_t WS_WOUT0T = WS_WIN0T + (size_t)IN_EVEN * DM * 2;
constexpr size_t WS_WIN1T  = WS_WOUT0T + (size_t)DM * DM * 2;
constexpr size_t WS_WOUT1T = WS_WIN1T + (size_t)IN_ODD_P * DM * 2;
constexpr size_t WS_C1T    = WS_WOUT1T + (size_t)DM * DM * 2;
constexpr size_t WS_MW1T   = WS_C1T + (size_t)2 * 256 * 2048 * 2;
constexpr size_t WS_MWDT   = WS_MW1T + (size_t)2 * 16 * 512 * 1024 * 2;
constexpr size_t WS_XN     = WS_MWDT + (size_t)2 * 16 * 1024 * 256 * 2;
constexpr size_t WS_PROJ   = WS_XN + (size_t)T * DM * 2;
constexpr size_t WS_A2     = WS_PROJ + (size_t)T * 2560 * 2;
constexpr size_t WS_S5E    = WS_A2 + (size_t)T * DM * 2;
constexpr size_t WS_TOKI   = WS_S5E + (size_t)NB * S5_NCH * 16 * 64 * 8;
constexpr size_t WS_ROWTOK = WS_TOKI + (size_t)T * 16;
constexpr size_t WS_WROW   = WS_ROWTOK + al256((size_t)MOE_MAXROWS * 4);
constexpr size_t WS_ATT    = WS_WROW + al256((size_t)MOE_MAXROWS * 16);
constexpr size_t WS_END    = WS_ATT + (size_t)149 * 1024 * 1024;
constexpr size_t WS_SS     = WS_END;
constexpr size_t WS_R0     = WS_SS + (size_t)T * 16 * 4;
constexpr size_t WS_C1BP   = WS_R0 + (size_t)T * 4;
constexpr size_t WS_TOTAL  = WS_C1BP + 2 * 4 * 32 * 64 * 4;
static_assert(WS_TOTAL <= (size_t)512 * 1024 * 1024, "workspace exceeds 512 MiB");
constexpr size_t S5_AG   = WS_ATT;
constexpr size_t S5_BG   = S5_AG + (size_t)16 * 512 * 1152 * 2;
constexpr size_t S5_YB   = S5_BG + (size_t)16 * 1024 * 1152 * 2;
constexpr size_t S5_MT   = S5_YB + (size_t)T * 256 * 2;
constexpr size_t S5_AP   = S5_MT + (size_t)16 * 64 * 256 * 4;
constexpr size_t S5_GLUT = S5_AP + (size_t)16 * 65 * 64 * 8;
constexpr size_t S5_SG   = S5_GLUT + 256 * 256 * 2;
static_assert(S5_SG + (size_t)16 * 256 * 1024 * 2 <= WS_END, "S5 buffers");
constexpr int CW_MOEQ = 16;
constexpr int CW_Q15A = 20;
constexpr int CW_Q15B = 21;
constexpr int CW_MOECNT = 64;
constexpr int CW_MOERDY = 256;
constexpr size_t WS_BAR = WS_CTL + 32768;

__device__ __forceinline__ unsigned cvt_pk_bf16(float lo, float hi) { unsigned r; asm volatile("v_cvt_pk_bf16_f32 %0, %1, %2" : "=v"(r) : "v"(lo), "v"(hi)); return r; }
__device__ __forceinline__ float bf_lo(unsigned w) { return __uint_as_float(w << 16); }
__device__ __forceinline__ float bf_hi(unsigned w) { return __uint_as_float(w & 0xffff0000u); }
__device__ __forceinline__ float bf2f(bf16_t b) { return __uint_as_float(((unsigned)b) << 16); }
__device__ __forceinline__ bf16_t f2bf(float f) { return (bf16_t)(cvt_pk_bf16(f, 0.f) & 0xffffu); }
__device__ __forceinline__ float wave_sum(float v) {
#pragma unroll
    for (int o = 1; o < 64; o <<= 1) v += __shfl_xor(v, o);
    return v;
}
__device__ __forceinline__ float wave_max(float v) {
#pragma unroll
    for (int o = 1; o < 64; o <<= 1) v = fmaxf(v, __shfl_xor(v, o));
    return v;
}
__device__ __forceinline__ float gelu_tanh(float x) {
    const float u = 0.7978845608028654f * (x + 0.044715f * x * x * x);
    const float e = __expf(2.f * u);
    const float th = 1.f - 2.f / (e + 1.f);
    return 0.5f * x * (1.f + th);
}
__device__ __forceinline__ float sigmoidf_(float x) { return 1.f / (1.f + __expf(-x)); }

namespace pg8 {
constexpr int BM = 256, BK = 64, HALF = 128, HTB = HALF * BK * 2, STAGE_BYTES = 8 * HTB;
__device__ __forceinline__ int lds_byte(int r, int c) { const int st = (r >> 4) * 2 + (c >> 5), rr = r & 15, cc = c & 31, ob = rr * 64 + cc * 2; return st * 1024 + (ob ^ (((ob >> 9) & 1) << 5)); }
__device__ __forceinline__ void stage_rc(int b, int& R, int& C) { const int st = b / 1024, sb = b % 1024, swz = sb ^ (((sb >> 9) & 1) << 5); R = (st >> 1) * 16 + swz / 64; C = (st & 1) * 32 + (swz % 64) / 2; }
__device__ __forceinline__ int perm32(int rho) { const int n = rho >> 4, i = rho & 15; return 8 * (i >> 2) + 4 * n + (i & 3); }

struct Unit { int arow, pn, b0, b1, nt, aux; };
struct Gemm { const bf16_t* A; const char* Bbase; int lda, ldb, K, ksplit; const int* gather; };

template <class Epi, class Sched, bool GATHER, bool HOOKS = false>
__device__ __forceinline__ void gemm_phase(LAS unsigned char* lds, const Gemm g, const Sched& S, const Epi& E) {
    int tid = threadIdx.x; asm volatile("" : "+v"(tid));
    const int wid = __builtin_amdgcn_readfirstlane(tid >> 6), lane = tid & 63, wr = wid >> 2, wc = wid & 3, fr = lane & 15, fq = lane >> 4;
    unsigned voffA[2], voffB[2];
#pragma unroll
    for (int i = 0; i < 2; ++i) { int R, C; stage_rc(tid * 16 + i * 8192, R, C); const int Rb = Epi::PERM ? ((R & ~31) + perm32(R & 31)) : R;
        voffA[i] = (unsigned)(R * g.lda + C) * 2u; voffB[i] = (unsigned)(Rb * g.ldb + C) * 2u; }
    const size_t kstep = (size_t)(BK * 2);
    const size_t hstepA = (size_t)HALF * g.lda * 2, hstepB = (size_t)HALF * g.ldb * 2;
    const unsigned ldsw = (unsigned)wid * 1024u;
    const int aoff = lds_byte(wr * 64 + fr, fq * 8), boff = lds_byte(wc * 32 + fr, fq * 8);
#define PG8_SA(b, h) (((b) * 2 + (h)) * HTB)
#define PG8_SB(b, h) ((4 + (b) * 2 + (h)) * HTB)
#define PG8_STAGE(bufoff, gbase, voff) do { _Pragma("unroll") for (int _i = 0; _i < 2; ++_i) \
        __builtin_amdgcn_global_load_lds((const unsigned*)((const char*)(gbase) + (voff)[_i]), (LAS unsigned*)(lds + (bufoff) + ldsw + _i * 8192), 16, 0, 0); } while (0)
#define PG8_STAGE_A(bufoff, isnext, h, toff) do { if constexpr (GATHER) { if (isnext) { unsigned _vn[2]; _vn[0] = park[(h) * 2 * 512]; _vn[1] = park[((h) * 2 + 1) * 512]; PG8_STAGE(bufoff, gA + (toff), _vn); } else PG8_STAGE(bufoff, gA + (toff), voC[h]); } \
        else { PG8_STAGE(bufoff, ((isnext) ? nA : cA) + (h) * hstepA + (toff), voffA); } } while (0)
#define PG8_LDA(dst, b, h) do { _Pragma("unroll") for (int m = 0; m < 4; ++m) _Pragma("unroll") for (int k = 0; k < 2; ++k) dst[m][k] = *(const LAS bf16x8*)(lds + PG8_SA(b, h) + aoff + m * 2048 + k * 1024); } while (0)
#define PG8_LDB(dst, b, h) do { _Pragma("unroll") for (int n = 0; n < 2; ++n) _Pragma("unroll") for (int k = 0; k < 2; ++k) dst[n][k] = *(const LAS bf16x8*)(lds + PG8_SB(b, h) + boff + n * 2048 + k * 1024); } while (0)
#define PG8_MMA(ai, bj, At, Bt) do { __builtin_amdgcn_s_setprio(1); _Pragma("unroll") for (int m = 0; m < 4; ++m) _Pragma("unroll") for (int n = 0; n < 2; ++n) _Pragma("unroll") for (int k = 0; k < 2; ++k) \
        acc[ai][bj][m][n] = __builtin_amdgcn_mfma_f32_16x16x32_bf16(Bt[n][k], At[m][k], acc[ai][bj][m][n], 0, 0, 0); __builtin_amdgcn_s_setprio(0); } while (0)
#define PG8_WAIT_V(n) asm volatile("s_waitcnt vmcnt(" #n ")" ::: "memory")
#define PG8_WAIT_L(n) asm volatile("s_waitcnt lgkmcnt(" #n ")" ::: "memory")
#define PG8_BAR __builtin_amdgcn_s_barrier()
#define PG8_SCHED __builtin_amdgcn_sched_barrier(0)
#define PG8_AOFFS(dst, u) do { int _t = threadIdx.x; asm volatile("" : "+v"(_t)); _Pragma("unroll") for (int _h = 0; _h < 2; ++_h) _Pragma("unroll") for (int _i = 0; _i < 2; ++_i) { \
        int _R, _C; stage_rc(_t * 16 + _i * 8192, _R, _C); int _row = g.gather[(u).arow + _h * HALF + _R]; _row = _row < 0 ? 0 : _row; \
        dst[_h][_i] = (unsigned)((size_t)_row * g.lda + _C) * 2u; } \
        asm volatile("" : "+v"(dst[0][0]), "+v"(dst[0][1]), "+v"(dst[1][0]), "+v"(dst[1][1])); } while (0)
    Unit cur, nxt; int ui = 0;
    if (!S.next(0, cur)) return;
    f32x4 acc[2][2][4][2];
#pragma unroll
    for (int a = 0; a < 2; ++a)
#pragma unroll
        for (int b = 0; b < 2; ++b)
#pragma unroll
            for (int m = 0; m < 4; ++m)
#pragma unroll
                for (int n = 0; n < 2; ++n) acc[a][b][m][n] = (f32x4){0.f, 0.f, 0.f, 0.f};
    bf16x8 At[4][2], B0[2][2], B1[2][2];
    unsigned voC[2][2];
    LAS unsigned* park = (LAS unsigned*)(lds + 131072 + 1024) + tid;
    const char* gA = (const char*)g.A;
    const char* cA = gA + (size_t)cur.arow * g.lda * 2; const char* nA = cA;
    if constexpr (GATHER) { PG8_AOFFS(voC, cur); }
    if constexpr (HOOKS) S.a_ready(cur);
#define PG8_BP(u, tile) (g.Bbase + (long)((tile) < g.ksplit ? (u).b0 : (u).b1) + (size_t)(tile) * kstep)
    { const char* b0 = PG8_BP(cur, 0); const char* b1 = PG8_BP(cur, 1);
      PG8_STAGE(PG8_SB(0, 0), b0, voffB); PG8_STAGE_A(PG8_SA(0, 0), false, 0, 0); PG8_STAGE(PG8_SB(0, 1), b0 + hstepB, voffB); PG8_STAGE_A(PG8_SA(0, 1), false, 1, 0);
      if (wr == 1) PG8_BAR;
      PG8_WAIT_V(4); PG8_BAR;
      PG8_STAGE(PG8_SB(1, 0), b1, voffB); PG8_STAGE_A(PG8_SA(1, 0), false, 0, kstep); PG8_STAGE(PG8_SB(1, 1), b1 + hstepB, voffB);
      PG8_WAIT_V(6); PG8_BAR; }
    for (;;) {
        const bool has_next = S.next(ui + 1, nxt);
        if (has_next) { nA = gA + (size_t)nxt.arow * g.lda * 2; if constexpr (GATHER) { unsigned voN[2][2]; PG8_AOFFS(voN, nxt); park[0] = voN[0][0]; park[512] = voN[0][1]; park[1024] = voN[1][0]; park[1536] = voN[1][1]; } }
        else { nA = cA; nxt = cur;
            if constexpr (GATHER) { park[0] = voC[0][0]; park[512] = voC[0][1]; park[1024] = voC[1][0]; park[1536] = voC[1][1]; } }
        const int nt = cur.nt;
#pragma unroll 1
        for (int t = 0; t < nt; t += 2) {
            const bool last = (t == nt - 2);
            if constexpr (HOOKS) { if (last && has_next) S.a_ready(nxt); }
            const size_t o1 = (size_t)(t + 1) * kstep, o2 = last ? 0 : (size_t)(t + 2) * kstep, o3 = o2 + kstep;
            const char* b2 = last ? PG8_BP(nxt, 0) : PG8_BP(cur, t + 2);
            const char* b3 = last ? PG8_BP(nxt, 1) : PG8_BP(cur, t + 3);
            PG8_LDB(B0, 0, 0); PG8_SCHED; PG8_LDA(At, 0, 0); PG8_STAGE_A(PG8_SA(1, 1), false, 1, o1);
            PG8_WAIT_L(8); PG8_BAR; PG8_WAIT_L(0); PG8_MMA(0, 0, At, B0); PG8_BAR; PG8_SCHED;
            PG8_LDB(B1, 0, 1); PG8_STAGE(PG8_SB(0, 0), b2, voffB);
            PG8_BAR; PG8_WAIT_L(0); PG8_MMA(0, 1, At, B1); PG8_BAR;
            PG8_LDA(At, 0, 1); PG8_STAGE_A(PG8_SA(0, 0), last, 0, o2);
            PG8_BAR; PG8_WAIT_L(0); PG8_MMA(1, 0, At, B0); PG8_BAR; PG8_SCHED;
            PG8_STAGE(PG8_SB(0, 1), b2 + hstepB, voffB);
            PG8_WAIT_V(6); PG8_BAR; PG8_MMA(1, 1, At, B1); PG8_BAR;
            PG8_LDB(B0, 1, 0); PG8_SCHED; PG8_LDA(At, 1, 0); PG8_STAGE_A(PG8_SA(0, 1), last, 1, o2);
            PG8_WAIT_L(8); PG8_BAR; PG8_WAIT_L(0); PG8_MMA(0, 0, At, B0); PG8_BAR; PG8_SCHED;
            PG8_LDB(B1, 1, 1); PG8_STAGE(PG8_SB(1, 0), b3, voffB);
            PG8_BAR; PG8_WAIT_L(0); PG8_MMA(0, 1, At, B1); PG8_BAR;
            PG8_LDA(At, 1, 1); PG8_STAGE_A(PG8_SA(1, 0), last, 0, o3);
            PG8_BAR; PG8_WAIT_L(0); PG8_MMA(1, 0, At, B0); PG8_BAR; PG8_SCHED;
            PG8_STAGE(PG8_SB(1, 1), b3 + hstepB, voffB);
            PG8_WAIT_V(6); PG8_BAR; PG8_MMA(1, 1, At, B1); PG8_BAR;
        }
        E(acc, cur, wr, wc, fr, fq);
        if constexpr (HOOKS) S.done(cur);
        if (!has_next) break;
#pragma unroll
        for (int a = 0; a < 2; ++a)
#pragma unroll
            for (int b = 0; b < 2; ++b)
#pragma unroll
                for (int m = 0; m < 4; ++m)
#pragma unroll
                    for (int n = 0; n < 2; ++n) acc[a][b][m][n] = (f32x4){0.f, 0.f, 0.f, 0.f};
        cur = nxt; cA = nA; ++ui;
        if constexpr (GATHER) { voC[0][0] = park[0]; voC[0][1] = park[512]; voC[1][0] = park[1024]; voC[1][1] = park[1536]; }
    }
    PG8_WAIT_V(0);
    if (wr == 0) PG8_BAR;
    PG8_BAR;
#undef PG8_SA
#undef PG8_SB
#undef PG8_STAGE
#undef PG8_STAGE_A
#undef PG8_LDA
#undef PG8_LDB
#undef PG8_MMA
#undef PG8_WAIT_V
#undef PG8_WAIT_L
#undef PG8_BAR
#undef PG8_SCHED
#undef PG8_AOFFS
#undef PG8_BP
}

struct DenseSched {
    int nM, nN, nwg, G, c, btile, nt;
    __device__ void init(int M, int N, int G_, int c_, int ldb, int K) { nM = M / BM; nN = N / BM; nwg = nM * nN; G = G_; c = c_; btile = BM * ldb * 2; nt = K / BK; }
    __device__ bool next(int i, Unit& u) const {
        const long L = (long)i * G + c; if (L >= nwg) return false;
        int wgid = (int)L; { const int q = nwg / 8, r = nwg % 8, xcd = wgid % 8, off = wgid / 8; wgid = (xcd < r ? xcd * (q + 1) : r * (q + 1) + (xcd - r) * q) + off; }
        const int WGM = 8, nig = WGM * nN, gid = wgid / nig, fm = gid * WGM, gsz = (nM - fm) < WGM ? (nM - fm) : WGM;
        u.arow = (fm + ((wgid % nig) % gsz)) * BM; u.pn = (wgid % nig) / gsz;
        u.b0 = u.pn * btile; u.b1 = u.b0; u.nt = nt; return true;
    }
};

struct EpiBf16Plain {
    static constexpr bool PERM = true;
    bf16_t* O; int ldc;
    __device__ __forceinline__ void operator()(const f32x4 (&acc)[2][2][4][2], const Unit& u, int wr, int wc, int fr, int fq) const {
        const int row0 = u.arow + wr * 64 + fr, col0 = u.pn * BM + wc * 32 + 8 * fq;
#pragma unroll
        for (int ai = 0; ai < 2; ++ai)
#pragma unroll
            for (int m = 0; m < 4; ++m) { bf16_t* rowp = O + (size_t)(row0 + ai * HALF + m * 16) * ldc + col0;
#pragma unroll
                for (int bj = 0; bj < 2; ++bj) { const f32x4 v0 = acc[ai][bj][m][0], v1 = acc[ai][bj][m][1];
                    u32x4 w; w.x = cvt_pk_bf16(v0[0], v0[1]); w.y = cvt_pk_bf16(v0[2], v0[3]); w.z = cvt_pk_bf16(v1[0], v1[1]); w.w = cvt_pk_bf16(v1[2], v1[3]);
                    *(u32x4*)(rowp + bj * HALF) = w; } }
    }
};
struct EpiBiasGeluBf16 {
    static constexpr bool PERM = true;
    bf16_t* O; int ldc; const float* bias;
    __device__ __forceinline__ void operator()(const f32x4 (&acc)[2][2][4][2], const Unit& u, int wr, int wc, int fr, int fq) const {
        const int row0 = u.arow + wr * 64 + fr, col0 = u.pn * BM + wc * 32 + 8 * fq;
#pragma unroll
        for (int ai = 0; ai < 2; ++ai)
#pragma unroll
            for (int m = 0; m < 4; ++m) { bf16_t* rowp = O + (size_t)(row0 + ai * HALF + m * 16) * ldc + col0;
#pragma unroll
                for (int bj = 0; bj < 2; ++bj) { f32x4 v0 = acc[ai][bj][m][0], v1 = acc[ai][bj][m][1];
                    const f32x4 b0 = *(const f32x4*)(bias + col0 + bj * HALF), b1 = *(const f32x4*)(bias + col0 + bj * HALF + 4);
#pragma unroll
                    for (int j = 0; j < 4; ++j) { v0[j] = gelu_tanh(v0[j] + b0[j]); v1[j] = gelu_tanh(v1[j] + b1[j]); }
                    u32x4 w; w.x = cvt_pk_bf16(v0[0], v0[1]); w.y = cvt_pk_bf16(v0[2], v0[3]); w.z = cvt_pk_bf16(v1[0], v1[1]); w.w = cvt_pk_bf16(v1[2], v1[3]);
                    *(u32x4*)(rowp + bj * HALF) = w; } }
    }
};
__device__ __forceinline__ float row_sumsq16(const f32x4& a, const f32x4& b, const f32x4& c, const f32x4& d) {
    float s = (a[0] * a[0] + a[1] * a[1]) + (a[2] * a[2] + a[3] * a[3]) + (b[0] * b[0] + b[1] * b[1]) + (b[2] * b[2] + b[3] * b[3])
            + (c[0] * c[0] + c[1] * c[1]) + (c[2] * c[2] + c[3] * c[3]) + (d[0] * d[0] + d[1] * d[1]) + (d[2] * d[2] + d[3] * d[3]);
    s += __shfl_xor(s, 16); s += __shfl_xor(s, 32); return s;
}
__device__ __forceinline__ float rms_from_ss(const float* ssrow) {
    const f32x4 a = *(const f32x4*)ssrow, b = *(const f32x4*)(ssrow + 4), c = *(const f32x4*)(ssrow + 8), d = *(const f32x4*)(ssrow + 12);
    const float s = ((a[0] + a[1]) + (a[2] + a[3])) + ((b[0] + b[1]) + (b[2] + b[3])) + ((c[0] + c[1]) + (c[2] + c[3])) + ((d[0] + d[1]) + (d[2] + d[3]));
    return rsqrtf(s * (1.f / DM) + 1e-6f);
}
template <bool BASE_F32> struct EpiResidualB {
    static constexpr bool PERM = !BASE_F32;
    const float* basef; bf16_t* hb; float* SS;
    __device__ __forceinline__ void operator()(const f32x4 (&acc)[2][2][4][2], const Unit& u, int wr, int wc, int fr, int fq) const {
        const int row0 = u.arow + wr * 64 + fr, col0 = u.pn * BM + wc * 32 + (BASE_F32 ? 4 : 8) * fq;
        if constexpr (!BASE_F32) {
            u32x4 bw[2][4][2]; const char* hbc = (const char*)hb;
#pragma unroll
            for (int ai = 0; ai < 2; ++ai)
#pragma unroll
                for (int m = 0; m < 4; ++m) { const unsigned off = (unsigned)((row0 + ai * HALF + m * 16) * DM + col0) * 2u;
#pragma unroll
                    for (int bj = 0; bj < 2; ++bj) bw[ai][m][bj] = *(const u32x4*)(hbc + (size_t)(off + bj * HALF * 2)); }
#pragma unroll
            for (int ai = 0; ai < 2; ++ai)
#pragma unroll
                for (int m = 0; m < 4; ++m) { const int row = row0 + ai * HALF + m * 16; const unsigned off = (unsigned)(row * DM + col0) * 2u; f32x4 v[2][2];
#pragma unroll
                    for (int bj = 0; bj < 2; ++bj) { const u32x4 w = bw[ai][m][bj];
                        v[bj][0] = (f32x4){bf_lo(w.x), bf_hi(w.x), bf_lo(w.y), bf_hi(w.y)} + acc[ai][bj][m][0]; v[bj][1] = (f32x4){bf_lo(w.z), bf_hi(w.z), bf_lo(w.w), bf_hi(w.w)} + acc[ai][bj][m][1];
                        u32x4 o; o.x = cvt_pk_bf16(v[bj][0][0], v[bj][0][1]); o.y = cvt_pk_bf16(v[bj][0][2], v[bj][0][3]); o.z = cvt_pk_bf16(v[bj][1][0], v[bj][1][1]); o.w = cvt_pk_bf16(v[bj][1][2], v[bj][1][3]);
                        *(u32x4*)((char*)hb + (size_t)(off + bj * HALF * 2)) = o; }
                    const float ss = row_sumsq16(v[0][0], v[0][1], v[1][0], v[1][1]);
                    if (fq == 0) SS[(size_t)row * 16 + u.pn * 4 + wc] = ss; }
        } else {
#pragma unroll
        for (int ai = 0; ai < 2; ++ai) {
            f32x4 bs[4][2][2];
#pragma unroll
            for (int m = 0; m < 4; ++m) { const size_t off = (size_t)(row0 + ai * HALF + m * 16) * DM + col0;
#pragma unroll
                for (int bj = 0; bj < 2; ++bj)
#pragma unroll
                    for (int n = 0; n < 2; ++n) bs[m][bj][n] = *(const f32x4*)(basef + off + bj * HALF + n * 16); }
#pragma unroll
            for (int m = 0; m < 4; ++m) { const int row = row0 + ai * HALF + m * 16; const size_t off = (size_t)row * DM + col0; f32x4 v[2][2];
#pragma unroll
                for (int bj = 0; bj < 2; ++bj)
#pragma unroll
                    for (int n = 0; n < 2; ++n) { v[bj][n] = bs[m][bj][n] + acc[ai][bj][m][n];
                        u32x2 o; o.x = cvt_pk_bf16(v[bj][n][0], v[bj][n][1]); o.y = cvt_pk_bf16(v[bj][n][2], v[bj][n][3]); *(u32x2*)(hb + off + bj * HALF + n * 16) = o; }
                const float ss = row_sumsq16(v[0][0], v[0][1], v[1][0], v[1][1]);
                if (fq == 0) SS[(size_t)row * 16 + u.pn * 4 + wc] = ss; }
            asm volatile("" ::: "memory"); }
        }
    }
};
struct EpiBf16RowScale {
    static constexpr bool PERM = true;
    bf16_t* O; int ldc; const LAS float* rl;
    __device__ __forceinline__ void operator()(const f32x4 (&acc)[2][2][4][2], const Unit& u, int wr, int wc, int fr, int fq) const {
        const int row0 = u.arow + wr * 64 + fr, col0 = u.pn * BM + wc * 32 + 8 * fq; const LAS float* rp = rl + u.aux * 256 + wr * 64 + fr;
#pragma unroll
        for (int ai = 0; ai < 2; ++ai)
#pragma unroll
            for (int m = 0; m < 4; ++m) { const int row = row0 + ai * HALF + m * 16; const float r = rp[ai * HALF + m * 16]; bf16_t* rowp = O + (size_t)row * ldc + col0;
#pragma unroll
                for (int bj = 0; bj < 2; ++bj) { const f32x4 v0 = acc[ai][bj][m][0] * r, v1 = acc[ai][bj][m][1] * r;
                    u32x4 w; w.x = cvt_pk_bf16(v0[0], v0[1]); w.y = cvt_pk_bf16(v0[2], v0[3]); w.z = cvt_pk_bf16(v1[0], v1[1]); w.w = cvt_pk_bf16(v1[2], v1[3]);
                    *(u32x4*)(rowp + bj * HALF) = w; } }
    }
};
struct RowScaleSched : DenseSched {
    const float* SS; LAS float* rl;
    __device__ bool next(int i, Unit& u) const { const bool ok = DenseSched::next(i, u); u.aux = i & 1; return ok; }
    __device__ __forceinline__ void a_ready(const Unit& u) const { const int t = threadIdx.x;
        if (t < 256) rl[u.aux * 256 + t] = rms_from_ss(SS + (size_t)(u.arow + t) * 16); }
    __device__ __forceinline__ void done(const Unit&) const {}
};
struct EpiResidual {
    static constexpr bool PERM = false;
    const float* base; float* out; int ldc;
    __device__ __forceinline__ void operator()(const f32x4 (&acc)[2][2][4][2], const Unit& u, int wr, int wc, int fr, int fq) const {
        const int row0 = u.arow + wr * 64 + fr, col0 = u.pn * BM + wc * 32 + 4 * fq;
#pragma unroll
        for (int ai = 0; ai < 2; ++ai)
#pragma unroll
            for (int m = 0; m < 4; ++m) { const size_t off = (size_t)(row0 + ai * HALF + m * 16) * ldc + col0;
#pragma unroll
                for (int bj = 0; bj < 2; ++bj)
#pragma unroll
                    for (int n = 0; n < 2; ++n) { const f32x4 bs = *(const f32x4*)(base + off + bj * HALF + n * 16); *(f32x4*)(out + off + bj * HALF + n * 16) = bs + acc[ai][bj][m][n]; } }
    }
};
}
#define XB_TMO      128
#define XB_XCNT(j)  (256  + 64 * (j))
#define XB_XSUB(j)  (1280 + 64 * (j))
#define XB_XGEN(j)  (2304 + 64 * (j))
#define XB_TOP      3328
#define XB_TOPGEN   3392
#define XCD_BAR_WORDS 3456
#define XB_SPIN_CAP (1u << 22)
__device__ __forceinline__ unsigned xb_ld(unsigned* p)              { return __hip_atomic_load(p, __ATOMIC_RELAXED, __HIP_MEMORY_SCOPE_AGENT); }
__device__ __forceinline__ unsigned xb_add(unsigned* p, unsigned v) { return __hip_atomic_fetch_add(p, v, __ATOMIC_RELAXED, __HIP_MEMORY_SCOPE_AGENT); }
__device__ __forceinline__ unsigned xb_xcc_id() { return (unsigned)__builtin_amdgcn_s_getreg((3 << 11) | 20) & 0xFu; }
#define XB_SPIN(cond, bar) do { unsigned _sp = 0; while (cond) { __builtin_amdgcn_s_sleep(1); \
    if ((++_sp & 255u) == 0u) { if (xb_ld(&(bar)[XB_TMO])) break; if (_sp > XB_SPIN_CAP) { atomicAdd(&(bar)[XB_TMO], 1u); break; } } } } while (0)
struct XcdBarrier { unsigned* bar; unsigned x; volatile LAS unsigned* st; };
__device__ __forceinline__ XcdBarrier xcd_barrier_post(unsigned* bar, volatile LAS unsigned* st) {
    XcdBarrier b; b.bar = bar; b.x = xb_xcc_id(); b.st = st;
    if (threadIdx.x == 0) (void)xb_add(&bar[XB_XCNT(b.x)], 1u);
    return b;
}
__device__ __forceinline__ void xcd_barrier_complete(unsigned* bar, unsigned x, unsigned& nloc, unsigned& nx) {
    const unsigned G = gridDim.x * gridDim.y * gridDim.z;
    unsigned sum, cnt, mine, sp = 0u;
    for (;;) {
        sum = 0u; cnt = 0u; mine = 0u;
#pragma unroll
        for (unsigned j = 0; j < 16; ++j) { const unsigned c = xb_ld(&bar[XB_XCNT(j)]); sum += c; cnt += (c > 0u) ? 1u : 0u; mine = (j == x) ? c : mine; }
        if (sum == G) break;
        __builtin_amdgcn_s_sleep(1);
        if ((++sp & 255u) == 0u) { if (xb_ld(&bar[XB_TMO])) break; if (sp > XB_SPIN_CAP) { atomicAdd(&bar[XB_TMO], 1u); break; } }
    }
    nloc = mine > 0u ? mine : 1u; nx = cnt > 0u ? cnt : 1u;
}
__device__ __forceinline__ void xcd_barrier(const XcdBarrier& b) {
    asm volatile("s_waitcnt vmcnt(0)" ::: "memory");
    __syncthreads();
    if (threadIdx.x == 0) {
        unsigned* bar = b.bar;
        __builtin_amdgcn_s_waitcnt(0);
        unsigned nloc = b.st[0], nx = b.st[1];
        if (nloc == 0u) { xcd_barrier_complete(bar, b.x, nloc, nx); b.st[0] = nloc; b.st[1] = nx; }
        const unsigned old = xb_add(&bar[XB_XSUB(b.x)], 1u);
        const unsigned gen = old / nloc;
        if (old + 1u == (gen + 1u) * nloc) {
            __builtin_amdgcn_fence(__ATOMIC_RELEASE, "agent");
            asm volatile("s_waitcnt vmcnt(0)" ::: "memory");
            const unsigned og = xb_add(&bar[XB_TOP], 1u);
            const unsigned tg = og / nx;
            if (og + 1u == (tg + 1u) * nx) xb_add(&bar[XB_TOPGEN], 1u);
            else XB_SPIN(xb_ld(&bar[XB_TOPGEN]) == tg, bar);
            __builtin_amdgcn_fence(__ATOMIC_ACQUIRE, "agent");
            xb_add(&bar[XB_XGEN(b.x)], 1u);
            asm volatile("s_waitcnt vmcnt(0)" ::: "memory");
        } else {
            XB_SPIN(xb_ld(&bar[XB_XGEN(b.x)]) == gen, bar);
            __builtin_amdgcn_fence(__ATOMIC_ACQUIRE, "agent");
            asm volatile("s_waitcnt vmcnt(0)" ::: "memory");
        }
    }
    __syncthreads();
}
struct Params { const float* in[38]; float* out; unsigned char* ws; int ph_lo, ph_hi; };
enum { I_X = 0, I_EVNORM, I_EVWIN, I_EVWOUT, I_LAMRE, I_LAMIM, I_LOGDT, I_BRE, I_BIM, I_CRE, I_CIM, I_S5D, I_WGLU, I_CONVW, I_CONVB,
       I_ODNORM, I_ODWIN, I_ODWOUT, I_MQN, I_MKN, I_NQN, I_NKCN, I_NKSN, I_NKWN, I_PEK, I_W1K, I_W2K, I_PEV, I_W1V, I_W2V,
       I_MOENORM, I_WGRP, I_BGRP, I_WEXP, I_BEXP, I_WGATE, I_WUP, I_WDOWN };

struct Ctx {
    LAS unsigned char* lds; int tid, lane, wave, G, bid;
};
#define LDS_WAIT() asm volatile("s_waitcnt lgkmcnt(0)" ::: "memory")

__device__ __forceinline__ void transpose_item(const float* W, int ldw, int Nvalid, bf16_t* WT, int ldt, int mode, int rowoff, LAS float* scr, int kb, int nb, int lane, const float* kgain = nullptr) {
    (void)scr;
    const int kq = lane >> 3, nq = lane & 7, k0 = 64 * kb + 8 * kq, n = 32 * nb + 4 * nq;
    f32x4 a[8];
#pragma unroll
    for (int i = 0; i < 8; ++i) a[i] = n < Nvalid ? *(const f32x4*)(W + (size_t)(k0 + i) * ldw + n) : (f32x4){0.f, 0.f, 0.f, 0.f};
    if (kgain) {
#pragma unroll
        for (int i = 0; i < 8; ++i) a[i] = a[i] * kgain[k0 + i]; }
#pragma unroll
    for (int j = 0; j < 4; ++j) { const int nn = n + j; int row = (mode == 0 ? nn : ((nn >> 7) * 256 + (nn & 127))) + rowoff;
        if (mode == 2) {
            row = nn < 256 ? nn : nn < 1024 ? 256 + ((nn - 256) >> 7) * 256 + ((nn - 256) & 127) : nn < 1792 ? 1792 + (nn - 1024) : 256 + ((nn - 1792) >> 7) * 256 + 128 + ((nn - 1792) & 127); }
        u32x4 o; o.x = cvt_pk_bf16(a[0][j], a[1][j]); o.y = cvt_pk_bf16(a[2][j], a[3][j]); o.z = cvt_pk_bf16(a[4][j], a[5][j]); o.w = cvt_pk_bf16(a[6][j], a[7][j]);
        *(u32x4*)(WT + (size_t)row * ldt + k0) = o; }
}
__device__ __forceinline__ void row_to_bf16_r(const float* xrow, bf16_t* orow, float* rout, int lane) {
    const f32x4* xr = (const f32x4*)xrow + lane;
    f32x4 v[4]; float s = 0.f;
#pragma unroll
    for (int j = 0; j < 4; ++j) { v[j] = xr[64 * j]; s += (v[j].x * v[j].x + v[j].y * v[j].y) + (v[j].z * v[j].z + v[j].w * v[j].w); }
    const float r = rsqrtf(wave_sum(s) * (1.f / DM) + 1e-6f);
    u32x2* o8 = (u32x2*)orow + lane;
#pragma unroll
    for (int j = 0; j < 4; ++j) { u32x2 w; w.x = cvt_pk_bf16(v[j].x, v[j].y); w.y = cvt_pk_bf16(v[j].z, v[j].w); o8[64 * j] = w; }
    if (lane == 0) *rout = r;
}

__device__ __forceinline__ void moe_weight_item(const Params& P, unsigned char* ws, int le, int r, LAS float* scr, int lane) {
    bf16_t* w1t = (bf16_t*)(ws + WS_MW1T) + (size_t)le * 512 * 1024; bf16_t* wdt = (bf16_t*)(ws + WS_MWDT) + (size_t)le * 1024 * 256;
    if (r < 128) transpose_item(P.in[I_WGATE] + (size_t)le * 1024 * 256, 256, 256, w1t, 1024, 1, 0, scr, r / 8, r % 8, lane, P.in[I_MOENORM] + (le >> 4) * DM);
    else if (r < 256) transpose_item(P.in[I_WUP] + (size_t)le * 1024 * 256, 256, 256, w1t, 1024, 1, 128, scr, (r - 128) / 8, (r - 128) % 8, lane, P.in[I_MOENORM] + (le >> 4) * DM);
    else transpose_item(P.in[I_WDOWN] + (size_t)le * 256 * 1024, 1024, 1024, wdt, 256, 0, 0, scr, (r - 256) / 32, (r - 256) % 32, lane);
}
__device__ __forceinline__ void late_weight_items(Ctx& C, const Params& P, int rank, int nranks) {
    unsigned char* ws = P.ws; LAS float* scr = (LAS float*)(C.lds + C.wave * 16384);
    constexpr int IT_MOE0 = 16 * 384, IT_IN1 = 16 * 80, IT_OUT = 16 * 32, IT_C1 = 32 * 8;
    for (int it = rank * NWAVES + C.wave; it < IT_MOE0 + IT_IN1 + IT_OUT + 2 * IT_C1; it += nranks * NWAVES) {
        int r = it;
        if (r < IT_MOE0) { moe_weight_item(P, ws, r / 384, r % 384, scr, C.lane); continue; } r -= IT_MOE0;
        if (r < IT_IN1) { transpose_item(P.in[I_ODWIN], IN_ODD, IN_ODD, (bf16_t*)(ws + WS_WIN1T), DM, 0, 0, scr, r / 80, r % 80, C.lane, P.in[I_ODNORM]); continue; } r -= IT_IN1;
        if (r < IT_OUT) { transpose_item(P.in[I_ODWOUT], DM, DM, (bf16_t*)(ws + WS_WOUT1T), DM, 0, 0, scr, r / 32, r % 32, C.lane); continue; } r -= IT_OUT;
        { const int kv = r >= IT_C1, q = r - kv * IT_C1, hf = q >> 7, kb = (q >> 3) & 15, nb = q & 7;
          transpose_item(P.in[kv ? I_W1V : I_W1K] + (size_t)hf * 1024 * 256, 256, 256, (bf16_t*)(ws + WS_C1T) + (size_t)kv * 512 * 1024, 1024, 0, 256 * hf, scr, kb, nb, C.lane); }
    }
}
__device__ __forceinline__ void cplx_exp(float x, float y, float& re, float& im) {
    const float n = rintf(y * 0.15915494309189535f);
    float r = fmaf(-n, 6.28318548202514648f, y); r = fmaf(-n, -1.7484555e-7f, r);
    const float m = __expf(x); re = m * __cosf(r); im = m * __sinf(r);
}
__device__ __forceinline__ void phase_prep(Ctx& C, const Params& prm) {
    const Params& P = prm; unsigned char* ws = P.ws;
    LAS float* scr = (LAS float*)(C.lds + C.wave * 16384);
    const int gw = C.bid * NWAVES + C.wave, NGW = C.G * NWAVES;
    if (C.bid == 0) for (int i = C.tid; i < 4096; i += NTHREADS) ((unsigned*)(ws + WS_CTL))[i] = 0u;
    constexpr int IT_IN0 = 16 * 80, IT_OUT = 16 * 32, IT_GLU = 4 * 8;
    for (int it = gw; it < IT_IN0 + IT_OUT + IT_GLU; it += NGW) {
        int r = it;
        if (r < IT_IN0) { transpose_item(P.in[I_EVWIN], IN_EVEN, IN_EVEN, (bf16_t*)(ws + WS_WIN0T), DM, 2, 0, scr, r / 80, r % 80, C.lane, P.in[I_EVNORM]); continue; } r -= IT_IN0;
        if (r < IT_OUT) { transpose_item(P.in[I_EVWOUT], DM, DM, (bf16_t*)(ws + WS_WOUT0T), DM, 0, 0, scr, r / 32, r % 32, C.lane); continue; } r -= IT_OUT;
        transpose_item(P.in[I_WGLU], 256, 256, (bf16_t*)(ws + S5_GLUT), 256, 0, 0, scr, r / 8, r % 8, C.lane);
    }
    for (int m = gw; m < T; m += 2 * NGW) {
        const int m2 = m + NGW; const f32x4* xa = (const f32x4*)(P.in[I_X] + (size_t)m * DM) + 2 * C.lane; const f32x4* xb2 = (const f32x4*)(P.in[I_X] + (size_t)m2 * DM) + 2 * C.lane;
        f32x4 va[4], vb[4]; float sa = 0.f, sb = 0.f;
#pragma unroll
        for (int j = 0; j < 2; ++j) { va[2 * j] = xa[128 * j]; va[2 * j + 1] = xa[128 * j + 1]; vb[2 * j] = xb2[128 * j]; vb[2 * j + 1] = xb2[128 * j + 1]; }
#pragma unroll
        for (int j = 0; j < 4; ++j) { sa += (va[j].x * va[j].x + va[j].y * va[j].y) + (va[j].z * va[j].z + va[j].w * va[j].w); sb += (vb[j].x * vb[j].x + vb[j].y * vb[j].y) + (vb[j].z * vb[j].z + vb[j].w * vb[j].w); }
        u32x4* oa = (u32x4*)((bf16_t*)(ws + WS_XN) + (size_t)m * DM) + C.lane; u32x4* ob = (u32x4*)((bf16_t*)(ws + WS_XN) + (size_t)m2 * DM) + C.lane;
#pragma unroll
        for (int j = 0; j < 2; ++j) { u32x4 w; w.x = cvt_pk_bf16(va[2 * j].x, va[2 * j].y); w.y = cvt_pk_bf16(va[2 * j].z, va[2 * j].w); w.z = cvt_pk_bf16(va[2 * j + 1].x, va[2 * j + 1].y); w.w = cvt_pk_bf16(va[2 * j + 1].z, va[2 * j + 1].w); oa[64 * j] = w;
            w.x = cvt_pk_bf16(vb[2 * j].x, vb[2 * j].y); w.y = cvt_pk_bf16(vb[2 * j].z, vb[2 * j].w); w.z = cvt_pk_bf16(vb[2 * j + 1].x, vb[2 * j + 1].y); w.w = cvt_pk_bf16(vb[2 * j + 1].z, vb[2 * j + 1].w); ob[64 * j] = w; }
        sa = wave_sum(sa); sb = wave_sum(sb);
        if (C.lane == 0) { ((float*)(ws + WS_R0))[m] = rsqrtf(sa * (1.f / DM) + 1e-6f); ((float*)(ws + WS_R0))[m2] = rsqrtf(sb * (1.f / DM) + 1e-6f); }
    }
    { const int gt = C.bid * NTHREADS + C.tid;
      if (gt < 1024) { const int g = gt >> 6;
        const float lr = P.in[I_LAMRE][gt], li = P.in[I_LAMIM][gt], dt = __expf(P.in[I_LOGDT][g]);
        float are, aim; cplx_exp(lr * dt, li * dt, are, aim);
        const float den = lr * lr + li * li, fre = ((are - 1.f) * lr + aim * li) / den, fim = (aim * lr - (are - 1.f) * li) / den;
        ((f32x2*)(ws + WS_S5A))[gt] = (f32x2){are, aim};
        float* bb = (float*)(ws + WS_S5BB) + (size_t)gt * 32;
        for (int h = 0; h < 16; ++h) { const float br = P.in[I_BRE][(size_t)gt * 16 + h], bi = P.in[I_BIM][(size_t)gt * 16 + h]; bb[h] = fre * br - fim * bi; bb[16 + h] = fre * bi + fim * br; } }
    }
    for (int it = gw; it < 256; it += NGW) { const int kv = it >> 7, jg = (it >> 5) & 3, sl = it & 31; const float* pe = P.in[kv ? I_PEV : I_PEK] + sl * 64; const float* w1 = P.in[kv ? I_W1V : I_W1K] + (size_t)sl * 64 * 256 + jg * 64 + C.lane;
        float s = 0.f;
#pragma unroll 16
        for (int i = 0; i < 64; ++i) s += pe[i] * w1[(size_t)i * 256];
        ((float*)(ws + WS_C1BP))[((kv * 4 + jg) * 32 + sl) * 64 + C.lane] = s; }
    for (int i = C.bid * NTHREADS + C.tid; i < 16 * 65 * 64; i += C.G * NTHREADS) { const int pp = i & 63, k = (i >> 6) % 65, g = i / (65 * 64);
        const float lr = P.in[I_LAMRE][g * 64 + pp], li = P.in[I_LAMIM][g * 64 + pp], dt = __expf(P.in[I_LOGDT][g]); float re, im; cplx_exp(lr * dt * (float)k, li * dt * (float)k, re, im);
        ((f32x2*)(ws + S5_AP))[i] = (f32x2){re, im}; }
    { int* rt = (int*)(ws + WS_ROWTOK); for (int i = C.bid * NTHREADS + C.tid; i < MOE_MAXROWS; i += C.G * NTHREADS) rt[i] = -1; }
}

__device__ __forceinline__ void s5_load_u(const bf16_t* proj, int tok0, int g, LAS float* ubuf, int lane) {
    { const u32x4* src = (const u32x4*)(proj + (size_t)(tok0 + lane) * IN_EVEN + g * 16); const u32x4 a = src[0], b = src[1];
        LAS f32x4* d = (LAS f32x4*)(ubuf + lane * 16);
        d[0] = (f32x4){bf_lo(a.x), bf_hi(a.x), bf_lo(a.y), bf_hi(a.y)}; d[1] = (f32x4){bf_lo(a.z), bf_hi(a.z), bf_lo(a.w), bf_hi(a.w)};
        d[2] = (f32x4){bf_lo(b.x), bf_hi(b.x), bf_lo(b.y), bf_hi(b.y)}; d[3] = (f32x4){bf_lo(b.z), bf_hi(b.z), bf_lo(b.w), bf_hi(b.w)}; }
    LDS_WAIT();
}
__device__ __forceinline__ void phase_s5a_conv(Ctx& C, const Params& prm, int rank, int nranks) {
    const Params& P = prm; unsigned char* ws = P.ws;
    if (rank == 0) { const float* pp = (const float*)(ws + WS_C1BP) + ((C.tid >> 6) * 32) * 64 + (C.tid & 63); float s = 0.f;
        for (int q = 0; q < 32; ++q) s += pp[q * 64];
        ((float*)(ws + WS_C1B))[C.tid] = s; }
    const bf16_t* proj = (const bf16_t*)(ws + WS_PROJ);
    bf16_t* A2 = (bf16_t*)(ws + WS_A2);
    const float* cw = P.in[I_CONVW]; const float* cb = P.in[I_CONVB];
    for (int it = rank * NTHREADS + C.tid; it < (T / 32) * 96; it += nranks * NTHREADS) {
        const int cg8 = it % 96, tb = it / 96, c0 = cg8 * 8, tok0 = tb * 32, l0 = tok0 % SEQ;
        float w0[8], w1[8], w2[8], bb[8];
#pragma unroll
        for (int j = 0; j < 8; ++j) { w0[j] = cw[c0 + j]; w1[j] = cw[768 + c0 + j]; w2[j] = cw[1536 + c0 + j]; bb[j] = cb[c0 + j]; }
        float zm2[8], zm1[8];
#pragma unroll
        for (int j = 0; j < 8; ++j) { zm2[j] = 0.f; zm1[j] = 0.f; }
#pragma unroll 4
        for (int dt = -2; dt < 32; ++dt) {
            const int l = l0 + dt; if (l < 0) continue;
            const bf16_t* row = proj + (size_t)(tok0 + dt) * 1536;
            const u32x4 zw = *(const u32x4*)(row + c0);
            float z[8]; z[0] = bf_lo(zw.x); z[1] = bf_hi(zw.x); z[2] = bf_lo(zw.y); z[3] = bf_hi(zw.y); z[4] = bf_lo(zw.z); z[5] = bf_hi(zw.z); z[6] = bf_lo(zw.w); z[7] = bf_hi(zw.w);
            if (dt >= 0) { const u32x4 gb = *(const u32x4*)(row + 768 + c0); float gbf[8] = {bf_lo(gb.x), bf_hi(gb.x), bf_lo(gb.y), bf_hi(gb.y), bf_lo(gb.z), bf_hi(gb.z), bf_lo(gb.w), bf_hi(gb.w)};
                float y[8];
#pragma unroll
                for (int j = 0; j < 8; ++j) y[j] = gbf[j] * (w0[j] * zm2[j] + w1[j] * zm1[j] + w2[j] * z[j] + bb[j]);
                u32x4 o; o.x = cvt_pk_bf16(y[0], y[1]); o.y = cvt_pk_bf16(y[2], y[3]); o.z = cvt_pk_bf16(y[4], y[5]); o.w = cvt_pk_bf16(y[6], y[7]);
                *(u32x4*)(A2 + (size_t)(tok0 + dt) * DM + 256 + c0) = o; }
#pragma unroll
            for (int j = 0; j < 8; ++j) { zm2[j] = zm1[j]; zm1[j] = z[j]; }
        }
    }
}

__device__ __forceinline__ int pair_index(int a, int b) { return a == 0 ? (b - 1) : (a == 1 ? (b + 1) : 5); }
__device__ __forceinline__ void phase_moe_route(Ctx& C, const Params& prm, int layer) {
    const Params& P = prm; unsigned char* ws = P.ws;
    const bf16_t* hb = (const bf16_t*)(ws + WS_XN); const float* SS = (const float*)(ws + WS_SS); const float* g = P.in[I_MOENORM] + layer * DM;
    const float* wg = P.in[I_WGRP] + (size_t)layer * DM * 4; const float* we = P.in[I_WEXP] + (size_t)layer * DM * 16;
    const float* bg = P.in[I_BGRP] + layer * 4; const float* be = P.in[I_BEXP] + layer * 16;
    constexpr int RS = 1032;
    LAS bf16_t* Wh = (LAS bf16_t*)C.lds; LAS bf16_t* Wl = Wh + 20 * RS;
    LAS int* hist = (LAS int*)(C.lds + 2 * 20 * RS * 2);
    LAS int* tb = hist + 32;
    LAS int* tp = tb + 128;
    LAS int* gbase = tp + 128;
    const int lane = C.lane;
    { int* rt = (int*)(ws + WS_ROWTOK); for (int i = C.bid * NTHREADS + C.tid; i < MOE_MAXROWS; i += C.G * NTHREADS) rt[i] = -1; }
    for (int i = C.tid; i < DM * 4; i += NTHREADS) { const int k = i >> 2, n = i & 3; const float p = wg[i] * g[k]; const unsigned h = cvt_pk_bf16(p, 0.f) & 0xffffu;
        Wh[(16 + n) * RS + k] = (bf16_t)h; Wl[(16 + n) * RS + k] = (bf16_t)(cvt_pk_bf16(p - bf_lo(h), 0.f) & 0xffffu); }
    for (int i = C.tid; i < DM * 16; i += NTHREADS) { const int k = i >> 4, n = i & 15; const float p = we[i] * g[k]; const unsigned h = cvt_pk_bf16(p, 0.f) & 0xffffu;
        Wh[n * RS + k] = (bf16_t)h; Wl[n * RS + k] = (bf16_t)(cvt_pk_bf16(p - bf_lo(h), 0.f) & 0xffffu); }
    if (C.tid < 32) hist[C.tid] = 0;
    __syncthreads();
    const int rows_per_block = T / C.G;
    const int row0 = C.bid * rows_per_block;
    f32x4* toki = (f32x4*)(ws + WS_TOKI);
    const int fr = lane & 15, fq = lane >> 4;
    for (int rt0 = C.wave * 16; rt0 < rows_per_block; rt0 += NWAVES * 16) {
        const int lr = rt0 + fr, m = row0 + lr;
        const u32x4* xp = (const u32x4*)(hb + (size_t)m * DM) + fq;
        u32x4 xv[32];
#pragma unroll
        for (int kk = 0; kk < 32; ++kk) xv[kk] = xp[kk * 4];
        const f32x4 sq = *(const f32x4*)(SS + (size_t)m * 16 + fq * 4);
        const f32x4 bev = *(const f32x4*)(be + fq * 4);
        const LAS u32x4* whE = (const LAS u32x4*)(Wh + fr * RS) + fq; const LAS u32x4* wlE = (const LAS u32x4*)(Wl + fr * RS) + fq;
        const LAS u32x4* whG = (const LAS u32x4*)(Wh + (16 + (fr & 3)) * RS) + fq; const LAS u32x4* wlG = (const LAS u32x4*)(Wl + (16 + (fr & 3)) * RS) + fq;
        f32x4 aE = {0.f, 0.f, 0.f, 0.f}, aE2 = aE, aG = aE, aG2 = aE;
#pragma unroll
        for (int kk = 0; kk < 32; ++kk) { const bf16x8 xb = __builtin_bit_cast(bf16x8, xv[kk]);
            aE = __builtin_amdgcn_mfma_f32_16x16x32_bf16(__builtin_bit_cast(bf16x8, whE[kk * 4]), xb, aE, 0, 0, 0);
            aE2 = __builtin_amdgcn_mfma_f32_16x16x32_bf16(__builtin_bit_cast(bf16x8, wlE[kk * 4]), xb, aE2, 0, 0, 0);
            aG = __builtin_amdgcn_mfma_f32_16x16x32_bf16(__builtin_bit_cast(bf16x8, whG[kk * 4]), xb, aG, 0, 0, 0);
            aG2 = __builtin_amdgcn_mfma_f32_16x16x32_bf16(__builtin_bit_cast(bf16x8, wlG[kk * 4]), xb, aG2, 0, 0, 0); }
        float ssum = (sq[0] + sq[1]) + (sq[2] + sq[3]); ssum += __shfl_xor(ssum, 16); ssum += __shfl_xor(ssum, 32);
        const float r = rsqrtf(ssum * (1.f / DM) + 1e-6f);
        float gl[4], el[4];
#pragma unroll
        for (int n = 0; n < 4; ++n) { gl[n] = (aG[n] + aG2[n]) * r + bg[n]; el[n] = (aE[n] + aE2[n]) * r + bev[n]; }
        int gi = 0; float gm = gl[0];
#pragma unroll
        for (int n = 1; n < 4; ++n) if (gl[n] > gm) { gm = gl[n]; gi = n; }
        float gs = 0.f;
#pragma unroll
        for (int n = 0; n < 4; ++n) gs += __expf(gl[n] - gm);
        const float gwt = 1.f / gs;
        int e1 = 0; float v1 = el[0];
#pragma unroll
        for (int n = 1; n < 4; ++n) if (el[n] > v1) { v1 = el[n]; e1 = n; }
        int e2 = -1; float v2 = -3.0e38f;
#pragma unroll
        for (int n = 0; n < 4; ++n) if (n != e1 && (e2 < 0 || el[n] > v2)) { e2 = n; v2 = el[n]; }
        const float p2 = __expf(v2 - v1), w1 = gwt / (1.f + p2), w2 = gwt * p2 / (1.f + p2);
        const int ea = e1 < e2 ? e1 : e2, eb = e1 < e2 ? e2 : e1; const float wa = e1 < e2 ? w1 : w2, wb = e1 < e2 ? w2 : w1;
        if (fq == gi) {
            const int bucket = gi * 6 + pair_index(ea, eb);
            const int lp = __hip_atomic_fetch_add(&hist[bucket], 1, __ATOMIC_RELAXED, __HIP_MEMORY_SCOPE_WORKGROUP); tb[lr] = bucket; tp[lr] = lp;
            toki[m] = (f32x4){__int_as_float(bucket), 0.f, wa, wb}; ((float*)(ws + WS_R0))[m] = r; }
    }
    __syncthreads();
    unsigned* cnt = (unsigned*)(ws + WS_CTL) + CW_MOECNT + layer * 32;
    if (C.tid < 24) gbase[C.tid] = (int)atomicAdd(&cnt[C.tid], (unsigned)hist[C.tid]);
    __syncthreads();
    for (int lr = C.tid; lr < rows_per_block; lr += NTHREADS) ((int*)(toki + row0 + lr))[1] = gbase[tb[lr]] + tp[lr];
    __syncthreads();
}
struct MoeTab { int tiles_before[25]; };
__device__ __forceinline__ void moe_load_tab(const unsigned* cnt, LAS int* tabl, int tid) {
    if (tid < 64) { int tiles = 0; if (tid < 24) tiles = (int)((__hip_atomic_load(cnt + tid, __ATOMIC_RELAXED, __HIP_MEMORY_SCOPE_AGENT) + 255u) >> 8);
        int pre = tiles;
#pragma unroll
        for (int d = 1; d < 32; d <<= 1) { const int o = __shfl_up(pre, d); if ((tid & 63) >= d) pre += o; }
        if (tid < 24) tabl[tid] = pre - tiles;
        if (tid == 23) tabl[24] = pre; }
}
__device__ __forceinline__ void phase_moe_scatter(Ctx& C, const Params& prm, int layer) {
    const Params& P = prm; unsigned char* ws = P.ws;
    LAS int* tabl = (LAS int*)C.lds;
    moe_load_tab((const unsigned*)(ws + WS_CTL) + CW_MOECNT + layer * 32, tabl, C.tid);
    __syncthreads();
    const f32x4* toki = (const f32x4*)(ws + WS_TOKI); int* rt = (int*)(ws + WS_ROWTOK); f32x4* wrow = (f32x4*)(ws + WS_WROW); const float* rr = (const float*)(ws + WS_R0);
    for (int t = C.bid * NTHREADS + C.tid; t < T; t += C.G * NTHREADS) { const f32x4 ti = toki[t]; const int bucket = __float_as_int(ti.x), pos = __float_as_int(ti.y);
        const int r = tabl[bucket] * 256 + pos; rt[r] = t; wrow[r] = (f32x4){ti.z, ti.w, rr[t], 0.f}; }
    __syncthreads();
}
namespace pg8 {
struct MoeSched {
    const LAS int* tabl; int G, c, mode; unsigned* ready;
    unsigned* q; LAS int* tk;
    __device__ bool decode(int L, Unit& u) const {
        const int tile = L >> 2, pn = L & 3; int b = 0;
        for (int qq = 1; qq < 24; ++qq) if (tile >= tabl[qq]) b = qq;
        const int grp = b / 6, pr = b % 6; const int ea = pr < 3 ? 0 : (pr < 5 ? 1 : 2), eb = pr < 3 ? pr + 1 : (pr < 5 ? pr - 1 : 3);
        u.arow = tile * 256; u.pn = pn; u.nt = mode == 0 ? 16 : 8;
        if (mode == 0) { const int e = grp * 4 + (pn < 2 ? ea : eb); u.b0 = (e * 512 + (pn & 1) * 256) * 1024 * 2; u.b1 = u.b0; }
        else { u.b0 = ((grp * 4 + ea) * 1024 + pn * 256) * 256 * 2; u.b1 = ((grp * 4 + eb) * 1024 + pn * 256) * 256 * 2 - 4 * 128; }
        return true;
    }
    __device__ bool next(int i, Unit& u) const {
        const int nun = tabl[24] * 4; int s;
        if (i == 0 && mode == 1) s = tk[1];
        else { if (threadIdx.x == 0) tk[0] = (int)atomicAdd(q, 1u);
               asm volatile("s_waitcnt lgkmcnt(0)" ::: "memory"); __builtin_amdgcn_s_barrier(); asm volatile("" ::: "memory"); s = tk[0]; }
        s = __builtin_amdgcn_readfirstlane(s);
        const int L = s - mode * nun;
        if (L >= nun) { if (threadIdx.x == 0) tk[1] = s; asm volatile("s_waitcnt lgkmcnt(0)" ::: "memory"); return false; }
        return decode(L, u);
    }
    __device__ __forceinline__ void done(const Unit& u) const {
        if (mode == 0) { asm volatile("s_waitcnt vmcnt(0)" ::: "memory");
            if ((threadIdx.x & 63) == 0) __hip_atomic_fetch_add(ready + (u.arow >> 8), 1u, __ATOMIC_RELAXED, __HIP_MEMORY_SCOPE_AGENT); } }
    __device__ __forceinline__ void a_ready(const Unit& u) const {
        if (mode == 1) {
            if (threadIdx.x < 64) {
                unsigned spins = 0;
                while ((unsigned)__builtin_amdgcn_readfirstlane((int)__hip_atomic_load(ready + (u.arow >> 8), __ATOMIC_RELAXED, __HIP_MEMORY_SCOPE_AGENT)) < 32u) { __builtin_amdgcn_s_sleep(2); if (++spins > (1u << 24)) break; }
                __builtin_amdgcn_fence(__ATOMIC_ACQUIRE, "agent");
                asm volatile("s_waitcnt vmcnt(0)" ::: "memory");
            }
            asm volatile("" ::: "memory"); __builtin_amdgcn_s_barrier(); asm volatile("" ::: "memory");
        } }
};
struct EpiSwiGLU {
    static constexpr bool PERM = true;
    bf16_t* H; const f32x4* wrow;
    __device__ __forceinline__ void operator()(const f32x4 (&acc)[2][2][4][2], const Unit& u, int wr, int wc, int fr, int fq) const {
        const int row0 = u.arow + wr * 64 + fr, slot = u.pn >> 1, col0 = slot * 256 + (u.pn & 1) * 128 + wc * 32 + 8 * fq;
        float wtv[2][4], rsv[2][4];
#pragma unroll
        for (int ai = 0; ai < 2; ++ai)
#pragma unroll
            for (int m = 0; m < 4; ++m) { const f32x4 w2 = wrow[row0 + ai * HALF + m * 16]; wtv[ai][m] = slot ? w2.y : w2.x; rsv[ai][m] = w2.z; }
#pragma unroll
        for (int ai = 0; ai < 2; ++ai)
#pragma unroll
            for (int m = 0; m < 4; ++m) { const int row = row0 + ai * HALF + m * 16; const float wt = wtv[ai][m], rs = rsv[ai][m];
                float o[8];
#pragma unroll
                for (int n = 0; n < 2; ++n)
#pragma unroll
                    for (int j = 0; j < 4; ++j) { const float gv = acc[ai][0][m][n][j] * rs, uv = acc[ai][1][m][n][j] * rs; o[4 * n + j] = gv * sigmoidf_(gv) * uv * wt; }
                u32x4 w; w.x = cvt_pk_bf16(o[0], o[1]); w.y = cvt_pk_bf16(o[2], o[3]); w.z = cvt_pk_bf16(o[4], o[5]); w.w = cvt_pk_bf16(o[6], o[7]);
                unsigned long long* hp = (unsigned long long*)(H + (size_t)row * 512 + col0);
                __hip_atomic_store(hp, ((unsigned long long)w.y << 32) | w.x, __ATOMIC_RELAXED, __HIP_MEMORY_SCOPE_AGENT); __hip_atomic_store(hp + 1, ((unsigned long long)w.w << 32) | w.z, __ATOMIC_RELAXED, __HIP_MEMORY_SCOPE_AGENT); }
    }
};
template <bool FINAL> struct EpiScatterResB;
template <> struct EpiScatterResB<false> {
    static constexpr bool PERM = true;
    float* outf; bf16_t* hb; float* SS; const int* rowtok;
    __device__ __forceinline__ void operator()(const f32x4 (&acc)[2][2][4][2], const Unit& u, int wr, int wc, int fr, int fq) const {
        const int row0 = u.arow + wr * 64 + fr, col0 = u.pn * BM + wc * 32 + 8 * fq;
        int toks[2][4];
#pragma unroll
        for (int ai = 0; ai < 2; ++ai)
#pragma unroll
            for (int m = 0; m < 4; ++m) toks[ai][m] = rowtok[row0 + ai * HALF + m * 16];
        u32x4 bw[2][4][2];
#pragma unroll
        for (int ai = 0; ai < 2; ++ai)
#pragma unroll
            for (int m = 0; m < 4; ++m) { const int tk = toks[ai][m] < 0 ? 0 : toks[ai][m]; const size_t off = (size_t)tk * DM + col0;
#pragma unroll
                for (int bj = 0; bj < 2; ++bj) bw[ai][m][bj] = *(const u32x4*)(hb + off + bj * HALF); }
#pragma unroll
        for (int ai = 0; ai < 2; ++ai)
#pragma unroll
            for (int m = 0; m < 4; ++m) { const int tok = toks[ai][m]; const int tk = tok < 0 ? 0 : tok; const size_t off = (size_t)tk * DM + col0; f32x4 v[2][2];
#pragma unroll
                for (int bj = 0; bj < 2; ++bj) { const u32x4 w = bw[ai][m][bj];
                    v[bj][0] = (f32x4){bf_lo(w.x), bf_hi(w.x), bf_lo(w.y), bf_hi(w.y)} + acc[ai][bj][m][0]; v[bj][1] = (f32x4){bf_lo(w.z), bf_hi(w.z), bf_lo(w.w), bf_hi(w.w)} + acc[ai][bj][m][1];
                    if (tok >= 0) { u32x4 o; o.x = cvt_pk_bf16(v[bj][0][0], v[bj][0][1]); o.y = cvt_pk_bf16(v[bj][0][2], v[bj][0][3]); o.z = cvt_pk_bf16(v[bj][1][0], v[bj][1][1]); o.w = cvt_pk_bf16(v[bj][1][2], v[bj][1][3]);
                        *(u32x4*)(hb + off + bj * HALF) = o; } }
                const float ss = row_sumsq16(v[0][0], v[0][1], v[1][0], v[1][1]); if (fq == 0 && tok >= 0) SS[(size_t)tok * 16 + u.pn * 4 + wc] = ss; }
    }
};
template <> struct EpiScatterResB<true> {
    static constexpr bool FINAL = true;
    static constexpr bool PERM = false;
    float* outf; bf16_t* hb; float* SS; const int* rowtok;
    __device__ __forceinline__ void operator()(const f32x4 (&acc)[2][2][4][2], const Unit& u, int wr, int wc, int fr, int fq) const {
        const int row0 = u.arow + wr * 64 + fr, col0 = u.pn * BM + wc * 32 + 4 * fq;
        int toks[2][4];
#pragma unroll
        for (int ai = 0; ai < 2; ++ai)
#pragma unroll
            for (int m = 0; m < 4; ++m) toks[ai][m] = rowtok[row0 + ai * HALF + m * 16];
        u32x2 bw[2][4][2][2];
#pragma unroll
        for (int ai = 0; ai < 2; ++ai)
#pragma unroll
            for (int m = 0; m < 4; ++m) { const int tk = toks[ai][m] < 0 ? 0 : toks[ai][m]; const size_t off = (size_t)tk * DM + col0;
#pragma unroll
                for (int bj = 0; bj < 2; ++bj)
#pragma unroll
                    for (int n = 0; n < 2; ++n) bw[ai][m][bj][n] = *(const u32x2*)(hb + off + bj * HALF + n * 16); }
#pragma unroll
        for (int ai = 0; ai < 2; ++ai)
#pragma unroll
            for (int m = 0; m < 4; ++m) { const int tok = toks[ai][m]; const int tk = tok < 0 ? 0 : tok; const size_t off = (size_t)tk * DM + col0; f32x4 v[2][2];
#pragma unroll
                for (int bj = 0; bj < 2; ++bj)
#pragma unroll
                    for (int n = 0; n < 2; ++n) { const u32x2 w = bw[ai][m][bj][n]; v[bj][n] = (f32x4){bf_lo(w.x), bf_hi(w.x), bf_lo(w.y), bf_hi(w.y)} + acc[ai][bj][m][n];
                        if (tok >= 0) { if (FINAL) *(f32x4*)(outf + off + bj * HALF + n * 16) = v[bj][n];
                            else { u32x2 o; o.x = cvt_pk_bf16(v[bj][n][0], v[bj][n][1]); o.y = cvt_pk_bf16(v[bj][n][2], v[bj][n][3]); *(u32x2*)(hb + off + bj * HALF + n * 16) = o; } } }
                if (!FINAL) { const float ss = row_sumsq16(v[0][0], v[0][1], v[1][0], v[1][1]); if (fq == 0 && tok >= 0) SS[(size_t)tok * 16 + u.pn * 4 + wc] = ss; } }
    }
};
}
constexpr size_t HD_PLANE = (size_t)SEQ * 64 * 2;
constexpr size_t AT_QM   = WS_ATT;
constexpr size_t AT_KM   = AT_QM + 8 * HD_PLANE;
constexpr size_t AT_VM   = AT_KM + 8 * HD_PLANE;
constexpr size_t AT_KSEL = AT_VM + 8 * HD_PLANE;
constexpr size_t AT_VSEL = AT_KSEL + 4 * HD_PLANE;
constexpr size_t AT_KWIN = AT_VSEL + 4 * HD_PLANE;
constexpr size_t AT_VWIN = AT_KWIN + 4 * HD_PLANE;
constexpr size_t AT_KC   = AT_VWIN + 4 * HD_PLANE;
constexpr size_t AT_VC   = AT_KC + (size_t)(4096 + 8) * 2048;
constexpr size_t AT_GATES= AT_VC + (size_t)(4096 + 8) * 2048;
constexpr size_t AT_KMSUM= AT_GATES + (size_t)T * 36 * 4;
constexpr size_t AT_KMMEAN = AT_KMSUM + (size_t)NB * 4 * 256 * 64 * 4;
constexpr size_t AT_HC   = AT_KMMEAN + (size_t)NB * 4 * 64 * 64 * 4;
constexpr size_t AT_KCMP = AT_HC + (size_t)2 * (4096 + 8) * 512 * 2;
constexpr size_t AT_VCMP = AT_KCMP + (size_t)4 * 1024 * 64 * 2;
constexpr size_t AT_VMT  = AT_VCMP + (size_t)4 * 1024 * 64 * 2;
constexpr size_t AT_VSELT= AT_VMT + 8 * HD_PLANE;
constexpr size_t AT_VWINT= AT_VSELT + 4 * HD_PLANE;
constexpr size_t AT_VCMPT= AT_VWINT + 4 * HD_PLANE;
constexpr size_t AT_END  = AT_VCMPT + (size_t)4 * 16 * 64 * 64 * 2;
constexpr size_t AT_KMB    = AT_END;
constexpr size_t AT_SELIDX = AT_KMB + (size_t)NB * 4 * 64 * 64 * 2;
constexpr size_t AT_END2   = AT_SELIDX + (size_t)NB * 2 * SEQ * 8;
static_assert(AT_END2 <= WS_END, "workspace");
static_assert(AT_END <= WS_END, "attention tensors overflow the workspace plan");

__device__ __forceinline__ int odd_slice_mode(int s) { return s < 8 ? 2 : s < 12 ? 0 : s < 24 ? 2 : s < 28 ? 1 : s < 30 ? 2 : s < 32 ? 0 : s < 34 ? 2 : 0; }
namespace pg8 {
struct EpiOdd {
    static constexpr bool PERM = true;
    bf16_t* O; int ldc; const LAS float* rl; LAS float* xl; unsigned char* ws; unsigned char* outb;
    const float* gMQ; const float* gMK; const float* gNQ; const float* gKS; const float* gKW;
    __device__ __forceinline__ void operator()(const f32x4 (&acc)[2][2][4][2], const Unit& u, int wr, int wc, int fr, int fq) const {
        asm volatile("" : "+v"(fr), "+v"(fq));
        const int lr0 = wr * 64 + fr, c64 = (wc & 1) * 32 + 8 * fq; const LAS float* rp = rl + u.aux * 256 + lr0;
        const int b = u.arow / SEQ, lu = u.arow % SEQ;
#pragma unroll
        for (int bj = 0; bj < 2; ++bj) { const int s = u.pn * 4 + bj * 2 + (wc >> 1);
            if (odd_slice_mode(s) == 2) {
#pragma unroll
                for (int ai = 0; ai < 2; ++ai)
#pragma unroll
                    for (int m = 0; m < 4; ++m) { const int lrow = lr0 + ai * HALF + m * 16; const float r = rp[ai * HALF + m * 16]; const f32x4 v0 = acc[ai][bj][m][0] * r, v1 = acc[ai][bj][m][1] * r;
                        float ss = ((v0[0] * v0[0] + v0[1] * v0[1]) + (v0[2] * v0[2] + v0[3] * v0[3])) + ((v1[0] * v1[0] + v1[1] * v1[1]) + (v1[2] * v1[2] + v1[3] * v1[3]));
                        ss += __shfl_xor(ss, 16); ss += __shfl_xor(ss, 32);
                        if (fq == 0) xl[(lrow * 2 + bj) * 4 + wc] = ss; __builtin_amdgcn_sched_barrier(0); } } }
        asm volatile("s_waitcnt lgkmcnt(0)" ::: "memory"); __builtin_amdgcn_s_barrier(); asm volatile("" ::: "memory");
#pragma unroll
        for (int bj = 0; bj < 2; ++bj) { const int s = u.pn * 4 + bj * 2 + (wc >> 1), mode = odd_slice_mode(s);
            if (mode == 0) {
#pragma unroll
                for (int ai = 0; ai < 2; ++ai)
#pragma unroll
                    for (int m = 0; m < 4; ++m) { const int row = u.arow + lr0 + ai * HALF + m * 16; float r = rp[ai * HALF + m * 16]; asm volatile("" : "+v"(r)); const f32x4 v0 = acc[ai][bj][m][0] * r, v1 = acc[ai][bj][m][1] * r;
                        u32x4 w; w.x = cvt_pk_bf16(v0[0], v0[1]); w.y = cvt_pk_bf16(v0[2], v0[3]); w.z = cvt_pk_bf16(v1[0], v1[1]); w.w = cvt_pk_bf16(v1[2], v1[3]);
                        *(u32x4*)(O + (size_t)row * ldc + u.pn * BM + bj * HALF + wc * 32 + 8 * fq) = w; __builtin_amdgcn_sched_barrier(0); }
            } else {
                unsigned char* sbase; size_t pitch = 128; const float* gain = nullptr; float extra = 1.f;
                if (s < 4) { sbase = ws + AT_QM + ((size_t)(b * 4 + s) * SEQ + lu) * 128; gain = gMQ; extra = 0.125f * 1.4426950408889634f; }
                else if (s < 8) { sbase = ws + AT_KM + ((size_t)(b * 4 + (s - 4)) * SEQ + lu) * 128; gain = gMK; }
                else if (s < 24) { const int hg = s - 12, hk = hg / 6, g = hg % 6; sbase = outb + (((size_t)(b * 2 + hk) * SEQ + lu) * 6 + g) * 128; pitch = 768; gain = gNQ; extra = 0.125f * 1.4426950408889634f; }
                else { const int kind = (s - 24) >> 1, hk = (s - 24) & 1; const size_t po = ((size_t)(b * 2 + hk) * SEQ + lu) * 128;
                    sbase = ws + (kind == 0 ? AT_KC : kind == 1 ? AT_VC : kind == 2 ? AT_KSEL : AT_KWIN) + po; gain = kind == 2 ? gKS : kind == 4 ? gKW : nullptr; }
                f32x4 g0 = (f32x4){1.f, 1.f, 1.f, 1.f}, g1 = g0;
                if (mode == 2) { g0 = *(const f32x4*)(gain + c64) * extra; g1 = *(const f32x4*)(gain + c64 + 4) * extra; }
#pragma unroll
                for (int ai = 0; ai < 2; ++ai) { f32x4 cs0 = (f32x4){0.f, 0.f, 0.f, 0.f}, cs1 = cs0;
#pragma unroll
                    for (int m = 0; m < 4; ++m) { const int lrow = lr0 + ai * HALF + m * 16; float r = rp[ai * HALF + m * 16]; asm volatile("" : "+v"(r));
                        f32x4 v0 = acc[ai][bj][m][0] * r, v1 = acc[ai][bj][m][1] * r;
                        if (mode == 2) { const float tot = xl[(lrow * 2 + bj) * 4 + (wc & 2)] + xl[(lrow * 2 + bj) * 4 + (wc & 2) + 1]; const float rs = rsqrtf(tot * (1.f / 64.f) + 1e-6f);
                            v0 = v0 * rs * g0; v1 = v1 * rs * g1; }
                        u32x4 w; w.x = cvt_pk_bf16(v0[0], v0[1]); w.y = cvt_pk_bf16(v0[2], v0[3]); w.z = cvt_pk_bf16(v1[0], v1[1]); w.w = cvt_pk_bf16(v1[2], v1[3]);
                        *(u32x4*)(sbase + (size_t)lrow * pitch + c64 * 2) = w;
                        cs0 += v0; cs1 += v1; __builtin_amdgcn_sched_barrier(0); }
                    if (s >= 4 && s < 8) {
#pragma unroll
                        for (int e = 0; e < 4; ++e) { float a0 = cs0[e], a1 = cs1[e];
                            a0 += __shfl_xor(a0, 1); a0 += __shfl_xor(a0, 2); a0 += __shfl_xor(a0, 4); a0 += __shfl_xor(a0, 8);
                            a1 += __shfl_xor(a1, 1); a1 += __shfl_xor(a1, 2); a1 += __shfl_xor(a1, 4); a1 += __shfl_xor(a1, 8); cs0[e] = a0; cs1[e] = a1; }
                        if (fr == 0) { float* kp = (float*)(ws + AT_KMSUM) + ((size_t)(b * 4 + (s - 4)) * 256 + ((lu + wr * 64 + ai * HALF) >> 6)) * 64 + c64; *(f32x4*)kp = cs0; *(f32x4*)(kp + 4) = cs1; } } }
            } }
    }
};
}
__device__ __forceinline__ void load_slice(const bf16_t* p, float (&v)[64]) {
    const u32x4* s = (const u32x4*)p;
#pragma unroll
    for (int q = 0; q < 8; ++q) { const u32x4 w = s[q]; v[8 * q] = bf_lo(w.x); v[8 * q + 1] = bf_hi(w.x); v[8 * q + 2] = bf_lo(w.y); v[8 * q + 3] = bf_hi(w.y); v[8 * q + 4] = bf_lo(w.z); v[8 * q + 5] = bf_hi(w.z); v[8 * q + 6] = bf_lo(w.w); v[8 * q + 7] = bf_hi(w.w); }
}
__device__ __forceinline__ void store_slice(bf16_t* p, const float (&v)[64]) {
    u32x4* d = (u32x4*)p;
#pragma unroll
    for (int q = 0; q < 8; ++q) { u32x4 w; w.x = cvt_pk_bf16(v[8 * q], v[8 * q + 1]); w.y = cvt_pk_bf16(v[8 * q + 2], v[8 * q + 3]); w.z = cvt_pk_bf16(v[8 * q + 4], v[8 * q + 5]); w.w = cvt_pk_bf16(v[8 * q + 6], v[8 * q + 7]); d[q] = w; }
}
__device__ __forceinline__ void head_norm(float (&v)[64], const float* gain, float extra) {
    { int z = 0; asm volatile("" : "+v"(z)); gain += z; }
    float s = 0.f;
#pragma unroll
    for (int i = 0; i < 64; ++i) s += v[i] * v[i];
    const float r = rsqrtf(s * (1.f / 64.f) + 1e-6f) * extra;
#pragma unroll
    for (int i = 0; i < 64; ++i) v[i] = v[i] * r * gain[i];
}
__device__ __forceinline__ void phase_post1(Ctx& C, const Params& prm, int rank, int nranks) {
    unsigned char* ws = prm.ws; const bf16_t* proj = (const bf16_t*)(ws + WS_PROJ);
    const int gw = rank * NWAVES + C.wave, NGW = nranks * NWAVES, lane = C.lane, rr = lane >> 3, c = lane & 7;
    LAS bf16_t* tl = (LAS bf16_t*)(C.lds + C.wave * 9216);
    for (int it = gw; it < (T / 64) * 9; it += NGW) {
        const int q9 = it % 9, s = q9 < 4 ? 8 + q9 : (q9 < 6 ? 26 + q9 : (q9 < 8 ? 28 + q9 : 36)), ci = it / 9, tok0 = ci * 64, b = tok0 / SEQ, l0 = tok0 % SEQ;
        if (s == 36) {
            const int tok = tok0 + lane; const u32x4* gp = (const u32x4*)(proj + (size_t)tok * IN_ODD_P + 2304); float g[40];
#pragma unroll
            for (int q = 0; q < 5; ++q) { const u32x4 w = gp[q]; g[8 * q] = bf_lo(w.x); g[8 * q + 1] = bf_hi(w.x); g[8 * q + 2] = bf_lo(w.y); g[8 * q + 3] = bf_hi(w.y); g[8 * q + 4] = bf_lo(w.z); g[8 * q + 5] = bf_hi(w.z); g[8 * q + 6] = bf_lo(w.w); g[8 * q + 7] = bf_hi(w.w); }
            f32x4* o = (f32x4*)((float*)(ws + AT_GATES) + (size_t)tok * 36);
#pragma unroll
            for (int q = 0; q < 9; ++q) o[q] = (f32x4){sigmoidf_(g[4 * q]), sigmoidf_(g[4 * q + 1]), sigmoidf_(g[4 * q + 2]), sigmoidf_(g[4 * q + 3])};
            continue;
        }
        size_t dst = 0; size_t pitch = 128; const float* gain = nullptr; float extra = 1.f; bool qn = false, tr = false;
        if (s < 4) { dst = AT_QM + ((size_t)(b * 4 + s) * SEQ + l0) * 128; gain = prm.in[I_MQN]; extra = 0.125f * 1.4426950408889634f; }
        else if (s < 8) { dst = AT_KM + ((size_t)(b * 4 + (s - 4)) * SEQ + l0) * 128; gain = prm.in[I_MKN]; }
        else if (s < 12) { dst = AT_VMT + ((size_t)(b * 4 + (s - 8)) * 256 + (l0 >> 6)) * 8192; tr = true; }
        else if (s < 24) { const int hg = s - 12, hk = hg / 6, g = hg % 6; dst = (((size_t)(b * 2 + hk) * SEQ + l0) * 6 + g) * 128; pitch = 768; qn = true; gain = prm.in[I_NQN]; extra = 0.125f * 1.4426950408889634f; }
        else { const int kind = (s - 24) >> 1, hk = (s - 24) & 1; const size_t po = ((size_t)(b * 2 + hk) * SEQ + l0) * 128, tb = ((size_t)(b * 2 + hk) * 256 + (l0 >> 6)) * 8192;
            if (kind == 0) dst = AT_KC + po; else if (kind == 1) dst = AT_VC + po; else if (kind == 2) { dst = AT_KSEL + po; gain = prm.in[I_NKSN]; }
            else if (kind == 3) { dst = AT_VSELT + tb; tr = true; } else if (kind == 4) { dst = AT_KWIN + po; gain = prm.in[I_NKWN]; } else { dst = AT_VWINT + tb; tr = true; } }
        float v[8][8];
        { const bf16_t* src = proj + (size_t)(tok0 + rr) * IN_ODD_P + 64 * s + 8 * c;
#pragma unroll
          for (int i = 0; i < 8; ++i) { const u32x4 w = *(const u32x4*)(src + (size_t)i * 8 * IN_ODD_P);
              v[i][0] = bf_lo(w.x); v[i][1] = bf_hi(w.x); v[i][2] = bf_lo(w.y); v[i][3] = bf_hi(w.y); v[i][4] = bf_lo(w.z); v[i][5] = bf_hi(w.z); v[i][6] = bf_lo(w.w); v[i][7] = bf_hi(w.w); } }
        if (gain) { float gg[8];
#pragma unroll
            for (int e = 0; e < 8; ++e) gg[e] = gain[8 * c + e] * extra;
#pragma unroll
            for (int i = 0; i < 8; ++i) { float ss = 0.f;
#pragma unroll
                for (int e = 0; e < 8; ++e) ss += v[i][e] * v[i][e];
                ss += __shfl_xor(ss, 1); ss += __shfl_xor(ss, 2); ss += __shfl_xor(ss, 4);
                const float rs = rsqrtf(ss * (1.f / 64.f) + 1e-6f);
#pragma unroll
                for (int e = 0; e < 8; ++e) v[i][e] = v[i][e] * rs * gg[e]; } }
        unsigned char* obase = (qn ? (unsigned char*)prm.out : ws) + dst;
        if (!tr) {
#pragma unroll
            for (int i = 0; i < 8; ++i) { u32x4 w; w.x = cvt_pk_bf16(v[i][0], v[i][1]); w.y = cvt_pk_bf16(v[i][2], v[i][3]); w.z = cvt_pk_bf16(v[i][4], v[i][5]); w.w = cvt_pk_bf16(v[i][6], v[i][7]);
                *(u32x4*)(obase + (size_t)(i * 8 + rr) * pitch + 16 * c) = w; }
        } else {
            LDS_WAIT();
#pragma unroll
            for (int i = 0; i < 8; ++i)
#pragma unroll
                for (int e = 0; e < 8; ++e) tl[(8 * c + e) * 72 + i * 8 + rr] = f2bf(v[i][e]);
            LDS_WAIT();
#pragma unroll
            for (int i = 0; i < 8; ++i) { const int d = i * 8 + rr; const u32x4 w = *(const LAS u32x4*)(tl + d * 72 + 8 * c); *(u32x4*)(obase + (size_t)d * 128 + 16 * c) = w; }
        }
        if (s >= 4 && s < 8) {
            float cs[8];
#pragma unroll
            for (int e = 0; e < 8; ++e) { float a = 0.f;
#pragma unroll
                for (int i = 0; i < 8; ++i) a += v[i][e];
                a += __shfl_xor(a, 8); a += __shfl_xor(a, 16); a += __shfl_xor(a, 32); cs[e] = a; }
            if (rr == 0) { float* kp = (float*)(ws + AT_KMSUM) + ((size_t)(b * 4 + (s - 4)) * 256 + (l0 >> 6)) * 64 + 8 * c;
                *(f32x4*)kp = (f32x4){cs[0], cs[1], cs[2], cs[3]}; *(f32x4*)(kp + 4) = (f32x4){cs[4], cs[5], cs[6], cs[7]}; }
        }
    }
    for (int i = rank * NTHREADS + C.tid; i < 2 * 8 * 1024 / 2; i += nranks * NTHREADS) { const int kv = i / (8 * 512), o = i % (8 * 512);
        ((unsigned*)(ws + (kv ? AT_VC : AT_KC) + (size_t)4096 * 2048))[o] = 0u; }
}
__device__ __forceinline__ void kmmean_items(Ctx& C, const Params& prm) {
    unsigned char* ws = prm.ws; const float* ks = (const float*)(ws + AT_KMSUM); float* km = (float*)(ws + AT_KMMEAN);
    for (int i = C.bid * NTHREADS + C.tid; i < NB * 4 * 64 * 64; i += C.G * NTHREADS) { const int d = i & 63, j = (i >> 6) & 63, bh = i >> 12;
        const float* p = ks + ((size_t)bh * 256 + 4 * j) * 64 + d; const float mv = ((p[0] + p[64]) + (p[128] + p[192])) * (1.f / 256.f); km[i] = mv; ((bf16_t*)(ws + AT_KMB))[i] = f2bf(mv); }
}
namespace pg8 {
struct C1Sched { int G, c;
    __device__ bool next(int i, Unit& u) const { const int L = i * G + c; if (L >= 64) return false; const int kv = L >> 5, tile = (L >> 1) & 15, pn = L & 1;
        u.arow = kv * (4096 + 8) + tile * 256; u.pn = pn; u.b0 = (kv * 512 + pn * 256) * 1024 * 2; u.b1 = u.b0; u.nt = 16; return true; } };
}
__device__ __forceinline__ void phase_c2(Ctx& C, const Params& prm) {
    unsigned char* ws = prm.ws; const int lane = C.lane, fr = lane & 15, fq = lane >> 4, tile = C.bid * NWAVES + C.wave;
    if (C.bid >= 64) return;
    const int kv = C.bid >> 5;
    constexpr int WS2 = 264;
    LAS bf16_t* w2t = (LAS bf16_t*)C.lds;
    { const float* w2 = prm.in[kv ? I_W2V : I_W2K];
      for (int i = C.tid; i < 256 * 64; i += NTHREADS) { const int k = i >> 6, n = i & 63; w2t[n * WS2 + k] = f2bf(w2[i]); } }
    __syncthreads();
    const int r0 = tile * 16, rr0 = r0 & 4095, row = rr0 + fr, n = row & 1023;
    const bf16_t* p0 = (const bf16_t*)(ws + AT_HC) + ((size_t)kv * (4096 + 8) + row) * 512 + fq * 8; const bf16_t* p1 = p0 + 512 + 256;
    const float* b1 = (const float*)(ws + WS_C1B) + kv * 256 + fq * 8;
    u32x4 ha[8], hc[8];
#pragma unroll
    for (int kk = 0; kk < 8; ++kk) { ha[kk] = *(const u32x4*)(p0 + kk * 32); hc[kk] = *(const u32x4*)(p1 + kk * 32); }
    f32x4 acc[4];
#pragma unroll
    for (int nt = 0; nt < 4; ++nt) acc[nt] = (f32x4){0.f, 0.f, 0.f, 0.f};
#pragma unroll
    for (int kk = 0; kk < 8; ++kk) {
        const f32x4 ba = *(const f32x4*)(b1 + kk * 32), bb = *(const f32x4*)(b1 + kk * 32 + 4); const u32x4 a = ha[kk], c = hc[kk];
        u32x4 hw;
        hw.x = cvt_pk_bf16(gelu_tanh(bf_lo(a.x) + bf_lo(c.x) + ba.x), gelu_tanh(bf_hi(a.x) + bf_hi(c.x) + ba.y));
        hw.y = cvt_pk_bf16(gelu_tanh(bf_lo(a.y) + bf_lo(c.y) + ba.z), gelu_tanh(bf_hi(a.y) + bf_hi(c.y) + ba.w));
        hw.z = cvt_pk_bf16(gelu_tanh(bf_lo(a.z) + bf_lo(c.z) + bb.x), gelu_tanh(bf_hi(a.z) + bf_hi(c.z) + bb.y));
        hw.w = cvt_pk_bf16(gelu_tanh(bf_lo(a.w) + bf_lo(c.w) + bb.z), gelu_tanh(bf_hi(a.w) + bf_hi(c.w) + bb.w));
        const bf16x8 hb8 = __builtin_bit_cast(bf16x8, hw);
#pragma unroll
        for (int nt = 0; nt < 4; ++nt) { const bf16x8 wf = *(const LAS bf16x8*)(w2t + (nt * 16 + fr) * WS2 + kk * 32 + fq * 8);
            acc[nt] = __builtin_amdgcn_mfma_f32_16x16x32_bf16(wf, hb8, acc[nt], 0, 0, 0); }
    }
    if (n == 1023) return;
    if (kv == 0) { float ss = 0.f;
#pragma unroll
        for (int nt = 0; nt < 4; ++nt) ss += (acc[nt][0] * acc[nt][0] + acc[nt][1] * acc[nt][1]) + (acc[nt][2] * acc[nt][2] + acc[nt][3] * acc[nt][3]);
        ss += __shfl_xor(ss, 16); ss += __shfl_xor(ss, 32);
        const float rs = rsqrtf(ss * (1.f / 64.f) + 1e-6f);
#pragma unroll
        for (int nt = 0; nt < 4; ++nt) { const f32x4 gn = *(const f32x4*)(prm.in[I_NKCN] + nt * 16 + 4 * fq); const f32x4 v = acc[nt] * rs * gn;
            u32x2 o; o.x = cvt_pk_bf16(v[0], v[1]); o.y = cvt_pk_bf16(v[2], v[3]); *(u32x2*)((bf16_t*)(ws + AT_KCMP) + (size_t)row * 64 + nt * 16 + 4 * fq) = o; } }
    else { bf16_t* vt = (bf16_t*)(ws + AT_VCMPT) + (((size_t)(row >> 10) * 16 + (n >> 6)) * 64) * 64 + (n & 63);
#pragma unroll
        for (int nt = 0; nt < 4; ++nt)
#pragma unroll
            for (int j = 0; j < 4; ++j) vt[(size_t)(nt * 16 + 4 * fq + j) * 64] = f2bf(acc[nt][j]); }
}

__device__ __forceinline__ float exp2f_(float x) { return __builtin_amdgcn_exp2f(x); }
template <int NH> struct AttnState { float m[NH], l[NH], o[NH]; };
template <int NH> __device__ __forceinline__ void attn_init(AttnState<NH>& st) {
#pragma unroll
    for (int h = 0; h < NH; ++h) { st.m[h] = -1e30f; st.l[h] = 0.f; st.o[h] = 0.f; } }
template <int NH> __device__ __forceinline__ void qk_scores(const bf16_t* krow, const LAS float* q_, float (&s)[NH]) {
    unsigned qa = (unsigned)(size_t)q_;
    const u32x4* kp = (const u32x4*)krow; u32x4 kw[8];
#pragma unroll
    for (int i = 0; i < 8; ++i) kw[i] = kp[i];
#pragma unroll
    for (int h = 0; h < NH; ++h) s[h] = 0.f;
#pragma unroll
    for (int i = 0; i < 8; ++i) { const u32x4 w = kw[i];
        asm volatile("" : "+v"(qa), "+v"(s[0]));
        const LAS float* q = (const LAS float*)(size_t)qa;
        const float k0 = bf_lo(w.x), k1 = bf_hi(w.x), k2 = bf_lo(w.y), k3 = bf_hi(w.y), k4 = bf_lo(w.z), k5 = bf_hi(w.z), k6 = bf_lo(w.w), k7 = bf_hi(w.w);
#pragma unroll
        for (int h = 0; h < NH; ++h) { const LAS f32x4* qp = (const LAS f32x4*)(q + h * 64 + 8 * i); const f32x4 q0 = qp[0], q1 = qp[1];
            s[h] += k0 * q0.x + k1 * q0.y + k2 * q0.z + k3 * q0.w + k4 * q1.x + k5 * q1.y + k6 * q1.z + k7 * q1.w; } }
}
template <int NH> __device__ __forceinline__ void pv_accum(const bf16_t* Vbase, int vrow, int nk, const float (&p)[NH], float (&o)[NH], int lane) {
#pragma unroll 4
    for (int j = 0; j < nk; ++j) { const int r = __builtin_amdgcn_readlane(vrow, j); const float v = bf2f(Vbase[(size_t)r * 64 + lane]);
#pragma unroll
        for (int h = 0; h < NH; ++h) o[h] += __builtin_bit_cast(float, __builtin_amdgcn_readlane(__builtin_bit_cast(int, p[h]), j)) * v; }
}
template <int NH> __device__ __forceinline__ void attn_chunk(const bf16_t* Kbase, const bf16_t* Vbase, int row, bool valid, int nk, const LAS float* q, AttnState<NH>& st, int lane) {
    float s[NH]; qk_scores<NH>(Kbase + (size_t)row * 64, q, s);
    float p[NH];
#pragma unroll
    for (int h = 0; h < NH; ++h) { const float sv = valid ? s[h] : -1e30f; const float mn = fmaxf(st.m[h], wave_max(sv));
        const float alpha = exp2f_(st.m[h] - mn); p[h] = valid ? exp2f_(sv - mn) : 0.f;
        st.l[h] = st.l[h] * alpha + wave_sum(p[h]); st.o[h] *= alpha; st.m[h] = mn; }
    pv_accum<NH>(Vbase, row, nk, p, st.o, lane);
}
__device__ __forceinline__ void wave_argmax(float& v, int& i) {
#pragma unroll
    for (int o = 1; o < 64; o <<= 1) { const float ov = __shfl_xor(v, o); const int oi = __shfl_xor(i, o); if (ov > v || (ov == v && oi < i)) { v = ov; i = oi; } }
}

__device__ __forceinline__ void phase_attn_baseline(Ctx& C, const Params& prm) {
    unsigned char* ws = prm.ws; const int gw = C.bid * NWAVES + C.wave, NGW = C.G * NWAVES, lane = C.lane;
    LAS float* qs = (LAS float*)(C.lds + C.wave * 4096); LAS float* pslc = qs + 6 * 64;
    bf16_t* A2 = (bf16_t*)(ws + WS_A2);
    const float NEG = -1e30f;
    for (int it = gw; it < NB * 4 * SEQ; it += NGW) {
        const int l = it % SEQ, bh = it / SEQ, b = bh >> 2, h = bh & 3, tok = b * SEQ + l;
        { const bf16_t* qp = (const bf16_t*)(ws + AT_QM) + ((size_t)bh * SEQ + l) * 64; qs[lane] = bf2f(qp[lane]); }
        LDS_WAIT();
        const int cur = l >> 8;
        float gate = NEG;
        if (lane < cur) { const f32x4* mp = (const f32x4*)((const float*)(ws + AT_KMMEAN) + ((size_t)bh * 64 + lane) * 64); const LAS f32x4* qp = (const LAS f32x4*)qs; float a = 0.f;
#pragma unroll
            for (int i = 0; i < 16; ++i) { const f32x4 m = mp[i], q = qp[i]; a += m.x * q.x + m.y * q.y + m.z * q.z + m.w * q.w; }
            gate = a; }
        int sel[3]; bool selv[3];
#pragma unroll
        for (int r = 0; r < 3; ++r) { float bv = gate; int bi = lane; wave_argmax(bv, bi); sel[r] = bi; selv[r] = bv > -1e29f; if (lane == bi) gate = -3e38f; }
        AttnState<1> st; attn_init<1>(st);
        const bf16_t* Km = (const bf16_t*)(ws + AT_KM) + (size_t)bh * SEQ * 64; const bf16_t* Vm = (const bf16_t*)(ws + AT_VM) + (size_t)bh * SEQ * 64;
#pragma unroll 1
        for (int p0 = cur * 256; p0 <= l; p0 += 64) { const int pos = p0 + lane; const int nk = (l - p0 + 1) < 64 ? (l - p0 + 1) : 64;
            attn_chunk<1>(Km, Vm, pos <= l ? pos : l, pos <= l, nk, qs, st, lane); }
#pragma unroll 1
        for (int r = 0; r < 3; ++r) { int sj = sel[0]; bool sv = selv[0];
#pragma unroll
            for (int q = 1; q < 3; ++q) { sj = (r == q) ? sel[q] : sj; sv = (r == q) ? selv[q] : sv; }
            if (!sv) continue;
            for (int c = 0; c < 4; ++c) attn_chunk<1>(Km, Vm, sj * 256 + c * 64 + lane, true, 64, qs, st, lane); }
        A2[(size_t)tok * DM + h * 64 + lane] = f2bf(st.l[0] > 0.f ? st.o[0] / st.l[0] : 0.f);
        LDS_WAIT();
    }
}
typedef float f32x16 __attribute__((ext_vector_type(16)));
constexpr int KL_STRIDE = 144, VL_STRIDE = 136, KL_BYTES = 64 * KL_STRIDE, VL_BYTES = 64 * VL_STRIDE, KV_BYTES = KL_BYTES + VL_BYTES;
struct RowTile { f32x16 O[2]; float m, l; bf16x8 Q[4]; };
__device__ __forceinline__ void rt_init(RowTile& R) {
#pragma unroll
    for (int i = 0; i < 16; ++i) { R.O[0][i] = 0.f; R.O[1][i] = 0.f; }
    R.m = 0.f; R.l = 0.f;
}
__device__ __forceinline__ void rt_load_q(RowTile& R, const bf16_t* qrow, int lane) {
    const int h = lane >> 5;
#pragma unroll
    for (int ks = 0; ks < 4; ++ks) R.Q[ks] = *(const bf16x8*)(qrow + ks * 16 + h * 8);
}
__device__ __forceinline__ float max3f(float a, float b, float c) { float r; asm("v_max3_f32 %0, %1, %2, %3" : "=v"(r) : "v"(a), "v"(b), "v"(c)); return r; }
template <bool MASK, bool FIX>
__device__ __forceinline__ void flash_step_(RowTile& R, const LAS unsigned char* Kl, const LAS unsigned char* Vl, int kidx0, int lo, int hi, int lane) {
    const int r = lane & 31, h = lane >> 5;
    f32x16 S[2];
    const float nm = -R.m;
#pragma unroll
    for (int kt = 0; kt < 2; ++kt) {
#pragma unroll
        for (int i = 0; i < 16; ++i) S[kt][i] = nm;
#pragma unroll
        for (int ks = 0; ks < 4; ++ks) { const bf16x8 a = *(const LAS bf16x8*)(Kl + (kt * 32 + r) * KL_STRIDE + ks * 32 + h * 16);
            S[kt] = __builtin_amdgcn_mfma_f32_32x32x16_bf16(a, R.Q[ks], S[kt], 0, 0, 0); } }
    if (MASK) { const int lo2 = lo - kidx0 - 4 * h, hi2 = hi - kidx0 - 4 * h;
#pragma unroll
        for (int kt = 0; kt < 2; ++kt)
#pragma unroll
            for (int i = 0; i < 16; ++i) { const int c = kt * 32 + (i & 3) + 8 * (i >> 2); S[kt][i] = (c > lo2 && c <= hi2) ? S[kt][i] : -1e30f; } }
    if (!FIX) {
    float mx = max3f(S[0][0], S[0][1], S[0][2]);
#pragma unroll
    for (int i = 3; i < 15; i += 2) mx = max3f(mx, S[0][i], S[0][i + 1]);
    mx = max3f(mx, S[0][15], S[1][0]);
#pragma unroll
    for (int i = 1; i < 15; i += 2) mx = max3f(mx, S[1][i], S[1][i + 1]);
    mx = fmaxf(mx, S[1][15]);
    mx = fmaxf(mx, __shfl_xor(mx, 32));
    const bool fresh = R.l == 0.f, live = mx > -1e29f;
    if (__any(live && (mx > 8.f || (fresh && mx < -8.f)))) {
        const float d = live ? (fresh ? mx : fmaxf(mx, 0.f)) : 0.f, alpha = exp2f_(-d);
        R.m += d; R.l *= alpha;
#pragma unroll
        for (int i = 0; i < 16; ++i) { R.O[0][i] *= alpha; R.O[1][i] *= alpha; S[0][i] -= d; S[1][i] -= d; } }
    }
    f32x2 sum2 = (f32x2){0.f, 0.f};
#pragma unroll
    for (int kt = 0; kt < 2; ++kt)
#pragma unroll
        for (int i = 0; i < 16; i += 2) { const float p0 = exp2f_(S[kt][i]), p1 = exp2f_(S[kt][i + 1]); S[kt][i] = p0; S[kt][i + 1] = p1; sum2 += (f32x2){p0, p1}; }
    float sum = sum2.x + sum2.y;
    sum += __shfl_xor(sum, 32);
    R.l += sum;
#pragma unroll
    for (int kt = 0; kt < 2; ++kt)
#pragma unroll
        for (int s = 0; s < 2; ++s) {
            u32x4 pw; pw.x = cvt_pk_bf16(S[kt][8 * s + 0], S[kt][8 * s + 1]); pw.y = cvt_pk_bf16(S[kt][8 * s + 2], S[kt][8 * s + 3]);
            pw.z = cvt_pk_bf16(S[kt][8 * s + 4], S[kt][8 * s + 5]); pw.w = cvt_pk_bf16(S[kt][8 * s + 6], S[kt][8 * s + 7]);
            const bf16x8 pb = __builtin_bit_cast(bf16x8, pw);
#pragma unroll
            for (int dt = 0; dt < 2; ++dt) { const LAS unsigned char* vp = Vl + (dt * 32 + r) * VL_STRIDE + (kt * 32 + 16 * s + 4 * h) * 2;
                const u32x2 v0 = *(const LAS u32x2*)vp, v1 = *(const LAS u32x2*)(vp + 16);
                u32x4 vw; vw.x = v0.x; vw.y = v0.y; vw.z = v1.x; vw.w = v1.y;
                R.O[dt] = __builtin_amdgcn_mfma_f32_32x32x16_bf16(__builtin_bit_cast(bf16x8, vw), pb, R.O[dt], 0, 0, 0); } }
}
template <bool MASK>
__device__ __forceinline__ void flash_step(RowTile& R, const LAS unsigned char* Kl, const LAS unsigned char* Vl, int kidx0, int lo, int hi, int lane, bool fix) {
    if (fix) {
        if (MASK) { if (__all((kidx0 > lo) && (kidx0 + 63 <= hi))) flash_step_<false, true>(R, Kl, Vl, kidx0, lo, hi, lane); else flash_step_<true, true>(R, Kl, Vl, kidx0, lo, hi, lane); }
        else flash_step_<false, true>(R, Kl, Vl, kidx0, lo, hi, lane);
    } else {
        if (MASK) { if (__all((kidx0 > lo) && (kidx0 + 63 <= hi))) flash_step_<false, false>(R, Kl, Vl, kidx0, lo, hi, lane); else flash_step_<true, false>(R, Kl, Vl, kidx0, lo, hi, lane); }
        else flash_step_<false, false>(R, Kl, Vl, kidx0, lo, hi, lane);
    }
}
constexpr float ATT_FIX_BOUND = 80.f;
__device__ __forceinline__ bool attn_fixed_ref(const float* gq, const float* gk, int lane) {
    const float mq = wave_max(fabsf(gq[lane])), mk = wave_max(fabsf(gk[lane]));
    const float bnd = 64.f * 0.125f * 1.4426950408889634f * mq * mk;
    return __builtin_amdgcn_readfirstlane((int)(bnd < ATT_FIX_BOUND)) != 0;
}
struct KVRegs { u32x4 k, v; };
template <int NT> __device__ __forceinline__ void kv_issue(KVRegs& g, const bf16_t* ktile, const bf16_t* vtile, int t) {
    g.k = *(const u32x4*)((const char*)ktile + t * 16); g.v = *(const u32x4*)((const char*)vtile + t * 16);
}
__device__ __forceinline__ void kv_commit(const KVRegs& g, LAS unsigned char* Kl, LAS unsigned char* Vl, int t) {
    const int row = t >> 3, c16 = t & 7;
    *(LAS u32x4*)(Kl + row * KL_STRIDE + c16 * 16) = g.k;
    LAS u32x2* vp = (LAS u32x2*)(Vl + row * VL_STRIDE + c16 * 16); vp[0] = (u32x2){g.v.x, g.v.y}; vp[1] = (u32x2){g.v.z, g.v.w};
}

constexpr size_t PS_O   = WS_PROJ;
constexpr size_t PS_LSE = PS_O + (size_t)NB * 2 * SEQ * 30 * 64;
static_assert(PS_LSE + (size_t)NB * 2 * SEQ * 30 * 4 <= WS_A2, "partials overflow the projection buffer");
__device__ __forceinline__ unsigned pack_fp8x4(float a, float b, float c, float d) { int w = __builtin_amdgcn_cvt_pk_fp8_f32(a, b, 0, false); w = __builtin_amdgcn_cvt_pk_fp8_f32(c, d, w, true); return (unsigned)w; }
__device__ __forceinline__ void unpack_fp8x4(unsigned w, float (&o)[4]) { const f32x2 lo = __builtin_amdgcn_cvt_pk_f32_fp8((int)w, false), hi = __builtin_amdgcn_cvt_pk_f32_fp8((int)w, true); o[0] = lo.x; o[1] = lo.y; o[2] = hi.x; o[3] = hi.y; }
__device__ __forceinline__ void store_partial(const RowTile& R, unsigned char* po, float* plse, size_t row, bool active, int lane) {
    const int h = lane >> 5; const float inv = 1.f / R.l;
    if (active) {
#pragma unroll
        for (int dt = 0; dt < 2; ++dt)
#pragma unroll
            for (int q4 = 0; q4 < 4; ++q4) *(unsigned*)(po + row * 64 + dt * 32 + 8 * q4 + 4 * h) = pack_fp8x4(R.O[dt][4 * q4] * inv, R.O[dt][4 * q4 + 1] * inv, R.O[dt][4 * q4 + 2] * inv, R.O[dt][4 * q4 + 3] * inv);
        if (h == 0) plse[row] = R.m + __builtin_amdgcn_logf(R.l); }
}
template <int NS>
__device__ __forceinline__ void merge_partials(RowTile& R, const unsigned char* po, const float* plse, size_t row0, size_t rstride, unsigned have, int lane) {
    const int h = lane >> 5; float lp[NS]; unsigned w[NS][8];
#pragma unroll
    for (int k = 0; k < NS; ++k) { const bool on = (have >> k) & 1u; const size_t row = row0 + (on ? (size_t)k * rstride : 0);
        lp[k] = on ? plse[row] : -1e30f;
#pragma unroll
        for (int dt = 0; dt < 2; ++dt)
#pragma unroll
            for (int q4 = 0; q4 < 4; ++q4) { const unsigned x = *(const unsigned*)(po + row * 64 + dt * 32 + 8 * q4 + 4 * h); w[k][dt * 4 + q4] = on ? x : 0u; } }
    float mn = R.m;
#pragma unroll
    for (int k = 0; k < NS; ++k) mn = fmaxf(mn, lp[k]);
    const float a = exp2f_(R.m - mn); R.l *= a; R.m = mn;
#pragma unroll
    for (int i = 0; i < 16; ++i) { R.O[0][i] *= a; R.O[1][i] *= a; }
#pragma unroll
    for (int k = 0; k < NS; ++k) { const float bsc = exp2f_(lp[k] - mn);
        R.l += bsc;
#pragma unroll
        for (int dt = 0; dt < 2; ++dt)
#pragma unroll
            for (int q4 = 0; q4 < 4; ++q4) { float v[4]; unpack_fp8x4(w[k][dt * 4 + q4], v);
#pragma unroll
                for (int j = 0; j < 4; ++j) R.O[dt][4 * q4 + j] += v[j] * bsc; } }
}

__device__ __forceinline__ void nsa_gather_item(int it, int& bh, int& j, int& s0, int& tmin) {
    bh = it / 628; const int f = it - bh * 628;
    const int seg = (f >= 61) + (f >= 186) + (f >= 375);
    const int pre = seg == 0 ? 0 : seg == 1 ? 61 : seg == 2 ? 186 : 375;
    j = 1 + (f - pre); s0 = seg * 4096; tmin = 64 * (j + 2);
}
__device__ __forceinline__ void phase_nsa_gather(Ctx& C, const Params& prm) {
    unsigned char* ws = prm.ws; const int lane = C.lane, r = lane & 31, w = C.wave, tid = C.tid;
    const bool fix = attn_fixed_ref(prm.in[I_NQN], prm.in[I_NKSN], lane);
    constexpr int SLOT = KV_BYTES + 16384;
    LAS unsigned* cnts = (LAS unsigned*)(C.lds + 2 * SLOT);
    const int nit = 4 * 628;
    unsigned* qctr = (unsigned*)(ws + WS_CTL) + CW_Q15A; LAS int* tkt = (LAS int*)(cnts + 4);
    if (tid == 0) { tkt[0] = (int)atomicAdd(qctr, 1u); tkt[1] = (int)atomicAdd(qctr, 1u); }
    if (tid < 3) cnts[tid] = 0u;
    __syncthreads();
    int it = __builtin_amdgcn_readfirstlane(tkt[0]), itn = __builtin_amdgcn_readfirstlane(tkt[1]);
    KVRegs gr; unsigned long long pks[8]; int bh, j, s0, tmin;
#define NSG_ISSUE(it_) do { nsa_gather_item(it_, bh, j, s0, tmin); \
        kv_issue<512>(gr, (const bf16_t*)(ws + AT_KSEL) + ((size_t)bh * SEQ + (size_t)j * 64) * 64, (const bf16_t*)(ws + AT_VSELT) + ((size_t)bh * 256 + j) * 4096, tid); \
        const unsigned char* _sx = (const unsigned char*)(ws + AT_SELIDX) + (size_t)bh * SEQ * 8; \
        _Pragma("unroll") for (int k_ = 0; k_ < 8; ++k_) pks[k_] = *(const unsigned long long*)(_sx + (size_t)(s0 + tid + 512 * k_) * 8); } while (0)
    if (it < nit) NSG_ISSUE(it);
    __syncthreads();
    for (int kk = 0; it < nit; ++kk) {
        LAS unsigned char* slot = C.lds + (kk & 1) * SLOT; LAS unsigned* list = (LAS unsigned*)(slot + KV_BYTES); LAS unsigned* cnt = cnts + (kk % 3);
        const int cbh = bh, cj = j;
        int tnew = 0; if (tid == 0) tnew = (int)atomicAdd(qctr, 1u);
        kv_commit(gr, slot, slot + KL_BYTES, tid);
        { int sl8[8]; int mine = 0; unsigned long long mk[8];
#pragma unroll
          for (int k = 0; k < 8; ++k) { const int t = s0 + tid + 512 * k; int sl = -1;
              if (t >= tmin) {
#pragma unroll
                  for (int x = 0; x < 5; ++x) if ((int)((pks[k] >> (8 * x)) & 0xffull) == cj) sl = x; }
              sl8[k] = sl; mk[k] = __ballot(sl >= 0); mine += __popcll(mk[k]); }
          unsigned base = 0u;
          if (lane == 0 && mine > 0) base = __hip_atomic_fetch_add(cnt, (unsigned)mine, __ATOMIC_RELAXED, __HIP_MEMORY_SCOPE_WORKGROUP);
          base = (unsigned)__builtin_amdgcn_readfirstlane((int)base);
#pragma unroll
          for (int k = 0; k < 8; ++k) { if (sl8[k] >= 0) list[base + __popcll(mk[k] & ((1ull << lane) - 1ull))] = (unsigned)(s0 + tid + 512 * k) | ((unsigned)sl8[k] << 16); base += __popcll(mk[k]); } }
        if (itn < nit) NSG_ISSUE(itn);
        if (tid == 0) { cnts[(kk + 1) % 3] = 0u; tkt[(kk + 2) % 3] = tnew; }
        __syncthreads();
        const int n = (int)*cnt, ntile = (n + 4) / 5;
        for (int tile = w; tile < ntile; tile += NWAVES) {
            const int e5 = r / 6, gg = r - 6 * e5, e = tile * 5 + (e5 < 5 ? e5 : 0); const bool active = (r < 30) && (e < n);
            const unsigned ent = list[active ? e : tile * 5]; const int t = (int)(ent & 0xffffu), sl = (int)(ent >> 16), g = active ? gg : 0;
            RowTile R; rt_init(R); rt_load_q(R, (const bf16_t*)prm.out + (((size_t)cbh * SEQ + t) * 6 + g) * 64, lane);
            flash_step<false>(R, slot, slot + KL_BYTES, 0, 0, 0, lane, fix);
            store_partial(R, ws + PS_O, (float*)(ws + PS_LSE), ((size_t)cbh * SEQ + t) * 30 + sl * 6 + g, active, lane);
        }
        it = itn; itn = __builtin_amdgcn_readfirstlane(tkt[(kk + 2) % 3]);
    }
#undef NSG_ISSUE
}

__device__ __forceinline__ void nsa_out_add(const RowTile& R, bf16_t* orow, float scale, int h) {
#pragma unroll
    for (int dt = 0; dt < 2; ++dt)
#pragma unroll
        for (int q4 = 0; q4 < 4; ++q4) { u32x2* pp = (u32x2*)(orow + dt * 32 + 8 * q4 + 4 * h); const u32x2 old = *pp;
            u32x2 nw; nw.x = cvt_pk_bf16(bf_lo(old.x) + scale * R.O[dt][4 * q4 + 0], bf_hi(old.x) + scale * R.O[dt][4 * q4 + 1]);
            nw.y = cvt_pk_bf16(bf_lo(old.y) + scale * R.O[dt][4 * q4 + 2], bf_hi(old.y) + scale * R.O[dt][4 * q4 + 3]); *pp = nw; }
}
__device__ __forceinline__ void phase_nsa_dense(Ctx& C, const Params& prm) {
    unsigned char* ws = prm.ws; const int lane = C.lane, r = lane & 31, h = lane >> 5, w = C.wave, hk = w >> 2, wq = w & 3;
    const bool fix = attn_fixed_ref(prm.in[I_NQN], prm.in[I_NKWN], lane) && attn_fixed_ref(prm.in[I_NQN], prm.in[I_NKSN], lane);
    const int t256 = C.tid & 255, shk = C.tid >> 8;
    bf16_t* A2 = (bf16_t*)(ws + WS_A2);
    for (int u = C.bid; u < NB * (SEQ / 64); u += C.G) {
        const int b = u / (SEQ / 64), qi = u % (SEQ / 64), t0 = qi * 64;
        const int tile_lo = qi >= 8 ? qi - 8 : 0, nwin = qi - tile_lo + 1, nf = qi >= 2 ? 3 : qi + 1, nseq = nwin + nf;
        const size_t plane = (size_t)(b * 2 + shk) * SEQ * 64;
        const bf16_t* Kw = (const bf16_t*)(ws + AT_KWIN) + plane; const bf16_t* Vw = (const bf16_t*)(ws + AT_VWINT) + plane;
        const bf16_t* Ks = (const bf16_t*)(ws + AT_KSEL) + plane; const bf16_t* Vs = (const bf16_t*)(ws + AT_VSELT) + plane;
#define NSA_SEQ_TILE(i) ((i) < nwin ? tile_lo + (i) : ((i) == nwin ? 0 : ((i) == nseq - 1 ? qi : qi - 1)))
#define NSA_SEQ_ISSUE(i) do { const int _t = NSA_SEQ_TILE(i); const bf16_t* _k = ((i) < nwin ? Kw : Ks) + (size_t)_t * 4096; const bf16_t* _v = ((i) < nwin ? Vw : Vs) + (size_t)_t * 4096; \
            kv_issue<256>(g0, _k, _v, t256); kv_issue<256>(g1, _k, _v, t256 + 256); } while (0)
#pragma unroll 1
        for (int pass = 0; pass < 3; ++pass) {
            const int rt = wq * 3 + pass, g = rt >> 1, half = rt & 1, l = t0 + half * 32 + r, tok = b * SEQ + l;
            RowTile R; rt_init(R); rt_load_q(R, (const bf16_t*)prm.out + (((size_t)(b * 2 + hk) * SEQ + l) * 6 + g) * 64, lane);
            const float* gt = (const float*)(ws + AT_GATES) + (size_t)tok * 36 + hk * 6 + g;
            bf16_t* orow = A2 + (size_t)tok * DM + 256 + (hk * 6 + g) * 64;
            KVRegs g0, g1;
            __syncthreads();
            NSA_SEQ_ISSUE(0);
            { LAS unsigned char* base = C.lds + shk * KV_BYTES; kv_commit(g0, base, base + KL_BYTES, t256); kv_commit(g1, base, base + KL_BYTES, t256 + 256); }
            __syncthreads();
#pragma unroll 1
            for (int i = 0; i < nseq; ++i) {
                const bool more = i + 1 < nseq;
                if (more) NSA_SEQ_ISSUE(i + 1);
                const LAS unsigned char* cb = C.lds + ((i & 1) * 2 + hk) * KV_BYTES;
                if (i == nwin) { nsa_out_add(R, orow, gt[24] / R.l, h); rt_init(R); }
                const int tile = NSA_SEQ_TILE(i);
                flash_step<true>(R, cb, cb + KL_BYTES, tile * 64, i < nwin ? l - 512 : -(1 << 30), l, lane, fix);
                if (more) { LAS unsigned char* nb = C.lds + (((i + 1) & 1) * 2 + shk) * KV_BYTES; kv_commit(g0, nb, nb + KL_BYTES, t256); kv_commit(g1, nb, nb + KL_BYTES, t256 + 256); }
                __syncthreads();
            }
            { const unsigned long long pk = *(const unsigned long long*)((const unsigned char*)(ws + AT_SELIDX) + ((size_t)(b * 2 + hk) * SEQ + l) * 8); unsigned have = 0u;
#pragma unroll
              for (int sl = 0; sl < 5; ++sl) have |= (((pk >> (8 * sl)) & 0xffull) != 0ull) ? (1u << sl) : 0u;
              merge_partials<5>(R, ws + PS_O, (const float*)(ws + PS_LSE), ((size_t)(b * 2 + hk) * SEQ + l) * 30 + g, 6, have, lane); }
            nsa_out_add(R, orow, gt[12] / R.l, h);
        }
#undef NSA_SEQ_TILE
#undef NSA_SEQ_ISSUE
    }
}

constexpr int PSLC_LD = 257;
__device__ __forceinline__ void qk_tile(f32x16 (&S)[2], const RowTile& R, float init, const LAS unsigned char* Kl, int lane) {
    const int r = lane & 31, h = lane >> 5;
#pragma unroll
    for (int kt = 0; kt < 2; ++kt) {
#pragma unroll
        for (int i = 0; i < 16; ++i) S[kt][i] = init;
#pragma unroll
        for (int ks = 0; ks < 4; ++ks) { const bf16x8 a = *(const LAS bf16x8*)(Kl + (kt * 32 + r) * KL_STRIDE + ks * 32 + h * 16);
            S[kt] = __builtin_amdgcn_mfma_f32_32x32x16_bf16(a, R.Q[ks], S[kt], 0, 0, 0); } }
}
template <bool FIX>
__device__ __forceinline__ void cmp_stats_step(RowTile& R, const LAS unsigned char* Kl, int kidx0, int hi, int lane) {
    const int h = lane >> 5; f32x16 S[2]; qk_tile(S, R, -R.m, Kl, lane);
    const bool full = __all(kidx0 + 63 <= hi);
    if (!full) {
#pragma unroll
        for (int kt = 0; kt < 2; ++kt)
#pragma unroll
            for (int i = 0; i < 16; ++i) { const int kidx = kidx0 + kt * 32 + (i & 3) + 8 * (i >> 2) + 4 * h; S[kt][i] = kidx <= hi ? S[kt][i] : -1e30f; } }
    if (!FIX) {
    float mx = max3f(S[0][0], S[0][1], S[0][2]);
#pragma unroll
    for (int i = 3; i < 15; i += 2) mx = max3f(mx, S[0][i], S[0][i + 1]);
    mx = max3f(mx, S[0][15], S[1][0]);
#pragma unroll
    for (int i = 1; i < 15; i += 2) mx = max3f(mx, S[1][i], S[1][i + 1]);
    mx = fmaxf(mx, S[1][15]);
    mx = fmaxf(mx, __shfl_xor(mx, 32));
    const bool fresh = R.l == 0.f, live = mx > -1e29f;
    if (__any(live && (mx > 8.f || (fresh && mx < -8.f)))) {
        const float d = live ? (fresh ? mx : fmaxf(mx, 0.f)) : 0.f; R.m += d; R.l *= exp2f_(-d);
#pragma unroll
        for (int i = 0; i < 16; ++i) { S[0][i] -= d; S[1][i] -= d; } }
    }
    f32x2 sum2 = (f32x2){0.f, 0.f};
#pragma unroll
    for (int kt = 0; kt < 2; ++kt)
#pragma unroll
        for (int i = 0; i < 16; i += 2) sum2 += (f32x2){exp2f_(S[kt][i]), exp2f_(S[kt][i + 1])};
    float sum = sum2.x + sum2.y; sum += __shfl_xor(sum, 32);
    R.l += sum;
}
__device__ __forceinline__ void cmp_norm_step(RowTile& R, float inv_l, const LAS unsigned char* Kl, const LAS unsigned char* Vl, int kidx0, int hi, LAS unsigned* prow, int lane) {
    const int r = lane & 31, h = lane >> 5; f32x16 S[2]; qk_tile(S, R, -R.m, Kl, lane);
    const bool full = __all(kidx0 + 63 <= hi);
#pragma unroll
    for (int kt = 0; kt < 2; ++kt)
#pragma unroll
        for (int i = 0; i < 16; ++i) { const int kidx = kidx0 + kt * 32 + (i & 3) + 8 * (i >> 2) + 4 * h; S[kt][i] = (full || kidx <= hi) ? exp2f_(S[kt][i]) : 0.f; }
    const float fx = inv_l * 16777216.f;
#pragma unroll
    for (int kt = 0; kt < 2; ++kt)
#pragma unroll
        for (int c = 0; c < 4; ++c) { const int jb = (kidx0 >> 2) + kt * 8 + 2 * c + h; const float s4 = (S[kt][4 * c] + S[kt][4 * c + 1]) + (S[kt][4 * c + 2] + S[kt][4 * c + 3]);
            __hip_atomic_fetch_add(prow + jb, (unsigned)(s4 * fx + 0.5f), __ATOMIC_RELAXED, __HIP_MEMORY_SCOPE_WORKGROUP);
            if (jb + 1 < 256) __hip_atomic_fetch_add(prow + jb + 1, (unsigned)(S[kt][4 * c + 3] * fx + 0.5f), __ATOMIC_RELAXED, __HIP_MEMORY_SCOPE_WORKGROUP); }
#pragma unroll
    for (int kt = 0; kt < 2; ++kt)
#pragma unroll
        for (int s = 0; s < 2; ++s) {
            u32x4 pw; pw.x = cvt_pk_bf16(S[kt][8 * s + 0], S[kt][8 * s + 1]); pw.y = cvt_pk_bf16(S[kt][8 * s + 2], S[kt][8 * s + 3]);
            pw.z = cvt_pk_bf16(S[kt][8 * s + 4], S[kt][8 * s + 5]); pw.w = cvt_pk_bf16(S[kt][8 * s + 6], S[kt][8 * s + 7]);
            const bf16x8 pb = __builtin_bit_cast(bf16x8, pw);
#pragma unroll
            for (int dt = 0; dt < 2; ++dt) { const LAS unsigned char* vp = Vl + (dt * 32 + r) * VL_STRIDE + (kt * 32 + 16 * s + 4 * h) * 2;
                const u32x2 v0 = *(const LAS u32x2*)vp, v1 = *(const LAS u32x2*)(vp + 16);
                u32x4 vw; vw.x = v0.x; vw.y = v0.y; vw.z = v1.x; vw.w = v1.y;
                R.O[dt] = __builtin_amdgcn_mfma_f32_32x32x16_bf16(__builtin_bit_cast(bf16x8, vw), pb, R.O[dt], 0, 0, 0); } }
}
__device__ __forceinline__ float rowmax32(const f32x16 (&S)[2]) {
    float mx = max3f(S[0][0], S[0][1], S[0][2]);
#pragma unroll
    for (int i = 3; i < 15; i += 2) mx = max3f(mx, S[0][i], S[0][i + 1]);
    mx = max3f(mx, S[0][15], S[1][0]);
#pragma unroll
    for (int i = 1; i < 15; i += 2) mx = max3f(mx, S[1][i], S[1][i + 1]);
    return fmaxf(mx, S[1][15]);
}
template <bool FIX>
__device__ __forceinline__ void cmp_stats_step2(RowTile& Ra, RowTile& Rb, const LAS unsigned char* Kl, int kidx0, int hia, int hib, int lane) {
    const int r = lane & 31, h = lane >> 5; f32x16 Sa[2], Sb[2];
    const float nma = -Ra.m, nmb = -Rb.m;
#pragma unroll
    for (int kt = 0; kt < 2; ++kt) {
#pragma unroll
        for (int i = 0; i < 16; ++i) { Sa[kt][i] = nma; Sb[kt][i] = nmb; }
#pragma unroll
        for (int ks = 0; ks < 4; ++ks) { const bf16x8 a = *(const LAS bf16x8*)(Kl + (kt * 32 + r) * KL_STRIDE + ks * 32 + h * 16);
            Sa[kt] = __builtin_amdgcn_mfma_f32_32x32x16_bf16(a, Ra.Q[ks], Sa[kt], 0, 0, 0); Sb[kt] = __builtin_amdgcn_mfma_f32_32x32x16_bf16(a, Rb.Q[ks], Sb[kt], 0, 0, 0); } }
    if (!__all(kidx0 + 63 <= hia && kidx0 + 63 <= hib)) {
#pragma unroll
        for (int kt = 0; kt < 2; ++kt)
#pragma unroll
            for (int i = 0; i < 16; ++i) { const int kidx = kidx0 + kt * 32 + (i & 3) + 8 * (i >> 2) + 4 * h; Sa[kt][i] = kidx <= hia ? Sa[kt][i] : -1e30f; Sb[kt][i] = kidx <= hib ? Sb[kt][i] : -1e30f; } }
    if (!FIX) {
    float mxa = rowmax32(Sa), mxb = rowmax32(Sb);
    mxa = fmaxf(mxa, __shfl_xor(mxa, 32)); mxb = fmaxf(mxb, __shfl_xor(mxb, 32));
    const bool fa = Ra.l == 0.f, la = mxa > -1e29f, fb = Rb.l == 0.f, lb = mxb > -1e29f;
    if (__any((la && (mxa > 8.f || (fa && mxa < -8.f))) || (lb && (mxb > 8.f || (fb && mxb < -8.f))))) {
        const float da = la ? (fa ? mxa : fmaxf(mxa, 0.f)) : 0.f, db = lb ? (fb ? mxb : fmaxf(mxb, 0.f)) : 0.f;
        Ra.m += da; Ra.l *= exp2f_(-da); Rb.m += db; Rb.l *= exp2f_(-db);
#pragma unroll
        for (int i = 0; i < 16; ++i) { Sa[0][i] -= da; Sa[1][i] -= da; Sb[0][i] -= db; Sb[1][i] -= db; } }
    }
    f32x2 s2a = (f32x2){0.f, 0.f}, s2b = (f32x2){0.f, 0.f};
#pragma unroll
    for (int kt = 0; kt < 2; ++kt)
#pragma unroll
        for (int i = 0; i < 16; i += 2) { s2a += (f32x2){exp2f_(Sa[kt][i]), exp2f_(Sa[kt][i + 1])}; s2b += (f32x2){exp2f_(Sb[kt][i]), exp2f_(Sb[kt][i + 1])}; }
    float sa = s2a.x + s2a.y, sb = s2b.x + s2b.y; sa += __shfl_xor(sa, 32); sb += __shfl_xor(sb, 32);
    Ra.l += sa; Rb.l += sb;
}
__device__ __forceinline__ void phase_nsa_cmp(Ctx& C, const Params& prm) {
    unsigned char* ws = prm.ws; const int w = C.wave;
    const bool fix = attn_fixed_ref(prm.in[I_NQN], prm.in[I_NKCN], C.lane);
    LAS unsigned* pslc = (LAS unsigned*)(C.lds + 2 * KV_BYTES);
    bf16_t* A2 = (bf16_t*)(ws + WS_A2);
    for (int u = C.bid; u < NB * 2 * (SEQ / 64); u += C.G) {
        int tid = C.tid; asm volatile("" : "+v"(tid));
        const int lane = tid & 63, r = lane & 31, h = lane >> 5;
        const int bh = u / (SEQ / 64), qr = u % (SEQ / 64), qi = (bh & 1) ? (SEQ / 64 - 1 - qr) : qr, b = bh >> 1, hk = bh & 1, t0 = qi * 64;
        const int nt = ((4 * qi + 2) >> 6) + 1;
        const bf16_t* Kc = (const bf16_t*)(ws + AT_KCMP) + (size_t)bh * 1024 * 64; const bf16_t* Vc = (const bf16_t*)(ws + AT_VCMPT) + (size_t)bh * 16 * 4096;
        __syncthreads();
        for (int i = tid; i < 64 * PSLC_LD; i += NTHREADS) pslc[i] = 0u;
        const int gA = w % 6, hA = w / 6, gB = (2 + w) % 6;
        {
            RowTile R0, R1; R0.m = 0.f; R0.l = 0.f; R1.m = 0.f; R1.l = 0.f;
            const int l0 = t0 + hA * 32 + r, l1 = t0 + 32 + r;
            rt_load_q(R0, (const bf16_t*)prm.out + (((size_t)bh * SEQ + l0) * 6 + gA) * 64, lane);
            if (w < 4) rt_load_q(R1, (const bf16_t*)prm.out + (((size_t)bh * SEQ + l1) * 6 + gB) * 64, lane);
            {
                KVRegs gr;
                __syncthreads();
                kv_issue<512>(gr, Kc, Vc, tid); kv_commit(gr, C.lds, C.lds + KL_BYTES, tid);
                __syncthreads();
#pragma unroll 1
                for (int i = 0; i < nt; ++i) {
                    const bool more = i + 1 < nt;
                    if (more) kv_issue<512>(gr, Kc + (size_t)(i + 1) * 4096, Vc + (size_t)(i + 1) * 4096, tid);
                    const LAS unsigned char* cb = C.lds + (i & 1) * KV_BYTES;
                    if (fix) { if (w < 4) cmp_stats_step2<true>(R0, R1, cb, i * 64, (l0 - 31) >> 4, (l1 - 31) >> 4, lane); else cmp_stats_step<true>(R0, cb, i * 64, (l0 - 31) >> 4, lane); }
                    else { if (w < 4) cmp_stats_step2<false>(R0, R1, cb, i * 64, (l0 - 31) >> 4, (l1 - 31) >> 4, lane); else cmp_stats_step<false>(R0, cb, i * 64, (l0 - 31) >> 4, lane); }
                    if (more) { LAS unsigned char* nb = C.lds + ((i + 1) & 1) * KV_BYTES; kv_commit(gr, nb, nb + KL_BYTES, tid); }
                    __syncthreads();
                }
            }
#pragma unroll 1
            for (int half = 0; half < 2; ++half) {
                RowTile R; R.m = half ? R1.m : R0.m; R.l = 0.f;
#pragma unroll
                for (int q = 0; q < 4; ++q) R.Q[q] = half ? R1.Q[q] : R0.Q[q];
#pragma unroll
                for (int q = 0; q < 16; ++q) { R.O[0][q] = 0.f; R.O[1][q] = 0.f; }
                const float lsum = half ? R1.l : R0.l, il = lsum > 0.f ? 1.f / lsum : 0.f;
                const int l = half ? l1 : l0, tok = b * SEQ + l, hi = (l - 31) >> 4, g = half ? gB : gA; const bool act = half == 0 || w < 4;
                KVRegs gr;
                __syncthreads();
                kv_issue<512>(gr, Kc, Vc, tid); kv_commit(gr, C.lds, C.lds + KL_BYTES, tid);
                __syncthreads();
#pragma unroll 1
                for (int i = 0; i < nt; ++i) {
                    const bool more = i + 1 < nt;
                    if (more) kv_issue<512>(gr, Kc + (size_t)(i + 1) * 4096, Vc + (size_t)(i + 1) * 4096, tid);
                    const LAS unsigned char* cb = C.lds + (i & 1) * KV_BYTES;
                    if (act) cmp_norm_step(R, il, cb, cb + KL_BYTES, i * 64, hi, pslc + (l - t0) * PSLC_LD, lane);
                    if (more) { LAS unsigned char* nb = C.lds + ((i + 1) & 1) * KV_BYTES; kv_commit(gr, nb, nb + KL_BYTES, tid); }
                    __syncthreads();
                }
                if (act) {
                    const float gc = ((const float*)(ws + AT_GATES))[(size_t)tok * 36 + hk * 6 + g] * il;
                    bf16_t* orow = A2 + (size_t)tok * DM + 256 + (hk * 6 + g) * 64;
#pragma unroll
                    for (int dt = 0; dt < 2; ++dt)
#pragma unroll
                        for (int q4 = 0; q4 < 4; ++q4) { u32x2 nw; nw.x = cvt_pk_bf16(gc * R.O[dt][4 * q4 + 0], gc * R.O[dt][4 * q4 + 1]); nw.y = cvt_pk_bf16(gc * R.O[dt][4 * q4 + 2], gc * R.O[dt][4 * q4 + 3]);
                            *(u32x2*)(orow + dt * 32 + 8 * q4 + 4 * h) = nw; }
                }
            }
        }
        {
            LAS float* tk = (LAS float*)(C.lds);
            float v0 = -1e30f, v1 = -1e30f, v2 = -1e30f, v3 = -1e30f, v4 = -1e30f; int i0 = 0, i1 = 0, i2 = 0, i3 = 0, i4 = 0;
#define TOPK_INSERT(a_, j_) do { const float _a = (a_); const int _j = (j_);     \
            const bool _c0 = _a > v0, _c1 = _a > v1, _c2 = _a > v2, _c3 = _a > v3, _c4 = _a > v4; \
            v4 = _c3 ? v3 : (_c4 ? _a : v4); i4 = _c3 ? i3 : (_c4 ? _j : i4); v3 = _c2 ? v2 : (_c3 ? _a : v3); i3 = _c2 ? i2 : (_c3 ? _j : i3); \
            v2 = _c1 ? v1 : (_c2 ? _a : v2); i2 = _c1 ? i1 : (_c2 ? _j : i2); v1 = _c0 ? v0 : (_c1 ? _a : v1); i1 = _c0 ? i0 : (_c1 ? _j : i1); \
            v0 = _c0 ? _a : v0; i0 = _c0 ? _j : i0; } while (0)
            const int jlo = w * 32 < 1 ? 1 : w * 32, jhi = (w * 32 + 31) < (qi - 2) ? (w * 32 + 31) : (qi - 2);
            for (int j = jlo; j <= jhi; ++j) TOPK_INSERT((float)pslc[lane * PSLC_LD + j], j);
            __syncthreads();
            tk[((w * 5 + 0) * 2 + 0) * 64 + lane] = v0; tk[((w * 5 + 0) * 2 + 1) * 64 + lane] = __int_as_float(i0);
            tk[((w * 5 + 1) * 2 + 0) * 64 + lane] = v1; tk[((w * 5 + 1) * 2 + 1) * 64 + lane] = __int_as_float(i1);
            tk[((w * 5 + 2) * 2 + 0) * 64 + lane] = v2; tk[((w * 5 + 2) * 2 + 1) * 64 + lane] = __int_as_float(i2);
            tk[((w * 5 + 3) * 2 + 0) * 64 + lane] = v3; tk[((w * 5 + 3) * 2 + 1) * 64 + lane] = __int_as_float(i3);
            tk[((w * 5 + 4) * 2 + 0) * 64 + lane] = v4; tk[((w * 5 + 4) * 2 + 1) * 64 + lane] = __int_as_float(i4);
            __syncthreads();
            if (w == 0) {
                for (int ww = 1; ww < 8; ++ww)
#pragma unroll
                    for (int q = 0; q < 5; ++q) { const float a = tk[((ww * 5 + q) * 2 + 0) * 64 + lane]; const int j = __float_as_int(tk[((ww * 5 + q) * 2 + 1) * 64 + lane]); TOPK_INSERT(a, j); }
                unsigned long long packed = 0ull;
                if (v0 > -1e29f) packed |= (unsigned long long)(unsigned)i0;
                if (v1 > -1e29f) packed |= (unsigned long long)(unsigned)i1 << 8;
                if (v2 > -1e29f) packed |= (unsigned long long)(unsigned)i2 << 16;
                if (v3 > -1e29f) packed |= (unsigned long long)(unsigned)i3 << 24;
                if (v4 > -1e29f) packed |= (unsigned long long)(unsigned)i4 << 32;
                *(unsigned long long*)((unsigned char*)(ws + AT_SELIDX) + ((size_t)bh * SEQ + t0 + lane) * 8) = packed;
            }
#undef TOPK_INSERT
        }
    }
}

constexpr size_t PM_O     = PS_LSE + (size_t)NB * 2 * SEQ * 30 * 4;
static_assert(PM_O + (size_t)NB * 4 * SEQ * 3 * 64 <= WS_A2, "MoBA partials overflow the projection buffer");
constexpr size_t PM_LSE   = AT_END2;
constexpr size_t AT_MIDX  = PM_LSE + (size_t)NB * 4 * SEQ * 4 * 4;
constexpr size_t AT_END3  = AT_MIDX + (size_t)NB * 4 * SEQ * 4;
static_assert(AT_END3 <= WS_END, "workspace");
__device__ __forceinline__ void moba_gate_items(Ctx& C, const Params& prm) {
    unsigned char* ws = prm.ws; const int gw = C.bid * NWAVES + C.wave, NGW = C.G * NWAVES, lane = C.lane, r = lane & 31, h = lane >> 5;
    for (int it = gw; it < NB * 4 * (SEQ / 64); it += NGW) {
        const int c64 = it % (SEQ / 64), bh = it / (SEQ / 64), cur = (c64 * 64) >> 8;
        unsigned* out = (unsigned*)(ws + AT_MIDX) + (size_t)bh * SEQ + c64 * 64;
        if (cur == 0) { out[lane] = 0xffffffffu; continue; }
        const bf16_t* km = (const bf16_t*)(ws + AT_KMB) + (size_t)bh * 64 * 64;
#pragma unroll 1
        for (int tt = 0; tt < 2; ++tt) {
            const bf16_t* qrow = (const bf16_t*)(ws + AT_QM) + ((size_t)bh * SEQ + c64 * 64 + tt * 32 + r) * 64;
            bf16x8 qf[4];
#pragma unroll
            for (int ks = 0; ks < 4; ++ks) qf[ks] = *(const bf16x8*)(qrow + ks * 16 + h * 8);
            float v0 = -3e38f, v1 = -3e38f, v2 = -3e38f; int i0 = 255, i1 = 255, i2 = 255;
#define GATE_INS(a_, j_) do { const float _a = (a_); const int _j = (j_);     \
            const bool _c0 = _a > v0 || (_a == v0 && _j < i0), _c1 = _a > v1 || (_a == v1 && _j < i1), _c2 = _a > v2 || (_a == v2 && _j < i2); \
            v2 = _c1 ? v1 : (_c2 ? _a : v2); i2 = _c1 ? i1 : (_c2 ? _j : i2); v1 = _c0 ? v0 : (_c1 ? _a : v1); i1 = _c0 ? i0 : (_c1 ? _j : i1); v0 = _c0 ? _a : v0; i0 = _c0 ? _j : i0; } while (0)
#pragma unroll
            for (int jt = 0; jt < 2; ++jt) {
                if (jt * 32 < cur) {
                    f32x16 S;
#pragma unroll
                    for (int i = 0; i < 16; ++i) S[i] = 0.f;
#pragma unroll
                    for (int ks = 0; ks < 4; ++ks) { const bf16x8 a = *(const bf16x8*)(km + (size_t)(jt * 32 + r) * 64 + ks * 16 + h * 8);
                        S = __builtin_amdgcn_mfma_f32_32x32x16_bf16(a, qf[ks], S, 0, 0, 0); }
#pragma unroll
                    for (int i = 0; i < 16; ++i) { const int j = jt * 32 + (i & 3) + 8 * (i >> 2) + 4 * h; if (j < cur) GATE_INS(S[i], j); }
                }
            }
            { const float pv0 = __shfl_xor(v0, 32), pv1 = __shfl_xor(v1, 32), pv2 = __shfl_xor(v2, 32); const int pi0 = __shfl_xor(i0, 32), pi1 = __shfl_xor(i1, 32), pi2 = __shfl_xor(i2, 32);
              if (pi0 != 255) GATE_INS(pv0, pi0); if (pi1 != 255) GATE_INS(pv1, pi1); if (pi2 != 255) GATE_INS(pv2, pi2); }
            if (h == 0) out[tt * 32 + r] = (unsigned)i0 | ((unsigned)i1 << 8) | ((unsigned)i2 << 16) | 0xff000000u;
#undef GATE_INS
        }
    }
}
__device__ __forceinline__ void moba_gather_item(int it, int& bh, int& j, int& s0, int& tmin) {
    bh = it / 280; const int f = it - bh * 280;
    const int seg = (f >= 7) + (f >= 22) + (f >= 45) + (f >= 76) + (f >= 115) + (f >= 162) + (f >= 217);
    const int pre = seg == 0 ? 0 : seg == 1 ? 7 : seg == 2 ? 22 : seg == 3 ? 45 : seg == 4 ? 76 : seg == 5 ? 115 : seg == 6 ? 162 : 217;
    j = f - pre; s0 = seg * 2048; tmin = 256 * (j + 1);
}
__device__ __forceinline__ void phase_moba_gather(Ctx& C, const Params& prm) {
    unsigned char* ws = prm.ws; const int lane = C.lane, r = lane & 31, w = C.wave, tid = C.tid;
    const bool fix = attn_fixed_ref(prm.in[I_MQN], prm.in[I_MKN], lane);
    constexpr int MKV = 4 * KV_BYTES, SLOT = MKV + 8192;
    LAS unsigned* cnts = (LAS unsigned*)(C.lds + 2 * SLOT); LAS int* tkt = (LAS int*)(cnts + 4);
    const int nit = 8 * 280;
    unsigned* qctr = (unsigned*)(ws + WS_CTL) + CW_Q15B;
    if (tid == 0) { tkt[0] = (int)atomicAdd(qctr, 1u); tkt[1] = (int)atomicAdd(qctr, 1u); }
    if (tid < 3) cnts[tid] = 0u;
    __syncthreads();
    int it = __builtin_amdgcn_readfirstlane(tkt[0]), itn = __builtin_amdgcn_readfirstlane(tkt[1]);
    KVRegs g0, g1, g2, g3; unsigned pks[4]; int bh, j, s0, tmin;
#define MBG_ISSUE(it_) do { moba_gather_item(it_, bh, j, s0, tmin); \
        const bf16_t* _km = (const bf16_t*)(ws + AT_KM) + ((size_t)bh * SEQ + (size_t)(4 * j) * 64) * 64; const bf16_t* _vm = (const bf16_t*)(ws + AT_VMT) + ((size_t)bh * 256 + 4 * j) * 4096; \
        kv_issue<512>(g0, _km, _vm, tid); kv_issue<512>(g1, _km + 4096, _vm + 4096, tid); kv_issue<512>(g2, _km + 2 * 4096, _vm + 2 * 4096, tid); kv_issue<512>(g3, _km + 3 * 4096, _vm + 3 * 4096, tid); \
        const unsigned* _mx = (const unsigned*)(ws + AT_MIDX) + (size_t)bh * SEQ; \
        _Pragma("unroll") for (int k_ = 0; k_ < 4; ++k_) pks[k_] = _mx[s0 + tid + 512 * k_]; } while (0)
    if (it < nit) MBG_ISSUE(it);
    __syncthreads();
    for (int kk = 0; it < nit; ++kk) {
        LAS unsigned char* slot = C.lds + (kk & 1) * SLOT; LAS unsigned* list = (LAS unsigned*)(slot + MKV); LAS unsigned* cnt = cnts + (kk % 3);
        const int cbh = bh, cj = j;
        int tnew = 0; if (tid == 0) tnew = (int)atomicAdd(qctr, 1u);
        kv_commit(g0, slot, slot + KL_BYTES, tid); kv_commit(g1, slot + KV_BYTES, slot + KV_BYTES + KL_BYTES, tid);
        kv_commit(g2, slot + 2 * KV_BYTES, slot + 2 * KV_BYTES + KL_BYTES, tid); kv_commit(g3, slot + 3 * KV_BYTES, slot + 3 * KV_BYTES + KL_BYTES, tid);
#pragma unroll
        for (int k = 0; k < 4; ++k) { const int t = s0 + tid + 512 * k;
            if (t >= tmin) {
#pragma unroll
                for (int sl = 0; sl < 3; ++sl) if ((int)((pks[k] >> (8 * sl)) & 0xffu) == cj) { const unsigned pos = __hip_atomic_fetch_add(cnt, 1u, __ATOMIC_RELAXED, __HIP_MEMORY_SCOPE_WORKGROUP); list[pos] = (unsigned)t | ((unsigned)sl << 16); } } }
        if (itn < nit) MBG_ISSUE(itn);
        if (tid == 0) { cnts[(kk + 1) % 3] = 0u; tkt[(kk + 2) % 3] = tnew; }
        __syncthreads();
        const int n = (int)*cnt, ntile = (n + 31) >> 5;
        for (int tile = w; tile < ntile; tile += NWAVES) {
            const int e = tile * 32 + r; const bool active = e < n;
            const unsigned ent = list[active ? e : tile * 32]; const int t = (int)(ent & 0xffffu), sl = (int)(ent >> 16);
            RowTile R; rt_init(R); rt_load_q(R, (const bf16_t*)(ws + AT_QM) + ((size_t)cbh * SEQ + t) * 64, lane);
#pragma unroll 1
            for (int kt = 0; kt < 4; ++kt) flash_step<false>(R, slot + kt * KV_BYTES, slot + kt * KV_BYTES + KL_BYTES, 0, 0, 0, lane, fix);
            store_partial(R, ws + PM_O, (float*)(ws + PM_LSE), ((size_t)cbh * SEQ + t) * 3 + sl, active, lane);
        }
        it = itn; itn = __builtin_amdgcn_readfirstlane(tkt[(kk + 2) % 3]);
    }
#undef MBG_ISSUE
}
__device__ __forceinline__ void phase_moba_dense(Ctx& C, const Params& prm) {
    unsigned char* ws = prm.ws; const int lane = C.lane, r = lane & 31, h = lane >> 5, w = C.wave, tid = C.tid;
    const bool fix = attn_fixed_ref(prm.in[I_MQN], prm.in[I_MKN], lane);
    bf16_t* A2 = (bf16_t*)(ws + WS_A2);
    for (int u = C.bid; u < NB * 4 * 64; u += C.G) {
        const int blk = u & 63, bh = u >> 6, b = bh >> 2, hd = bh & 3, l = blk * 256 + w * 32 + r, tok = b * SEQ + l;
        const bf16_t* Km = (const bf16_t*)(ws + AT_KM) + ((size_t)bh * SEQ + (size_t)blk * 256) * 64; const bf16_t* Vm = (const bf16_t*)(ws + AT_VMT) + ((size_t)bh * 256 + 4 * blk) * 4096;
        RowTile R; rt_init(R); rt_load_q(R, (const bf16_t*)(ws + AT_QM) + ((size_t)bh * SEQ + l) * 64, lane);
        KVRegs gr;
        __syncthreads();
        kv_issue<512>(gr, Km, Vm, tid); kv_commit(gr, C.lds, C.lds + KL_BYTES, tid);
        __syncthreads();
#pragma unroll 1
        for (int i = 0; i < 4; ++i) {
            const bool more = i + 1 < 4;
            if (more) kv_issue<512>(gr, Km + (size_t)(i + 1) * 4096, Vm + (size_t)(i + 1) * 4096, tid);
            const LAS unsigned char* cb = C.lds + (i & 1) * KV_BYTES;
            if (i <= (w >> 1)) flash_step<true>(R, cb, cb + KL_BYTES, blk * 256 + i * 64, -(1 << 30), l, lane, fix);
            if (more) { LAS unsigned char* nb = C.lds + ((i + 1) & 1) * KV_BYTES; kv_commit(gr, nb, nb + KL_BYTES, tid); }
            __syncthreads();
        }
        { const unsigned pk = ((const unsigned*)(ws + AT_MIDX))[(size_t)bh * SEQ + l]; unsigned have = 0u;
#pragma unroll
          for (int sl = 0; sl < 3; ++sl) have |= (((pk >> (8 * sl)) & 0xffu) != 0xffu) ? (1u << sl) : 0u;
          merge_partials<3>(R, ws + PM_O, (const float*)(ws + PM_LSE), ((size_t)bh * SEQ + l) * 3, 1, have, lane); }
        const float inv = 1.f / R.l;
        bf16_t* orow = A2 + (size_t)tok * DM + hd * 64;
#pragma unroll
        for (int dt = 0; dt < 2; ++dt)
#pragma unroll
            for (int q4 = 0; q4 < 4; ++q4) { u32x2 nw; nw.x = cvt_pk_bf16(inv * R.O[dt][4 * q4 + 0], inv * R.O[dt][4 * q4 + 1]); nw.y = cvt_pk_bf16(inv * R.O[dt][4 * q4 + 2], inv * R.O[dt][4 * q4 + 3]);
                *(u32x2*)(orow + dt * 32 + 8 * q4 + 4 * h) = nw; }
    }
}
__device__ __forceinline__ void s5_mtable_items(Ctx& C, const Params& prm) {
    unsigned char* ws = prm.ws; const float* cre = prm.in[I_CRE]; const float* cim = prm.in[I_CIM];
    const f32x2* AP = (const f32x2*)(ws + S5_AP); const float* BB = (const float*)(ws + WS_S5BB); float* MT = (float*)(ws + S5_MT);
    LAS f32x2* cl = (LAS f32x2*)C.lds;
    LAS f32x2* bl = cl + 1024;
    LAS f32x2* al = bl + 1024;
    for (int it = C.bid; it < 16 * 16; it += C.G) { const int g = it >> 4, k0 = (it & 15) * 4;
        __syncthreads();
        for (int i = C.tid; i < 1024; i += NTHREADS) { cl[i] = (f32x2){cre[(size_t)g * 1024 + i], cim[(size_t)g * 1024 + i]};
            const int p = i >> 4, hi = i & 15; bl[i] = (f32x2){BB[(size_t)(g * 64 + p) * 32 + hi], BB[(size_t)(g * 64 + p) * 32 + 16 + hi]}; }
        if (C.tid < 256) al[C.tid] = AP[(g * 65 + k0 + (C.tid >> 6)) * 64 + (C.tid & 63)];
        __syncthreads();
#pragma unroll
        for (int q = 0; q < 2; ++q) { const int o = C.tid + q * NTHREADS, hi = o & 15, ho = (o >> 4) & 15, kk = o >> 8;
            float acc = 0.f;
#pragma unroll 8
            for (int p = 0; p < 64; ++p) { const f32x2 a = al[kk * 64 + p], bb = bl[p * 16 + hi], cc = cl[ho * 64 + p];
                const float wr = a.x * bb.x - a.y * bb.y, wi = a.x * bb.y + a.y * bb.x; acc += cc.x * wr - cc.y * wi; }
            MT[((size_t)(g * 64 + k0 + kk) * 16 + ho) * 16 + hi] = acc; }
    }
    __syncthreads();
}
__device__ __forceinline__ void s5_bg_items(Ctx& C, const Params& prm, int rank, int nranks) {
    unsigned char* ws = prm.ws; const float* cre = prm.in[I_CRE]; const float* cim = prm.in[I_CIM];
    const f32x2* AP = (const f32x2*)(ws + S5_AP); const float* MT = (const float*)(ws + S5_MT); bf16_t* BG = (bf16_t*)(ws + S5_BG);
    for (int i = rank * NTHREADS + C.tid; i < 16 * 1024 * 144; i += nranks * NTHREADS) { const int kc = i % 144, n = (i / 144) & 1023, g = i / (144 * 1024), t = n >> 4, ho = n & 15;
        float v[8];
        if (kc < 16) { const int p0 = (kc & 7) * 8; const bool imag = kc >= 8;
            const f32x4* ap = (const f32x4*)(AP + (g * 65 + t + 1) * 64 + p0); const f32x4* crp = (const f32x4*)(cre + (size_t)g * 1024 + ho * 64 + p0); const f32x4* cip = (const f32x4*)(cim + (size_t)g * 1024 + ho * 64 + p0);
            const f32x4 a0 = ap[0], a1 = ap[1], a2 = ap[2], a3 = ap[3], cr0 = crp[0], cr1 = crp[1], ci0 = cip[0], ci1 = cip[1];
            const float ar[8] = {a0[0], a0[2], a1[0], a1[2], a2[0], a2[2], a3[0], a3[2]}, ai[8] = {a0[1], a0[3], a1[1], a1[3], a2[1], a2[3], a3[1], a3[3]};
            const float cr[8] = {cr0[0], cr0[1], cr0[2], cr0[3], cr1[0], cr1[1], cr1[2], cr1[3]}, ci[8] = {ci0[0], ci0[1], ci0[2], ci0[3], ci1[0], ci1[1], ci1[2], ci1[3]};
#pragma unroll
            for (int j = 0; j < 8; ++j) v[j] = imag ? -(cr[j] * ai[j] + ci[j] * ar[j]) : (cr[j] * ar[j] - ci[j] * ai[j]); }
        else { const int kk = (kc - 16) * 8, s = kk >> 4, hi0 = kk & 15;
            if (s <= t) { const f32x4* mp = (const f32x4*)(MT + ((g * 64 + (t - s)) * 16 + ho) * 16 + hi0); const f32x4 m0 = mp[0], m1 = mp[1];
                v[0] = m0[0]; v[1] = m0[1]; v[2] = m0[2]; v[3] = m0[3]; v[4] = m1[0]; v[5] = m1[1]; v[6] = m1[2]; v[7] = m1[3]; }
            else {
#pragma unroll
                for (int j = 0; j < 8; ++j) v[j] = 0.f; } }
        u32x4 o; o.x = cvt_pk_bf16(v[0], v[1]); o.y = cvt_pk_bf16(v[2], v[3]); o.z = cvt_pk_bf16(v[4], v[5]); o.w = cvt_pk_bf16(v[6], v[7]);
        *(u32x4*)(BG + ((size_t)(g * 1024 + n) * 1152 + kc * 8)) = o; }
}
__device__ __forceinline__ void s5_sg_items(Ctx& C, const Params& prm) {
    unsigned char* ws = prm.ws; const f32x2* AP = (const f32x2*)(ws + S5_AP); const float* BB = (const float*)(ws + WS_S5BB); bf16_t* SG = (bf16_t*)(ws + S5_SG);
    for (int i = C.bid * NTHREADS + C.tid; i < 16 * 128 * 128; i += C.G * NTHREADS) { const int kc = i & 127, n = (i >> 7) & 127, g = i >> 14, p = n & 63, s = kc >> 1, hi0 = (kc & 1) * 8;
        const f32x2 a = AP[(g * 65 + (63 - s)) * 64 + p]; const float* bb = BB + (size_t)(g * 64 + p) * 32 + hi0; float v[8];
#pragma unroll
        for (int j = 0; j < 8; ++j) { const float br = bb[j], bi = bb[16 + j]; v[j] = n < 64 ? (a.x * br - a.y * bi) : (a.x * bi + a.y * br); }
        u32x4 o; o.x = cvt_pk_bf16(v[0], v[1]); o.y = cvt_pk_bf16(v[2], v[3]); o.z = cvt_pk_bf16(v[4], v[5]); o.w = cvt_pk_bf16(v[6], v[7]);
        *(u32x4*)(SG + ((size_t)(g * 256 + n) * 1024 + kc * 8)) = o; }
}
__device__ __forceinline__ void s5_chunkscan_wave(Ctx& C, const Params& prm, int b, int g) {
    unsigned char* ws = prm.ws; const int lane = C.lane;
    const f32x2 aL = ((const f32x2*)(ws + S5_AP))[(g * 65 + 64) * 64 + lane];
    const f32x2* E = (const f32x2*)(ws + WS_S5E) + ((size_t)(b * S5_NCH) * 16 + g) * 64 + lane;
    bf16_t* ag = (bf16_t*)(ws + S5_AG) + (size_t)(g * 512 + b * 256) * 1152 + lane;
    float xr = 0.f, xi = 0.f;
    for (int c = 0; c < S5_NCH; c += 32) { f32x2 e[32];
#pragma unroll
        for (int q = 0; q < 32; ++q) e[q] = E[(size_t)(c + q) * 16 * 64];
#pragma unroll
        for (int q = 0; q < 32; ++q) { ag[(size_t)(c + q) * 1152] = f2bf(xr); ag[(size_t)(c + q) * 1152 + 64] = f2bf(xi);
            const float nr = aL.x * xr - aL.y * xi + e[q].x, ni = aL.x * xi + aL.y * xr + e[q].y; xr = nr; xi = ni; } }
}
namespace pg8 {
struct EpiProj0 {
    static constexpr bool PERM = true;
    bf16_t* O; int ldc; bf16_t* AG; const float* R0;
    __device__ __forceinline__ void operator()(const f32x4 (&acc)[2][2][4][2], const Unit& u, int wr, int wc, int fr, int fq) const {
        const int row0 = u.arow + wr * 64 + fr, cw = wc * 32 + 8 * fq;
        float rsv[2][4];
#pragma unroll
        for (int ai = 0; ai < 2; ++ai)
#pragma unroll
            for (int m = 0; m < 4; ++m) rsv[ai][m] = R0[row0 + ai * HALF + m * 16];
#pragma unroll
        for (int ai = 0; ai < 2; ++ai)
#pragma unroll
            for (int m = 0; m < 4; ++m) { const int row = row0 + ai * HALF + m * 16; const float rs = rsv[ai][m];
                if (u.pn >= 1 && u.pn <= 6) { const float r2 = rs * rs; const f32x4 v0 = acc[ai][0][m][0] * acc[ai][1][m][0] * r2, v1 = acc[ai][0][m][1] * acc[ai][1][m][1] * r2;
                    u32x4 w; w.x = cvt_pk_bf16(v0[0], v0[1]); w.y = cvt_pk_bf16(v0[2], v0[3]); w.z = cvt_pk_bf16(v1[0], v1[1]); w.w = cvt_pk_bf16(v1[2], v1[3]);
                    *(u32x4*)(O + (size_t)row * ldc + (u.pn - 1) * 128 + cw) = w; }
                else {
#pragma unroll
                    for (int bj = 0; bj < 2; ++bj) { const f32x4 v0 = acc[ai][bj][m][0] * rs, v1 = acc[ai][bj][m][1] * rs;
                        u32x4 w; w.x = cvt_pk_bf16(v0[0], v0[1]); w.y = cvt_pk_bf16(v0[2], v0[3]); w.z = cvt_pk_bf16(v1[0], v1[1]); w.w = cvt_pk_bf16(v1[2], v1[3]);
                        if (u.pn == 0) { const int ch = cw + bj * HALF, g = ch >> 4, b = row / SEQ, l = row % SEQ;
                            *(u32x4*)(AG + ((size_t)(g * 512 + b * 256 + (l >> 6)) * 1152 + 128 + (l & 63) * 16 + (ch & 15))) = w; }
                        else *(u32x4*)(O + (size_t)row * ldc + 768 + (u.pn - 7) * 256 + bj * HALF + cw) = w; } } }
    }
};
struct S5ESched { int G, c;
    __device__ bool next(int i, Unit& u) const { const int L = i * G + c; if (L >= 32) return false; const int g = L >> 1, mt = L & 1;
        u.arow = g * 512 + mt * 256; u.pn = 0; u.b0 = g * 256 * 1024 * 2; u.b1 = u.b0; u.nt = 16; return true; } };
struct EpiS5E {
    static constexpr bool PERM = true;
    float* E;
    __device__ __forceinline__ void operator()(const f32x4 (&acc)[2][2][4][2], const Unit& u, int wr, int wc, int fr, int fq) const {
        const int g = u.arow >> 9, row0 = (u.arow & 511) + wr * 64 + fr, n0 = wc * 32 + 8 * fq, im = n0 >> 6, p0 = n0 & 63;
#pragma unroll
        for (int ai = 0; ai < 2; ++ai)
#pragma unroll
            for (int m = 0; m < 4; ++m) { const int rg = row0 + ai * HALF + m * 16; float* e = E + (((size_t)rg * 16 + g) * 64 + p0) * 2 + im;
                const f32x4 v0 = acc[ai][0][m][0], v1 = acc[ai][0][m][1];
                e[0] = v0[0]; e[2] = v0[1]; e[4] = v0[2]; e[6] = v0[3]; e[8] = v1[0]; e[10] = v1[1]; e[12] = v1[2]; e[14] = v1[3]; }
    }
};
struct S5Sched { int G, c;
    __device__ bool next(int i, Unit& u) const { const int L = i * G + c; if (L >= 128) return false; const int g = L >> 3, mt = (L >> 2) & 1, pn = L & 3;
        u.arow = g * 512 + mt * 256; u.pn = pn; u.b0 = (g * 1024 + pn * 256) * 1152 * 2; u.b1 = u.b0; u.nt = 2 + 4 * (pn + 1); return true; } };
struct EpiS5 {
    static constexpr bool PERM = true;
    const bf16_t* AG; bf16_t* YB; const float* dvec;
    __device__ __forceinline__ void operator()(const f32x4 (&acc)[2][2][4][2], const Unit& u, int wr, int wc, int fr, int fq) const {
        const int g = u.arow >> 9, row0 = u.arow + wr * 64 + fr, col0 = u.pn * BM + wc * 32 + 8 * fq;
        f32x4 dd[2][2];
#pragma unroll
        for (int bj = 0; bj < 2; ++bj) { const int ho = (col0 + bj * HALF) & 15; dd[bj][0] = *(const f32x4*)(dvec + g * 16 + ho); dd[bj][1] = *(const f32x4*)(dvec + g * 16 + ho + 4); }
#pragma unroll
        for (int ai = 0; ai < 2; ++ai) { u32x4 uw[4][2];
#pragma unroll
            for (int m = 0; m < 4; ++m)
#pragma unroll
                for (int bj = 0; bj < 2; ++bj) uw[m][bj] = *(const u32x4*)(AG + (size_t)(row0 + ai * HALF + m * 16) * 1152 + 128 + col0 + bj * HALF);
#pragma unroll
            for (int m = 0; m < 4; ++m) { const int row = row0 + ai * HALF + m * 16, rg = row & 511;
#pragma unroll
                for (int bj = 0; bj < 2; ++bj) { const int col = col0 + bj * HALF, t = col >> 4, ho = col & 15; const size_t tok = (size_t)(rg >> 8) * SEQ + (size_t)(rg & 255) * 64 + t;
                    const u32x4 w4 = uw[m][bj]; const f32x4 d0 = dd[bj][0], d1 = dd[bj][1], v0 = acc[ai][bj][m][0], v1 = acc[ai][bj][m][1];
                    float y[8]; y[0] = v0[0] + d0[0] * bf_lo(w4.x); y[1] = v0[1] + d0[1] * bf_hi(w4.x); y[2] = v0[2] + d0[2] * bf_lo(w4.y); y[3] = v0[3] + d0[3] * bf_hi(w4.y);
                    y[4] = v1[0] + d1[0] * bf_lo(w4.z); y[5] = v1[1] + d1[1] * bf_hi(w4.z); y[6] = v1[2] + d1[2] * bf_lo(w4.w); y[7] = v1[3] + d1[3] * bf_hi(w4.w);
#pragma unroll
                    for (int j = 0; j < 8; ++j) y[j] = gelu_tanh(y[j]);
                    u32x4 w; w.x = cvt_pk_bf16(y[0], y[1]); w.y = cvt_pk_bf16(y[2], y[3]); w.z = cvt_pk_bf16(y[4], y[5]); w.w = cvt_pk_bf16(y[6], y[7]);
                    *(u32x4*)(YB + tok * 256 + g * 16 + ho) = w; } }
            asm volatile("" ::: "memory"); }
    }
};
struct EpiGLU {
    static constexpr bool PERM = true;
    const bf16_t* YB; bf16_t* O;
    __device__ __forceinline__ void operator()(const f32x4 (&acc)[2][2][4][2], const Unit& u, int wr, int wc, int fr, int fq) const {
        const int row0 = u.arow + wr * 64 + fr, col0 = wc * 32 + 8 * fq;
#pragma unroll
        for (int ai = 0; ai < 2; ++ai) { u32x4 yv[4][2];
#pragma unroll
            for (int m = 0; m < 4; ++m)
#pragma unroll
                for (int bj = 0; bj < 2; ++bj) yv[m][bj] = *(const u32x4*)(YB + (size_t)(row0 + ai * HALF + m * 16) * 256 + col0 + bj * HALF);
#pragma unroll
            for (int m = 0; m < 4; ++m) { const size_t row = (size_t)(row0 + ai * HALF + m * 16);
#pragma unroll
                for (int bj = 0; bj < 2; ++bj) { const int col = col0 + bj * HALF; const u32x4 yw = yv[m][bj]; const f32x4 v0 = acc[ai][bj][m][0], v1 = acc[ai][bj][m][1];
                    u32x4 w; w.x = cvt_pk_bf16(bf_lo(yw.x) * sigmoidf_(v0[0]), bf_hi(yw.x) * sigmoidf_(v0[1])); w.y = cvt_pk_bf16(bf_lo(yw.y) * sigmoidf_(v0[2]), bf_hi(yw.y) * sigmoidf_(v0[3]));
                    w.z = cvt_pk_bf16(bf_lo(yw.z) * sigmoidf_(v1[0]), bf_hi(yw.z) * sigmoidf_(v1[1])); w.w = cvt_pk_bf16(bf_lo(yw.w) * sigmoidf_(v1[2]), bf_hi(yw.w) * sigmoidf_(v1[3]));
                    *(u32x4*)(O + row * DM + col) = w; } }
            asm volatile("" ::: "memory"); }
    }
};
}
constexpr int LDS_BYTES = 160 * 1024;
constexpr int N_PHASES_A = 19;
#ifndef ONLY
#define ONLY -1
#endif
constexpr bool ph_on(int k) { return ONLY < 0 || ONLY == k; }
__global__ void __launch_bounds__(NTHREADS, 2) fwd_kernel(Params prm_) {
    extern __shared__ __attribute__((aligned(16))) unsigned char lds_raw[];
    cg::grid_group grid = cg::this_grid();
    const int ph_lo = prm_.ph_lo, ph_hi = prm_.ph_hi;
    volatile LAS unsigned* bst = (volatile LAS unsigned*)((LAS unsigned char*)lds_raw + LDS_BYTES - 16);
    if (threadIdx.x < 4) bst[threadIdx.x] = 0u;
    __syncthreads();
    XcdBarrier bar = xcd_barrier_post((unsigned*)(prm_.ws + WS_BAR), bst);
    if (ph_hi < 0) grid.sync();
#ifndef PROBE_MASK
#define PROBE_MASK 0u
#endif
    for (int pi = ph_lo; pi < ph_hi; ++pi) {
      const int ph = pi < 3 ? pi : (pi == 3 ? 22 : (pi == 4 ? 23 : (pi <= 8 ? pi - 1 : (pi == 9 ? 10 : pi + 2))));
      const int nrep = ((PROBE_MASK >> ph) & 1u) ? 2 : 1;
      for (int rep = 0; rep < nrep; ++rep) {
        const __attribute__((address_space(4))) Params* kp = (const __attribute__((address_space(4))) Params*)__builtin_amdgcn_kernarg_segment_ptr();
        asm volatile("" : "+s"(kp));
        const Params& prm = *(const Params*)kp;
        int tid_ = threadIdx.x, bid_ = blockIdx.x, G_ = gridDim.x; asm volatile("" : "+v"(tid_)); asm volatile("" : "+s"(bid_), "+s"(G_));
        Ctx C; C.lds = (LAS unsigned char*)lds_raw; C.tid = tid_; C.lane = tid_ & 63; C.wave = __builtin_amdgcn_readfirstlane(tid_ >> 6); C.G = G_; C.bid = bid_;
        unsigned char* ws = prm.ws;
        switch (ph) {
        case 0: if constexpr (ph_on(0)) { phase_prep(C, prm); } break;
        case 1: if constexpr (ph_on(1)) { pg8::Gemm g{(const bf16_t*)(ws + WS_XN), (const char*)(ws + WS_WIN0T), DM, DM, DM, 1 << 30, nullptr}; pg8::DenseSched S; S.init(T, IN_EVEN, C.G, C.bid, DM, DM);
                  s5_mtable_items(C, prm); s5_sg_items(C, prm);
                  pg8::EpiProj0 E{(bf16_t*)(ws + WS_PROJ), 1536, (bf16_t*)(ws + S5_AG), (const float*)(ws + WS_R0)}; pg8::gemm_phase<pg8::EpiProj0, pg8::DenseSched, false>(C.lds, g, S, E); } break;
        case 2: if constexpr (ph_on(2)) {
                  if (C.G > 64 && C.bid < 32) { pg8::Gemm g{(const bf16_t*)(ws + S5_AG) + 128, (const char*)(ws + S5_SG), 1152, 1024, 1024, 1 << 30, nullptr}; pg8::S5ESched S{32, C.bid};
                      pg8::EpiS5E E{(float*)(ws + WS_S5E)}; pg8::gemm_phase<pg8::EpiS5E, pg8::S5ESched, false>(C.lds, g, S, E);
                      asm volatile("s_waitcnt vmcnt(0)" ::: "memory"); __syncthreads(); if (C.wave == 0) { __builtin_amdgcn_fence(__ATOMIC_ACQUIRE, "agent"); s5_chunkscan_wave(C, prm, C.bid & 1, C.bid >> 1); } }
                  else if (C.G > 64) { phase_s5a_conv(C, prm, C.bid - 32, C.G - 32); s5_bg_items(C, prm, C.bid - 32, C.G - 32); }
                  else { pg8::Gemm g{(const bf16_t*)(ws + S5_AG) + 128, (const char*)(ws + S5_SG), 1152, 1024, 1024, 1 << 30, nullptr}; pg8::S5ESched S{C.G, C.bid};
                      pg8::EpiS5E E{(float*)(ws + WS_S5E)}; pg8::gemm_phase<pg8::EpiS5E, pg8::S5ESched, false>(C.lds, g, S, E); __syncthreads(); phase_s5a_conv(C, prm, C.bid, C.G); s5_bg_items(C, prm, C.bid, C.G); } } break;
        case 3: if constexpr (ph_on(3)) { if (C.G <= 64) { const int gw = C.bid * NWAVES + C.wave; if (gw < NB * 16) s5_chunkscan_wave(C, prm, gw >> 4, gw & 15); } } break;
        case 22: if constexpr (ph_on(22)) { pg8::Gemm g{(const bf16_t*)(ws + S5_AG), (const char*)(ws + S5_BG), 1152, 1152, 1152, 1 << 30, nullptr}; pg8::S5Sched S{C.G, C.bid};
                  pg8::EpiS5 E{(const bf16_t*)(ws + S5_AG), (bf16_t*)(ws + S5_YB), prm.in[I_S5D]}; pg8::gemm_phase<pg8::EpiS5, pg8::S5Sched, false>(C.lds, g, S, E);
                  if (C.G > 128) { if (C.bid >= 128) late_weight_items(C, prm, C.bid - 128, C.G - 128); } else { __syncthreads(); late_weight_items(C, prm, C.bid, C.G); } } break;
        case 23: if constexpr (ph_on(23)) { pg8::Gemm g{(const bf16_t*)(ws + S5_YB), (const char*)(ws + S5_GLUT), 256, 256, 256, 1 << 30, nullptr}; pg8::DenseSched S; S.init(T, 256, C.G, C.bid, 256, 256);
                  pg8::EpiGLU E{(const bf16_t*)(ws + S5_YB), (bf16_t*)(ws + WS_A2)}; pg8::gemm_phase<pg8::EpiGLU, pg8::DenseSched, false>(C.lds, g, S, E); } break;
        case 4: if constexpr (ph_on(4)) { pg8::Gemm g{(const bf16_t*)(ws + WS_A2), (const char*)(ws + WS_WOUT0T), DM, DM, DM, 1 << 30, nullptr}; pg8::DenseSched S; S.init(T, DM, C.G, C.bid, DM, DM);
                  pg8::EpiResidualB<false> E{nullptr, (bf16_t*)(ws + WS_XN), (float*)(ws + WS_SS)}; pg8::gemm_phase<pg8::EpiResidualB<false>, pg8::DenseSched, false>(C.lds, g, S, E); } break;
#define MOE_PHASES(P0, LAYER) \
        case P0: if constexpr (ph_on(P0)) { phase_moe_route(C, prm, LAYER); } break; \
        case P0 + 1: if constexpr (ph_on(P0 + 1)) { phase_moe_scatter(C, prm, LAYER); } break; \
        case P0 + 2: if constexpr (ph_on(P0 + 2)) { LAS int* tabl = (LAS int*)(C.lds + 131072); moe_load_tab((const unsigned*)(ws + WS_CTL) + CW_MOECNT + LAYER * 32, tabl, C.tid); __syncthreads(); \
                  unsigned* rdy = (unsigned*)(ws + WS_CTL) + CW_MOERDY + LAYER * 256; unsigned* qctr = (unsigned*)(ws + WS_CTL) + CW_MOEQ + LAYER; LAS int* tk = tabl + 32; \
                  { pg8::Gemm g{(const bf16_t*)(ws + WS_XN), (const char*)(ws + WS_MW1T) + (size_t)LAYER * 16 * 512 * 1024 * 2, DM, DM, DM, 1 << 30, (const int*)(ws + WS_ROWTOK)}; \
                    pg8::MoeSched S{tabl, C.G, C.bid, 0, rdy, qctr, tk}; \
                    pg8::EpiSwiGLU E{(bf16_t*)(ws + WS_PROJ), (const f32x4*)(ws + WS_WROW)}; pg8::gemm_phase<pg8::EpiSwiGLU, pg8::MoeSched, true, true>(C.lds, g, S, E); } \
                  __syncthreads(); \
                    \
                  { pg8::Gemm g{(const bf16_t*)(ws + WS_PROJ), (const char*)(ws + WS_MWDT) + (size_t)LAYER * 16 * 1024 * 256 * 2, 512, 256, 512, 4, nullptr}; \
                    pg8::MoeSched S{tabl, C.G, C.bid, 1, rdy, qctr, tk}; \
                    pg8::EpiScatterResB<(LAYER == 1)> E{prm.out, (bf16_t*)(ws + WS_XN), (float*)(ws + WS_SS), (const int*)(ws + WS_ROWTOK)}; pg8::gemm_phase<pg8::EpiScatterResB<(LAYER == 1)>, pg8::MoeSched, false, true>(C.lds, g, S, E); } \
                  if (LAYER == 0) {   \
                      __syncthreads(); LAS float* scr = (LAS float*)(C.lds + C.wave * 16384); const int nun = tabl[24] * 4; \
                      for (int s = __builtin_amdgcn_readfirstlane(tk[1]);;) { const int cg = s - 2 * nun; if (cg >= 768) break; \
                          const int it = cg * NWAVES + C.wave; moe_weight_item(prm, ws, 16 + it / 384, it % 384, scr, C.lane); \
                          __syncthreads(); if (C.tid == 0) tk[0] = (int)atomicAdd(qctr, 1u); __syncthreads(); s = __builtin_amdgcn_readfirstlane(tk[0]); } } } break; \
        case P0 + 3: break;
        MOE_PHASES(5, 0)
        case 9: break;
        case 10: if constexpr (ph_on(10)) { pg8::Gemm g{(const bf16_t*)(ws + WS_XN), (const char*)(ws + WS_WIN1T), DM, DM, DM, 1 << 30, nullptr};
                  LAS float* rl = (LAS float*)(C.lds + 131072 + 16384);
                  pg8::RowScaleSched S; S.init(T, IN_ODD_P, C.G, C.bid, DM, DM); S.SS = (const float*)(ws + WS_SS); S.rl = rl;
                  pg8::EpiOdd E{(bf16_t*)(ws + WS_PROJ), IN_ODD_P, rl, (LAS float*)(C.lds + 131072 + 20480), ws, (unsigned char*)prm.out, prm.in[I_MQN], prm.in[I_MKN], prm.in[I_NQN], prm.in[I_NKSN], prm.in[I_NKWN]};
                  pg8::gemm_phase<pg8::EpiOdd, pg8::RowScaleSched, false, true>(C.lds, g, S, E); } break;
        case 12: if constexpr (ph_on(12)) { kmmean_items(C, prm);
                  if (C.G > 64 && C.bid >= 64) phase_post1(C, prm, C.bid - 64, C.G - 64);
                  else { pg8::Gemm g{(const bf16_t*)(ws + AT_KC), (const char*)(ws + WS_C1T), 1024, 1024, 1024, 1 << 30, nullptr}; pg8::C1Sched S{C.G, C.bid};
                      pg8::EpiBf16Plain E{(bf16_t*)(ws + AT_HC), 512}; pg8::gemm_phase<pg8::EpiBf16Plain, pg8::C1Sched, false>(C.lds, g, S, E);
                      if (C.G <= 64) { __syncthreads(); phase_post1(C, prm, C.bid, C.G); } } } break;
        case 13: if constexpr (ph_on(13)) { phase_c2(C, prm); moba_gate_items(C, prm); } break;
        case 14: if constexpr (ph_on(14)) { phase_nsa_cmp(C, prm); } break;
        case 15: if constexpr (ph_on(15)) {
#ifdef REP_NSAG
                  phase_nsa_gather(C, prm); __syncthreads();
#endif
#ifdef REP_MOBAG
                  phase_moba_gather(C, prm); __syncthreads();
#endif
                  phase_nsa_gather(C, prm); __syncthreads(); phase_moba_gather(C, prm); } break;
        case 16: if constexpr (ph_on(16)) {
#ifdef REP_MOBAD
                  phase_moba_dense(C, prm); __syncthreads();
#endif
                  phase_nsa_dense(C, prm); __syncthreads(); phase_moba_dense(C, prm); } break;
        case 17: if constexpr (ph_on(17)) { pg8::Gemm g{(const bf16_t*)(ws + WS_A2), (const char*)(ws + WS_WOUT1T), DM, DM, DM, 1 << 30, nullptr}; pg8::DenseSched S; S.init(T, DM, C.G, C.bid, DM, DM);
                  pg8::EpiResidualB<false> E{nullptr, (bf16_t*)(ws + WS_XN), (float*)(ws + WS_SS)}; pg8::gemm_phase<pg8::EpiResidualB<false>, pg8::DenseSched, false>(C.lds, g, S, E); } break;
        MOE_PHASES(18, 1)
        default: break;
        }
        if (pi + 1 < ph_hi || rep + 1 < nrep) xcd_barrier(bar);
      }
    }
}

extern "C" void kernel_launch(void* const* d_in, const int* in_sizes, int n_in, void* d_out, int out_size, void* d_ws, size_t ws_size, hipStream_t stream) {
    static int grid_blocks = 0;
    if (!grid_blocks) {
        int dev = 0, cus = 0, per_cu = 0;
        (void)hipGetDevice(&dev);
        (void)hipDeviceGetAttribute(&cus, hipDeviceAttributeMultiprocessorCount, dev);
        (void)hipFuncSetAttribute((const void*)fwd_kernel, hipFuncAttributeMaxDynamicSharedMemorySize, LDS_BYTES);
        (void)hipOccupancyMaxActiveBlocksPerMultiprocessor(&per_cu, fwd_kernel, NTHREADS, LDS_BYTES);
        if (per_cu < 1) fprintf(stderr, "occupancy query says %d blocks/CU\n", per_cu);
        grid_blocks = cus;
        fprintf(stderr, "cus=%d per_cu=%d grid=%d ws=%zu need=%zu\n", cus, per_cu, grid_blocks, ws_size, (size_t)WS_TOTAL);
    }
    (void)hipMemsetAsync((char*)d_ws + WS_BAR, 0, XCD_BAR_WORDS * 4, stream);
    Params p{};
    for (int i = 0; i < 38; ++i) p.in[i] = (const float*)d_in[i];
    p.out = (float*)d_out; p.ws = (unsigned char*)d_ws; p.ph_lo = 0; p.ph_hi = N_PHASES_A;
    void* args[] = {&p};
    hipError_t e = hipLaunchCooperativeKernel((void*)fwd_kernel, dim3(grid_blocks), dim3(NTHREADS), args, LDS_BYTES, stream);
    if (e != hipSuccess) fprintf(stderr, "cooperative launch failed: %s (grid %d)\n", hipGetErrorString(e), grid_blocks);
}
```

```cpp
#include <hip/hip_runtime.h>
#include <hip/hip_cooperative_groups.h>
#include <cstdio>
namespace cg = cooperative_groups;

#define LAS __attribute__((address_space(3)))
typedef unsigned short bf16_t;
typedef short bf16x8 __attribute__((ext_vector_type(8)));
typedef float f32x4 __attribute__((ext_vector_type(4)));
typedef float f32x2 __attribute__((ext_vector_type(2)));
typedef unsigned u32x4 __attribute__((ext_vector_type(4)));
typedef unsigned u32x2 __attribute__((ext_vector_type(2)));

constexpr int NB = 2, SEQ = 16384, T = NB * SEQ, DM = 1024;
constexpr int IN_EVEN = 2560, IN_ODD = 2340, IN_ODD_P = 2560;
constexpr int NTHREADS = 512, NWAVES = 8;
constexpr int S5_LC = 64, S5_NCH = SEQ / S5_LC;
constexpr int MOE_MAXROWS = T + 24 * 256;

constexpr size_t al256(size_t x) { return (x + 255) & ~(size_t)255; }
constexpr size_t WS_CTL    = 0;
constexpr size_t WS_S5A    = WS_CTL + 65536;
constexpr size_t WS_S5AL   = WS_S5A + 16 * 64 * 8;
constexpr size_t WS_S5BB   = WS_S5AL + 16 * 64 * 8;
constexpr size_t WS_C1B    = WS_S5BB + 16 * 64 * 32 * 4;
constexpr size_t WS_WIN0T  = al256(WS_C1B + 2 * 256 * 4);
constexpr size_t WS_WOUT0T = WS_WIN0T + (size_t)IN_EVEN * DM * 2;
constexpr size_t WS_WIN1T  = WS_WOUT0T + (size_t)DM * DM * 2;
constexpr size_t WS_WOUT1T = WS_WIN1T + (size_t)IN_ODD_P * DM * 2;
constexpr size_t WS_C1T    = WS_WOUT1T + (size_t)DM * DM * 2;
constexpr size_t WS_MW1T   = WS_C1T + (size_t)2 * 256 * 2048 * 2;
constexpr size_t WS_MWDT   = WS_MW1T + (size_t)2 * 16 * 512 * 1024 * 2;
constexpr size_t WS_XN     = WS_MWDT + (size_t)2 * 16 * 1024 * 256 * 2;
constexpr size_t WS_PROJ   = WS_XN + (size_t)T * DM * 2;
constexpr size_t WS_A2     = WS_PROJ + (size_t)T * 2560 * 2;
constexpr size_t WS_S5E    = WS_A2 + (size_t)T * DM * 2;
constexpr size_t WS_TOKI   = WS_S5E + (size_t)NB * S5_NCH * 16 * 64 * 8;
constexpr size_t WS_ROWTOK = WS_TOKI + (size_t)T * 16;
constexpr size_t WS_WROW   = WS_ROWTOK + al256((size_t)MOE_MAXROWS * 4);
constexpr size_t WS_ATT    = WS_WROW + al256((size_t)MOE_MAXROWS * 16);
constexpr size_t WS_END    = WS_ATT + (size_t)149 * 1024 * 1024;
constexpr size_t WS_SS     = WS_END;
constexpr size_t WS_R0     = WS_SS + (size_t)T * 16 * 4;
constexpr size_t WS_C1BP   = WS_R0 + (size_t)T * 4;
constexpr size_t WS_TOTAL  = WS_C1BP + 2 * 4 * 32 * 64 * 4;
constexpr size_t WS_RT2    = WS_ATT;
constexpr size_t WS_WR2    = WS_RT2 + (size_t)24 * T * 4;
static_assert(WS_TOTAL <= (size_t)512 * 1024 * 1024, "workspace exceeds 512 MiB");
constexpr size_t S5_AG   = WS_ATT;
constexpr size_t S5_BG   = S5_AG + (size_t)16 * 512 * 1152 * 2;
constexpr size_t S5_YB   = S5_BG + (size_t)16 * 1024 * 1152 * 2;
constexpr size_t S5_MT   = S5_YB + (size_t)T * 256 * 2;
constexpr size_t S5_AP   = S5_MT + (size_t)16 * 64 * 256 * 4;
constexpr size_t S5_GLUT = S5_AP + (size_t)16 * 65 * 64 * 8;
constexpr size_t S5_SG   = S5_GLUT + 256 * 256 * 2;
static_assert(S5_SG + (size_t)16 * 256 * 1024 * 2 <= WS_END, "S5 buffers");
constexpr int CW_MOEQ = 16;
constexpr int CW_Q15A = 20;
constexpr int CW_Q15B = 21;
constexpr int CW_MOECNT = 64;
constexpr int CW_MOERDY = 256;
constexpr size_t WS_BAR = WS_CTL + 32768;

__device__ __forceinline__ unsigned cvt_pk_bf16(float lo, float hi) { unsigned r; asm volatile("v_cvt_pk_bf16_f32 %0, %1, %2" : "=v"(r) : "v"(lo), "v"(hi)); return r; }
__device__ __forceinline__ float bf_lo(unsigned w) { return __uint_as_float(w << 16); }
__device__ __forceinline__ float bf_hi(unsigned w) { return __uint_as_float(w & 0xffff0000u); }
__device__ __forceinline__ float bf2f(bf16_t b) { return __uint_as_float(((unsigned)b) << 16); }
__device__ __forceinline__ bf16_t f2bf(float f) { return (bf16_t)(cvt_pk_bf16(f, 0.f) & 0xffffu); }
__device__ __forceinline__ float wave_sum(float v) {
#pragma unroll
    for (int o = 1; o < 64; o <<= 1) v += __shfl_xor(v, o);
    return v;
}
__device__ __forceinline__ float wave_max(float v) {
#pragma unroll
    for (int o = 1; o < 64; o <<= 1) v = fmaxf(v, __shfl_xor(v, o));
    return v;
}
__device__ __forceinline__ float gelu_tanh(float x) {
    const float u = 0.7978845608028654f * (x + 0.044715f * x * x * x);
    const float e = __expf(2.f * u);
    const float th = 1.f - 2.f / (e + 1.f);
    return 0.5f * x * (1.f + th);
}
__device__ __forceinline__ float sigmoidf_(float x) { return 1.f / (1.f + __expf(-x)); }

namespace pg8 {
constexpr int BM = 256, BK = 64, HALF = 128, HTB = HALF * BK * 2, STAGE_BYTES = 8 * HTB;
__device__ __forceinline__ int lds_byte(int r, int c) { const int st = (r >> 4) * 2 + (c >> 5), rr = r & 15, cc = c & 31, ob = rr * 64 + cc * 2; return st * 1024 + (ob ^ (((ob >> 9) & 1) << 5)); }
__device__ __forceinline__ void stage_rc(int b, int& R, int& C) { const int st = b / 1024, sb = b % 1024, swz = sb ^ (((sb >> 9) & 1) << 5); R = (st >> 1) * 16 + swz / 64; C = (st & 1) * 32 + (swz % 64) / 2; }
__device__ __forceinline__ int perm32(int rho) { const int n = rho >> 4, i = rho & 15; return 8 * (i >> 2) + 4 * n + (i & 3); }

struct Unit { int arow, pn, b0, b1, nt, aux; };
struct Gemm { const bf16_t* A; const char* Bbase; int lda, ldb, K, ksplit; const int* gather; };

template <class Epi, class Sched, bool GATHER, bool HOOKS = false>
__device__ __forceinline__ void gemm_phase(LAS unsigned char* lds, const Gemm g, const Sched& S, const Epi& E) {
    int tid = threadIdx.x; asm volatile("" : "+v"(tid));
    const int wid = __builtin_amdgcn_readfirstlane(tid >> 6), lane = tid & 63, wr = wid >> 2, wc = wid & 3, fr = lane & 15, fq = lane >> 4;
    unsigned voffA[2], voffB[2];
#pragma unroll
    for (int i = 0; i < 2; ++i) { int R, C; stage_rc(tid * 16 + i * 8192, R, C); const int Rb = Epi::PERM ? ((R & ~31) + perm32(R & 31)) : R;
        voffA[i] = (unsigned)(R * g.lda + C) * 2u; voffB[i] = (unsigned)(Rb * g.ldb + C) * 2u; }
    const size_t kstep = (size_t)(BK * 2);
    const size_t hstepA = (size_t)HALF * g.lda * 2, hstepB = (size_t)HALF * g.ldb * 2;
    const unsigned ldsw = (unsigned)wid * 1024u;
    const int aoff = lds_byte(wr * 64 + fr, fq * 8), boff = lds_byte(wc * 32 + fr, fq * 8);
#define PG8_SA(b, h) (((b) * 2 + (h)) * HTB)
#define PG8_SB(b, h) ((4 + (b) * 2 + (h)) * HTB)
#define PG8_STAGE(bufoff, gbase, voff) do { _Pragma("unroll") for (int _i = 0; _i < 2; ++_i) \
        __builtin_amdgcn_global_load_lds((const unsigned*)((const char*)(gbase) + (voff)[_i]), (LAS unsigned*)(lds + (bufoff) + ldsw + _i * 8192), 16, 0, 0); } while (0)
#define PG8_STAGE_A(bufoff, isnext, h, toff) do { if constexpr (GATHER) { if (isnext) { unsigned _vn[2]; _vn[0] = park[(h) * 2 * 512]; _vn[1] = park[((h) * 2 + 1) * 512]; PG8_STAGE(bufoff, gA + (toff), _vn); } else PG8_STAGE(bufoff, gA + (toff), voC[h]); } \
        else { PG8_STAGE(bufoff, ((isnext) ? nA : cA) + (h) * hstepA + (toff), voffA); } } while (0)
#define PG8_LDA(dst, b, h) do { _Pragma("unroll") for (int m = 0; m < 4; ++m) _Pragma("unroll") for (int k = 0; k < 2; ++k) dst[m][k] = *(const LAS bf16x8*)(lds + PG8_SA(b, h) + aoff + m * 2048 + k * 1024); } while (0)
#define PG8_LDB(dst, b, h) do { _Pragma("unroll") for (int n = 0; n < 2; ++n) _Pragma("unroll") for (int k = 0; k < 2; ++k) dst[n][k] = *(const LAS bf16x8*)(lds + PG8_SB(b, h) + boff + n * 2048 + k * 1024); } while (0)
#define PG8_MMA(ai, bj, At, Bt) do { __builtin_amdgcn_s_setprio(1); _Pragma("unroll") for (int m = 0; m < 4; ++m) _Pragma("unroll") for (int n = 0; n < 2; ++n) _Pragma("unroll") for (int k = 0; k < 2; ++k) \
        acc[ai][bj][m][n] = __builtin_amdgcn_mfma_f32_16x16x32_bf16(Bt[n][k], At[m][k], acc[ai][bj][m][n], 0, 0, 0); __builtin_amdgcn_s_setprio(0); } while (0)
#define PG8_WAIT_V(n) asm volatile("s_waitcnt vmcnt(" #n ")" ::: "memory")
#define PG8_WAIT_L(n) asm volatile("s_waitcnt lgkmcnt(" #n ")" ::: "memory")
#define PG8_BAR __builtin_amdgcn_s_barrier()
#define PG8_SCHED __builtin_amdgcn_sched_barrier(0)
#define PG8_AOFFS(dst, u) do { int _t = threadIdx.x; asm volatile("" : "+v"(_t)); _Pragma("unroll") for (int _h = 0; _h < 2; ++_h) _Pragma("unroll") for (int _i = 0; _i < 2; ++_i) { \
        int _R, _C; stage_rc(_t * 16 + _i * 8192, _R, _C); int _row = g.gather[(u).aux + _h * HALF + _R]; _row = _row < 0 ? 0 : _row; \
        dst[_h][_i] = (unsigned)((size_t)_row * g.lda + _C) * 2u; } \
        asm volatile("" : "+v"(dst[0][0]), "+v"(dst[0][1]), "+v"(dst[1][0]), "+v"(dst[1][1])); } while (0)
    Unit cur, nxt; int ui = 0;
    if (!S.next(0, cur)) return;
    f32x4 acc[2][2][4][2];
#pragma unroll
    for (int a = 0; a < 2; ++a)
#pragma unroll
        for (int b = 0; b < 2; ++b)
#pragma unroll
            for (int m = 0; m < 4; ++m)
#pragma unroll
                for (int n = 0; n < 2; ++n) acc[a][b][m][n] = (f32x4){0.f, 0.f, 0.f, 0.f};
    bf16x8 At[4][2], B0[2][2], B1[2][2];
    unsigned voC[2][2];
    LAS unsigned* park = (LAS unsigned*)(lds + 131072 + 1024) + tid;
    const char* gA = (const char*)g.A;
    const char* cA = gA + (size_t)cur.arow * g.lda * 2; const char* nA = cA;
    if constexpr (GATHER) { PG8_AOFFS(voC, cur); }
    if constexpr (HOOKS) S.a_ready(cur);
#define PG8_BP(u, tile) (g.Bbase + (long)((tile) < g.ksplit ? (u).b0 : (u).b1) + (size_t)(tile) * kstep)
    { const char* b0 = PG8_BP(cur, 0); const char* b1 = PG8_BP(cur, 1);
      PG8_STAGE(PG8_SB(0, 0), b0, voffB); PG8_STAGE_A(PG8_SA(0, 0), false, 0, 0); PG8_STAGE(PG8_SB(0, 1), b0 + hstepB, voffB); PG8_STAGE_A(PG8_SA(0, 1), false, 1, 0);
      if (wr == 1) PG8_BAR;
      PG8_WAIT_V(4); PG8_BAR;
      PG8_STAGE(PG8_SB(1, 0), b1, voffB); PG8_STAGE_A(PG8_SA(1, 0), false, 0, kstep); PG8_STAGE(PG8_SB(1, 1), b1 + hstepB, voffB);
      PG8_WAIT_V(6); PG8_BAR; }
    for (;;) {
        const bool has_next = S.next(ui + 1, nxt);
        if (has_next) { nA = gA + (size_t)nxt.arow * g.lda * 2; if constexpr (GATHER) { unsigned voN[2][2]; PG8_AOFFS(voN, nxt); park[0] = voN[0][0]; park[512] = voN[0][1]; park[1024] = voN[1][0]; park[1536] = voN[1][1]; } }
        else { nA = cA; nxt = cur;
            if constexpr (GATHER) { park[0] = voC[0][0]; park[512] = voC[0][1]; park[1024] = voC[1][0]; park[1536] = voC[1][1]; } }
        const int nt = cur.nt;
#pragma unroll 1
        for (int t = 0; t < nt; t += 2) {
            const bool last = (t == nt - 2);
            if constexpr (HOOKS) { if (last && has_next) S.a_ready(nxt); }
            const size_t o1 = (size_t)(t + 1) * kstep, o2 = last ? 0 : (size_t)(t + 2) * kstep, o3 = o2 + kstep;
            const char* b2 = last ? PG8_BP(nxt, 0) : PG8_BP(cur, t + 2);
            const char* b3 = last ? PG8_BP(nxt, 1) : PG8_BP(cur, t + 3);
            PG8_LDB(B0, 0, 0); PG8_SCHED; PG8_LDA(At, 0, 0); PG8_STAGE_A(PG8_SA(1, 1), false, 1, o1);
            PG8_WAIT_L(8); PG8_BAR; PG8_WAIT_L(0); PG8_MMA(0, 0, At, B0); PG8_BAR; PG8_SCHED;
            PG8_LDB(B1, 0, 1); PG8_STAGE(PG8_SB(0, 0), b2, voffB);
            PG8_BAR; PG8_WAIT_L(0); PG8_MMA(0, 1, At, B1); PG8_BAR;
            PG8_LDA(At, 0, 1); PG8_STAGE_A(PG8_SA(0, 0), last, 0, o2);
            PG8_BAR; PG8_WAIT_L(0); PG8_MMA(1, 0, At, B0); PG8_BAR; PG8_SCHED;
            PG8_STAGE(PG8_SB(0, 1), b2 + hstepB, voffB);
            PG8_WAIT_V(6); PG8_BAR; PG8_MMA(1, 1, At, B1); PG8_BAR;
            PG8_LDB(B0, 1, 0); PG8_SCHED; PG8_LDA(At, 1, 0); PG8_STAGE_A(PG8_SA(0, 1), last, 1, o2);
            PG8_WAIT_L(8); PG8_BAR; PG8_WAIT_L(0); PG8_MMA(0, 0, At, B0); PG8_BAR; PG8_SCHED;
            PG8_LDB(B1, 1, 1); PG8_STAGE(PG8_SB(1, 0), b3, voffB);
            PG8_BAR; PG8_WAIT_L(0); PG8_MMA(0, 1, At, B1); PG8_BAR;
            PG8_LDA(At, 1, 1); PG8_STAGE_A(PG8_SA(1, 0), last, 0, o3);
            PG8_BAR; PG8_WAIT_L(0); PG8_MMA(1, 0, At, B0); PG8_BAR; PG8_SCHED;
            PG8_STAGE(PG8_SB(1, 1), b3 + hstepB, voffB);
            PG8_WAIT_V(6); PG8_BAR; PG8_MMA(1, 1, At, B1); PG8_BAR;
        }
        E(acc, cur, wr, wc, fr, fq);
        if constexpr (HOOKS) S.done(cur);
        if (!has_next) break;
#pragma unroll
        for (int a = 0; a < 2; ++a)
#pragma unroll
            for (int b = 0; b < 2; ++b)
#pragma unroll
                for (int m = 0; m < 4; ++m)
#pragma unroll
                    for (int n = 0; n < 2; ++n) acc[a][b][m][n] = (f32x4){0.f, 0.f, 0.f, 0.f};
        cur = nxt; cA = nA; ++ui;
        if constexpr (GATHER) { voC[0][0] = park[0]; voC[0][1] = park[512]; voC[1][0] = park[1024]; voC[1][1] = park[1536]; }
    }
    PG8_WAIT_V(0);
    if (wr == 0) PG8_BAR;
    PG8_BAR;
#undef PG8_SA
#undef PG8_SB
#undef PG8_STAGE
#undef PG8_STAGE_A
#undef PG8_LDA
#undef PG8_LDB
#undef PG8_MMA
#undef PG8_WAIT_V
#undef PG8_WAIT_L
#undef PG8_BAR
#undef PG8_SCHED
#undef PG8_AOFFS
#undef PG8_BP
}

struct DenseSched {
    int nM, nN, nwg, G, c, btile, nt;
    __device__ void init(int M, int N, int G_, int c_, int ldb, int K) { nM = M / BM; nN = N / BM; nwg = nM * nN; G = G_; c = c_; btile = BM * ldb * 2; nt = K / BK; }
    __device__ bool next(int i, Unit& u) const {
        const long L = (long)i * G + c; if (L >= nwg) return false;
        int wgid = (int)L; { const int q = nwg / 8, r = nwg % 8, xcd = wgid % 8, off = wgid / 8; wgid = (xcd < r ? xcd * (q + 1) : r * (q + 1) + (xcd - r) * q) + off; }
        const int WGM = 8, nig = WGM * nN, gid = wgid / nig, fm = gid * WGM, gsz = (nM - fm) < WGM ? (nM - fm) : WGM;
        u.arow = (fm + ((wgid % nig) % gsz)) * BM; u.pn = (wgid % nig) / gsz;
        u.b0 = u.pn * btile; u.b1 = u.b0; u.nt = nt; return true;
    }
};

struct EpiBf16Plain {
    static constexpr bool PERM = true;
    bf16_t* O; int ldc;
    __device__ __forceinline__ void operator()(const f32x4 (&acc)[2][2][4][2], const Unit& u, int wr, int wc, int fr, int fq) const {
        const int row0 = u.arow + wr * 64 + fr, col0 = u.pn * BM + wc * 32 + 8 * fq;
#pragma unroll
        for (int ai = 0; ai < 2; ++ai)
#pragma unroll
            for (int m = 0; m < 4; ++m) { bf16_t* rowp = O + (size_t)(row0 + ai * HALF + m * 16) * ldc + col0;
#pragma unroll
                for (int bj = 0; bj < 2; ++bj) { const f32x4 v0 = acc[ai][bj][m][0], v1 = acc[ai][bj][m][1];
                    u32x4 w; w.x = cvt_pk_bf16(v0[0], v0[1]); w.y = cvt_pk_bf16(v0[2], v0[3]); w.z = cvt_pk_bf16(v1[0], v1[1]); w.w = cvt_pk_bf16(v1[2], v1[3]);
                    *(u32x4*)(rowp + bj * HALF) = w; } }
    }
};
struct EpiBiasGeluBf16 {
    static constexpr bool PERM = true;
    bf16_t* O; int ldc; const float* bias;
    __device__ __forceinline__ void operator()(const f32x4 (&acc)[2][2][4][2], const Unit& u, int wr, int wc, int fr, int fq) const {
        const int row0 = u.arow + wr * 64 + fr, col0 = u.pn * BM + wc * 32 + 8 * fq;
#pragma unroll
        for (int ai = 0; ai < 2; ++ai)
#pragma unroll
            for (int m = 0; m < 4; ++m) { bf16_t* rowp = O + (size_t)(row0 + ai * HALF + m * 16) * ldc + col0;
#pragma unroll
                for (int bj = 0; bj < 2; ++bj) { f32x4 v0 = acc[ai][bj][m][0], v1 = acc[ai][bj][m][1];
                    const f32x4 b0 = *(const f32x4*)(bias + col0 + bj * HALF), b1 = *(const f32x4*)(bias + col0 + bj * HALF + 4);
#pragma unroll
                    for (int j = 0; j < 4; ++j) { v0[j] = gelu_tanh(v0[j] + b0[j]); v1[j] = gelu_tanh(v1[j] + b1[j]); }
                    u32x4 w; w.x = cvt_pk_bf16(v0[0], v0[1]); w.y = cvt_pk_bf16(v0[2], v0[3]); w.z = cvt_pk_bf16(v1[0], v1[1]); w.w = cvt_pk_bf16(v1[2], v1[3]);
                    *(u32x4*)(rowp + bj * HALF) = w; } }
    }
};
__device__ __forceinline__ float row_sumsq16(const f32x4& a, const f32x4& b, const f32x4& c, const f32x4& d) {
    float s = (a[0] * a[0] + a[1] * a[1]) + (a[2] * a[2] + a[3] * a[3]) + (b[0] * b[0] + b[1] * b[1]) + (b[2] * b[2] + b[3] * b[3])
            + (c[0] * c[0] + c[1] * c[1]) + (c[2] * c[2] + c[3] * c[3]) + (d[0] * d[0] + d[1] * d[1]) + (d[2] * d[2] + d[3] * d[3]);
    s += __shfl_xor(s, 16); s += __shfl_xor(s, 32); return s;
}
__device__ __forceinline__ float rms_from_ss(const float* ssrow) {
    const f32x4 a = *(const f32x4*)ssrow, b = *(const f32x4*)(ssrow + 4), c = *(const f32x4*)(ssrow + 8), d = *(const f32x4*)(ssrow + 12);
    const float s = ((a[0] + a[1]) + (a[2] + a[3])) + ((b[0] + b[1]) + (b[2] + b[3])) + ((c[0] + c[1]) + (c[2] + c[3])) + ((d[0] + d[1]) + (d[2] + d[3]));
    return rsqrtf(s * (1.f / DM) + 1e-6f);
}
template <bool BASE_F32> struct EpiResidualB {
    static constexpr bool PERM = !BASE_F32;
    const float* basef; bf16_t* hb; float* SS;
    __device__ __forceinline__ void operator()(const f32x4 (&acc)[2][2][4][2], const Unit& u, int wr, int wc, int fr, int fq) const {
        const int row0 = u.arow + wr * 64 + fr, col0 = u.pn * BM + wc * 32 + (BASE_F32 ? 4 : 8) * fq;
        if constexpr (!BASE_F32) {
            u32x4 bw[2][4][2]; const char* hbc = (const char*)hb;
#pragma unroll
            for (int ai = 0; ai < 2; ++ai)
#pragma unroll
                for (int m = 0; m < 4; ++m) { const unsigned off = (unsigned)((row0 + ai * HALF + m * 16) * DM + col0) * 2u;
#pragma unroll
                    for (int bj = 0; bj < 2; ++bj) bw[ai][m][bj] = *(const u32x4*)(hbc + (size_t)(off + bj * HALF * 2)); }
#pragma unroll
            for (int ai = 0; ai < 2; ++ai)
#pragma unroll
                for (int m = 0; m < 4; ++m) { const int row = row0 + ai * HALF + m * 16; const unsigned off = (unsigned)(row * DM + col0) * 2u; f32x4 v[2][2];
#pragma unroll
                    for (int bj = 0; bj < 2; ++bj) { const u32x4 w = bw[ai][m][bj];
                        v[bj][0] = (f32x4){bf_lo(w.x), bf_hi(w.x), bf_lo(w.y), bf_hi(w.y)} + acc[ai][bj][m][0]; v[bj][1] = (f32x4){bf_lo(w.z), bf_hi(w.z), bf_lo(w.w), bf_hi(w.w)} + acc[ai][bj][m][1];
                        u32x4 o; o.x = cvt_pk_bf16(v[bj][0][0], v[bj][0][1]); o.y = cvt_pk_bf16(v[bj][0][2], v[bj][0][3]); o.z = cvt_pk_bf16(v[bj][1][0], v[bj][1][1]); o.w = cvt_pk_bf16(v[bj][1][2], v[bj][1][3]);
                        *(u32x4*)((char*)hb + (size_t)(off + bj * HALF * 2)) = o; }
                    const float ss = row_sumsq16(v[0][0], v[0][1], v[1][0], v[1][1]);
                    if (fq == 0) SS[(size_t)row * 16 + u.pn * 4 + wc] = ss; }
        } else {
#pragma unroll
        for (int ai = 0; ai < 2; ++ai) {
            f32x4 bs[4][2][2];
#pragma unroll
            for (int m = 0; m < 4; ++m) { const size_t off = (size_t)(row0 + ai * HALF + m * 16) * DM + col0;
#pragma unroll
                for (int bj = 0; bj < 2; ++bj)
#pragma unroll
                    for (int n = 0; n < 2; ++n) bs[m][bj][n] = *(const f32x4*)(basef + off + bj * HALF + n * 16); }
#pragma unroll
            for (int m = 0; m < 4; ++m) { const int row = row0 + ai * HALF + m * 16; const size_t off = (size_t)row * DM + col0; f32x4 v[2][2];
#pragma unroll
                for (int bj = 0; bj < 2; ++bj)
#pragma unroll
                    for (int n = 0; n < 2; ++n) { v[bj][n] = bs[m][bj][n] + acc[ai][bj][m][n];
                        u32x2 o; o.x = cvt_pk_bf16(v[bj][n][0], v[bj][n][1]); o.y = cvt_pk_bf16(v[bj][n][2], v[bj][n][3]); *(u32x2*)(hb + off + bj * HALF + n * 16) = o; }
                const float ss = row_sumsq16(v[0][0], v[0][1], v[1][0], v[1][1]);
                if (fq == 0) SS[(size_t)row * 16 + u.pn * 4 + wc] = ss; }
            asm volatile("" ::: "memory"); }
        }
    }
};
struct EpiBf16RowScale {
    static constexpr bool PERM = true;
    bf16_t* O; int ldc; const LAS float* rl;
    __device__ __forceinline__ void operator()(const f32x4 (&acc)[2][2][4][2], const Unit& u, int wr, int wc, int fr, int fq) const {
        const int row0 = u.arow + wr * 64 + fr, col0 = u.pn * BM + wc * 32 + 8 * fq; const LAS float* rp = rl + u.aux * 256 + wr * 64 + fr;
#pragma unroll
        for (int ai = 0; ai < 2; ++ai)
#pragma unroll
            for (int m = 0; m < 4; ++m) { const int row = row0 + ai * HALF + m * 16; const float r = rp[ai * HALF + m * 16]; bf16_t* rowp = O + (size_t)row * ldc + col0;
#pragma unroll
                for (int bj = 0; bj < 2; ++bj) { const f32x4 v0 = acc[ai][bj][m][0] * r, v1 = acc[ai][bj][m][1] * r;
                    u32x4 w; w.x = cvt_pk_bf16(v0[0], v0[1]); w.y = cvt_pk_bf16(v0[2], v0[3]); w.z = cvt_pk_bf16(v1[0], v1[1]); w.w = cvt_pk_bf16(v1[2], v1[3]);
                    *(u32x4*)(rowp + bj * HALF) = w; } }
    }
};
struct RowScaleSched : DenseSched {
    const float* SS; LAS float* rl;
    __device__ bool next(int i, Unit& u) const { const bool ok = DenseSched::next(i, u); u.aux = i & 1; return ok; }
    __device__ __forceinline__ void a_ready(const Unit& u) const { const int t = threadIdx.x;
        if (t < 256) rl[u.aux * 256 + t] = rms_from_ss(SS + (size_t)(u.arow + t) * 16); }
    __device__ __forceinline__ void done(const Unit&) const {}
};
struct EpiResidual {
    static constexpr bool PERM = false;
    const float* base; float* out; int ldc;
    __device__ __forceinline__ void operator()(const f32x4 (&acc)[2][2][4][2], const Unit& u, int wr, int wc, int fr, int fq) const {
        const int row0 = u.arow + wr * 64 + fr, col0 = u.pn * BM + wc * 32 + 4 * fq;
#pragma unroll
        for (int ai = 0; ai < 2; ++ai)
#pragma unroll
            for (int m = 0; m < 4; ++m) { const size_t off = (size_t)(row0 + ai * HALF + m * 16) * ldc + col0;
#pragma unroll
                for (int bj = 0; bj < 2; ++bj)
#pragma unroll
                    for (int n = 0; n < 2; ++n) { const f32x4 bs = *(const f32x4*)(base + off + bj * HALF + n * 16); *(f32x4*)(out + off + bj * HALF + n * 16) = bs + acc[ai][bj][m][n]; } }
    }
};
}
#define XB_TMO      128
#define XB_XCNT(j)  (256  + 64 * (j))
#define XB_XSUB(j)  (1280 + 64 * (j))
#define XB_XGEN(j)  (2304 + 64 * (j))
#define XB_TOP      3328
#define XB_TOPGEN   3392
#define XCD_BAR_WORDS 3456
#define XB_SPIN_CAP (1u << 22)
__device__ __forceinline__ unsigned xb_ld(unsigned* p)              { return __hip_atomic_load(p, __ATOMIC_RELAXED, __HIP_MEMORY_SCOPE_AGENT); }
__device__ __forceinline__ unsigned xb_add(unsigned* p, unsigned v) { return __hip_atomic_fetch_add(p, v, __ATOMIC_RELAXED, __HIP_MEMORY_SCOPE_AGENT); }
__device__ __forceinline__ unsigned xb_xcc_id() { return (unsigned)__builtin_amdgcn_s_getreg((3 << 11) | 20) & 0xFu; }
#define XB_SPIN(cond, bar) do { unsigned _sp = 0; while (cond) { __builtin_amdgcn_s_sleep(1); \
    if ((++_sp & 255u) == 0u) { if (xb_ld(&(bar)[XB_TMO])) break; if (_sp > XB_SPIN_CAP) { atomicAdd(&(bar)[XB_TMO], 1u); break; } } } } while (0)
struct XcdBarrier { unsigned* bar; unsigned x; volatile LAS unsigned* st; };
__device__ __forceinline__ XcdBarrier xcd_barrier_post(unsigned* bar, volatile LAS unsigned* st) {
    XcdBarrier b; b.bar = bar; b.x = xb_xcc_id(); b.st = st;
    if (threadIdx.x == 0) (void)xb_add(&bar[XB_XCNT(b.x)], 1u);
    return b;
}
__device__ __forceinline__ void xcd_barrier_complete(unsigned* bar, unsigned x, unsigned& nloc, unsigned& nx) {
    const unsigned G = gridDim.x * gridDim.y * gridDim.z;
    unsigned sum, cnt, mine, sp = 0u;
    for (;;) {
        sum = 0u; cnt = 0u; mine = 0u;
#pragma unroll
        for (unsigned j = 0; j < 16; ++j) { const unsigned c = xb_ld(&bar[XB_XCNT(j)]); sum += c; cnt += (c > 0u) ? 1u : 0u; mine = (j == x) ? c : mine; }
        if (sum == G) break;
        __builtin_amdgcn_s_sleep(1);
        if ((++sp & 255u) == 0u) { if (xb_ld(&bar[XB_TMO])) break; if (sp > XB_SPIN_CAP) { atomicAdd(&bar[XB_TMO], 1u); break; } }
    }
    nloc = mine > 0u ? mine : 1u; nx = cnt > 0u ? cnt : 1u;
}
__device__ __forceinline__ void xcd_barrier(const XcdBarrier& b) {
    asm volatile("s_waitcnt vmcnt(0)" ::: "memory");
    __syncthreads();
    if (threadIdx.x == 0) {
        unsigned* bar = b.bar;
        __builtin_amdgcn_s_waitcnt(0);
        unsigned nloc = b.st[0], nx = b.st[1];
        if (nloc == 0u) { xcd_barrier_complete(bar, b.x, nloc, nx); b.st[0] = nloc; b.st[1] = nx; }
        const unsigned old = xb_add(&bar[XB_XSUB(b.x)], 1u);
        const unsigned gen = old / nloc;
        if (old + 1u == (gen + 1u) * nloc) {
            __builtin_amdgcn_fence(__ATOMIC_RELEASE, "agent");
            asm volatile("s_waitcnt vmcnt(0)" ::: "memory");
            const unsigned og = xb_add(&bar[XB_TOP], 1u);
            const unsigned tg = og / nx;
            if (og + 1u == (tg + 1u) * nx) xb_add(&bar[XB_TOPGEN], 1u);
            else XB_SPIN(xb_ld(&bar[XB_TOPGEN]) == tg, bar);
            __builtin_amdgcn_fence(__ATOMIC_ACQUIRE, "agent");
            xb_add(&bar[XB_XGEN(b.x)], 1u);
            asm volatile("s_waitcnt vmcnt(0)" ::: "memory");
        } else {
            XB_SPIN(xb_ld(&bar[XB_XGEN(b.x)]) == gen, bar);
            __builtin_amdgcn_fence(__ATOMIC_ACQUIRE, "agent");
            asm volatile("s_waitcnt vmcnt(0)" ::: "memory");
        }
    }
    __syncthreads();
}
struct Params { const float* in[38]; float* out; unsigned char* ws; int ph_lo, ph_hi; };
enum { I_X = 0, I_EVNORM, I_EVWIN, I_EVWOUT, I_LAMRE, I_LAMIM, I_LOGDT, I_BRE, I_BIM, I_CRE, I_CIM, I_S5D, I_WGLU, I_CONVW, I_CONVB,
       I_ODNORM, I_ODWIN, I_ODWOUT, I_MQN, I_MKN, I_NQN, I_NKCN, I_NKSN, I_NKWN, I_PEK, I_W1K, I_W2K, I_PEV, I_W1V, I_W2V,
       I_MOENORM, I_WGRP, I_BGRP, I_WEXP, I_BEXP, I_WGATE, I_WUP, I_WDOWN };

struct Ctx {
    LAS unsigned char* lds; int tid, lane, wave, G, bid;
};
#define LDS_WAIT() asm volatile("s_waitcnt lgkmcnt(0)" ::: "memory")

__device__ __forceinline__ void transpose_item(const float* W, int ldw, int Nvalid, bf16_t* WT, int ldt, int mode, int rowoff, LAS float* scr, int kb, int nb, int lane, const float* kgain = nullptr) {
    (void)scr;
    const int kq = lane >> 3, nq = lane & 7, k0 = 64 * kb + 8 * kq, n = 32 * nb + 4 * nq;
    f32x4 a[8];
#pragma unroll
    for (int i = 0; i < 8; ++i) a[i] = n < Nvalid ? *(const f32x4*)(W + (size_t)(k0 + i) * ldw + n) : (f32x4){0.f, 0.f, 0.f, 0.f};
    if (kgain) {
#pragma unroll
        for (int i = 0; i < 8; ++i) a[i] = a[i] * kgain[k0 + i]; }
#pragma unroll
    for (int j = 0; j < 4; ++j) { const int nn = n + j; int row = (mode == 0 ? nn : ((nn >> 7) * 256 + (nn & 127))) + rowoff;
        if (mode == 2) {
            row = nn < 256 ? nn : nn < 1024 ? 256 + ((nn - 256) >> 7) * 256 + ((nn - 256) & 127) : nn < 1792 ? 1792 + (nn - 1024) : 256 + ((nn - 1792) >> 7) * 256 + 128 + ((nn - 1792) & 127); }
        u32x4 o; o.x = cvt_pk_bf16(a[0][j], a[1][j]); o.y = cvt_pk_bf16(a[2][j], a[3][j]); o.z = cvt_pk_bf16(a[4][j], a[5][j]); o.w = cvt_pk_bf16(a[6][j], a[7][j]);
        *(u32x4*)(WT + (size_t)row * ldt + k0) = o; }
}
__device__ __forceinline__ void row_to_bf16_r(const float* xrow, bf16_t* orow, float* rout, int lane) {
    const f32x4* xr = (const f32x4*)xrow + lane;
    f32x4 v[4]; float s = 0.f;
#pragma unroll
    for (int j = 0; j < 4; ++j) { v[j] = xr[64 * j]; s += (v[j].x * v[j].x + v[j].y * v[j].y) + (v[j].z * v[j].z + v[j].w * v[j].w); }
    const float r = rsqrtf(wave_sum(s) * (1.f / DM) + 1e-6f);
    u32x2* o8 = (u32x2*)orow + lane;
#pragma unroll
    for (int j = 0; j < 4; ++j) { u32x2 w; w.x = cvt_pk_bf16(v[j].x, v[j].y); w.y = cvt_pk_bf16(v[j].z, v[j].w); o8[64 * j] = w; }
    if (lane == 0) *rout = r;
}

__device__ __forceinline__ void moe_weight_item(const Params& P, unsigned char* ws, int le, int r, LAS float* scr, int lane) {
    bf16_t* w1t = (bf16_t*)(ws + WS_MW1T) + (size_t)le * 512 * 1024; bf16_t* wdt = (bf16_t*)(ws + WS_MWDT) + (size_t)le * 1024 * 256;
    if (r < 128) transpose_item(P.in[I_WGATE] + (size_t)le * 1024 * 256, 256, 256, w1t, 1024, 1, 0, scr, r / 8, r % 8, lane, P.in[I_MOENORM] + (le >> 4) * DM);
    else if (r < 256) transpose_item(P.in[I_WUP] + (size_t)le * 1024 * 256, 256, 256, w1t, 1024, 1, 128, scr, (r - 128) / 8, (r - 128) % 8, lane, P.in[I_MOENORM] + (le >> 4) * DM);
    else transpose_item(P.in[I_WDOWN] + (size_t)le * 256 * 1024, 1024, 1024, wdt, 256, 0, 0, scr, (r - 256) / 32, (r - 256) % 32, lane);
}
__device__ __forceinline__ void late_weight_items(Ctx& C, const Params& P, int rank, int nranks) {
    unsigned char* ws = P.ws; LAS float* scr = (LAS float*)(C.lds + C.wave * 16384);
    constexpr int IT_MOE0 = 16 * 384, IT_IN1 = 16 * 80, IT_OUT = 16 * 32, IT_C1 = 32 * 8;
    for (int it = rank * NWAVES + C.wave; it < IT_MOE0 + IT_IN1 + IT_OUT + 2 * IT_C1; it += nranks * NWAVES) {
        int r = it;
        if (r < IT_MOE0) { moe_weight_item(P, ws, r / 384, r % 384, scr, C.lane); continue; } r -= IT_MOE0;
        if (r < IT_IN1) { transpose_item(P.in[I_ODWIN], IN_ODD, IN_ODD, (bf16_t*)(ws + WS_WIN1T), DM, 0, 0, scr, r / 80, r % 80, C.lane, P.in[I_ODNORM]); continue; } r -= IT_IN1;
        if (r < IT_OUT) { transpose_item(P.in[I_ODWOUT], DM, DM, (bf16_t*)(ws + WS_WOUT1T), DM, 0, 0, scr, r / 32, r % 32, C.lane); continue; } r -= IT_OUT;
        { const int kv = r >= IT_C1, q = r - kv * IT_C1, hf = q >> 7, kb = (q >> 3) & 15, nb = q & 7;
          transpose_item(P.in[kv ? I_W1V : I_W1K] + (size_t)hf * 1024 * 256, 256, 256, (bf16_t*)(ws + WS_C1T) + (size_t)kv * 512 * 1024, 1024, 0, 256 * hf, scr, kb, nb, C.lane); }
    }
}
__device__ __forceinline__ void cplx_exp(float x, float y, float& re, float& im) {
    const float n = rintf(y * 0.15915494309189535f);
    float r = fmaf(-n, 6.28318548202514648f, y); r = fmaf(-n, -1.7484555e-7f, r);
    const float m = __expf(x); re = m * __cosf(r); im = m * __sinf(r);
}
__device__ __forceinline__ void phase_prep(Ctx& C, const Params& prm) {
    const Params& P = prm; unsigned char* ws = P.ws;
    LAS float* scr = (LAS float*)(C.lds + C.wave * 16384);
    const int gw = C.bid * NWAVES + C.wave, NGW = C.G * NWAVES;
    if (C.bid == 0) for (int i = C.tid; i < 4096; i += NTHREADS) ((unsigned*)(ws + WS_CTL))[i] = 0u;
    constexpr int IT_IN0 = 16 * 80, IT_OUT = 16 * 32, IT_GLU = 4 * 8;
    for (int it = gw; it < IT_IN0 + IT_OUT + IT_GLU; it += NGW) {
        int r = it;
        if (r < IT_IN0) { transpose_item(P.in[I_EVWIN], IN_EVEN, IN_EVEN, (bf16_t*)(ws + WS_WIN0T), DM, 2, 0, scr, r / 80, r % 80, C.lane, P.in[I_EVNORM]); continue; } r -= IT_IN0;
        if (r < IT_OUT) { transpose_item(P.in[I_EVWOUT], DM, DM, (bf16_t*)(ws + WS_WOUT0T), DM, 0, 0, scr, r / 32, r % 32, C.lane); continue; } r -= IT_OUT;
        transpose_item(P.in[I_WGLU], 256, 256, (bf16_t*)(ws + S5_GLUT), 256, 0, 0, scr, r / 8, r % 8, C.lane);
    }
    for (int m = gw; m < T; m += 2 * NGW) {
        const int m2 = m + NGW; const f32x4* xa = (const f32x4*)(P.in[I_X] + (size_t)m * DM) + 2 * C.lane; const f32x4* xb2 = (const f32x4*)(P.in[I_X] + (size_t)m2 * DM) + 2 * C.lane;
        f32x4 va[4], vb[4]; float sa = 0.f, sb = 0.f;
#pragma unroll
        for (int j = 0; j < 2; ++j) { va[2 * j] = xa[128 * j]; va[2 * j + 1] = xa[128 * j + 1]; vb[2 * j] = xb2[128 * j]; vb[2 * j + 1] = xb2[128 * j + 1]; }
#pragma unroll
        for (int j = 0; j < 4; ++j) { sa += (va[j].x * va[j].x + va[j].y * va[j].y) + (va[j].z * va[j].z + va[j].w * va[j].w); sb += (vb[j].x * vb[j].x + vb[j].y * vb[j].y) + (vb[j].z * vb[j].z + vb[j].w * vb[j].w); }
        u32x4* oa = (u32x4*)((bf16_t*)(ws + WS_XN) + (size_t)m * DM) + C.lane; u32x4* ob = (u32x4*)((bf16_t*)(ws + WS_XN) + (size_t)m2 * DM) + C.lane;
#pragma unroll
        for (int j = 0; j < 2; ++j) { u32x4 w; w.x = cvt_pk_bf16(va[2 * j].x, va[2 * j].y); w.y = cvt_pk_bf16(va[2 * j].z, va[2 * j].w); w.z = cvt_pk_bf16(va[2 * j + 1].x, va[2 * j + 1].y); w.w = cvt_pk_bf16(va[2 * j + 1].z, va[2 * j + 1].w); oa[64 * j] = w;
            w.x = cvt_pk_bf16(vb[2 * j].x, vb[2 * j].y); w.y = cvt_pk_bf16(vb[2 * j].z, vb[2 * j].w); w.z = cvt_pk_bf16(vb[2 * j + 1].x, vb[2 * j + 1].y); w.w = cvt_pk_bf16(vb[2 * j + 1].z, vb[2 * j + 1].w); ob[64 * j] = w; }
        sa = wave_sum(sa); sb = wave_sum(sb);
        if (C.lane == 0) { ((float*)(ws + WS_R0))[m] = rsqrtf(sa * (1.f / DM) + 1e-6f); ((float*)(ws + WS_R0))[m2] = rsqrtf(sb * (1.f / DM) + 1e-6f); }
    }
    { constexpr int RS = 1032;
      for (int i = C.bid * NTHREADS + C.tid; i < 2 * 20 * DM; i += C.G * NTHREADS) { const int layer = i / (20 * DM), r = i % (20 * DM), n = r / DM, k = r % DM;
          const float w = n < 16 ? P.in[I_WEXP][(size_t)layer * DM * 16 + k * 16 + n] : P.in[I_WGRP][(size_t)layer * DM * 4 + k * 4 + (n - 16)];
          const float p = w * P.in[I_MOENORM][layer * DM + k]; const unsigned h = cvt_pk_bf16(p, 0.f) & 0xffffu;
          bf16_t* img = (bf16_t*)(ws + WS_TOKI + (size_t)layer * (2 * 20 * RS * 2));
          img[n * RS + k] = (bf16_t)h; img[20 * RS + n * RS + k] = (bf16_t)(cvt_pk_bf16(p - bf_lo(h), 0.f) & 0xffffu); } }
    { const int gt = C.bid * NTHREADS + C.tid;
      if (gt < 1024) { const int g = gt >> 6;
        const float lr = P.in[I_LAMRE][gt], li = P.in[I_LAMIM][gt], dt = __expf(P.in[I_LOGDT][g]);
        float are, aim; cplx_exp(lr * dt, li * dt, are, aim);
        const float den = lr * lr + li * li, fre = ((are - 1.f) * lr + aim * li) / den, fim = (aim * lr - (are - 1.f) * li) / den;
        ((f32x2*)(ws + WS_S5A))[gt] = (f32x2){are, aim};
        float* bb = (float*)(ws + WS_S5BB) + (size_t)gt * 32;
        for (int h = 0; h < 16; ++h) { const float br = P.in[I_BRE][(size_t)gt * 16 + h], bi = P.in[I_BIM][(size_t)gt * 16 + h]; bb[h] = fre * br - fim * bi; bb[16 + h] = fre * bi + fim * br; } }
    }
    for (int it = gw; it < 256; it += NGW) { const int kv = it >> 7, jg = (it >> 5) & 3, sl = it & 31; const float* pe = P.in[kv ? I_PEV : I_PEK] + sl * 64; const float* w1 = P.in[kv ? I_W1V : I_W1K] + (size_t)sl * 64 * 256 + jg * 64 + C.lane;
        float s = 0.f;
#pragma unroll 16
        for (int i = 0; i < 64; ++i) s += pe[i] * w1[(size_t)i * 256];
        ((float*)(ws + WS_C1BP))[((kv * 4 + jg) * 32 + sl) * 64 + C.lane] = s; }
    for (int i = C.bid * NTHREADS + C.tid; i < 16 * 65 * 64; i += C.G * NTHREADS) { const int pp = i & 63, k = (i >> 6) % 65, g = i / (65 * 64);
        const float lr = P.in[I_LAMRE][g * 64 + pp], li = P.in[I_LAMIM][g * 64 + pp], dt = __expf(P.in[I_LOGDT][g]); float re, im; cplx_exp(lr * dt * (float)k, li * dt * (float)k, re, im);
        ((f32x2*)(ws + S5_AP))[i] = (f32x2){re, im}; }
}

__device__ __forceinline__ void s5_load_u(const bf16_t* proj, int tok0, int g, LAS float* ubuf, int lane) {
    { const u32x4* src = (const u32x4*)(proj + (size_t)(tok0 + lane) * IN_EVEN + g * 16); const u32x4 a = src[0], b = src[1];
        LAS f32x4* d = (LAS f32x4*)(ubuf + lane * 16);
        d[0] = (f32x4){bf_lo(a.x), bf_hi(a.x), bf_lo(a.y), bf_hi(a.y)}; d[1] = (f32x4){bf_lo(a.z), bf_hi(a.z), bf_lo(a.w), bf_hi(a.w)};
        d[2] = (f32x4){bf_lo(b.x), bf_hi(b.x), bf_lo(b.y), bf_hi(b.y)}; d[3] = (f32x4){bf_lo(b.z), bf_hi(b.z), bf_lo(b.w), bf_hi(b.w)}; }
    LDS_WAIT();
}
__device__ __forceinline__ void phase_s5a_conv(Ctx& C, const Params& prm, int rank, int nranks) {
    const Params& P = prm; unsigned char* ws = P.ws;
    if (rank == 0) { const float* pp = (const float*)(ws + WS_C1BP) + ((C.tid >> 6) * 32) * 64 + (C.tid & 63); float s = 0.f;
        for (int q = 0; q < 32; ++q) s += pp[q * 64];
        ((float*)(ws + WS_C1B))[C.tid] = s; }
    const bf16_t* proj = (const bf16_t*)(ws + WS_PROJ);
    bf16_t* A2 = (bf16_t*)(ws + WS_A2);
    const float* cw = P.in[I_CONVW]; const float* cb = P.in[I_CONVB];
    for (int it = rank * NTHREADS + C.tid; it < (T / 32) * 96; it += nranks * NTHREADS) {
        const int cg8 = it % 96, tb = it / 96, c0 = cg8 * 8, tok0 = tb * 32, l0 = tok0 % SEQ;
        float w0[8], w1[8], w2[8], bb[8];
#pragma unroll
        for (int j = 0; j < 8; ++j) { w0[j] = cw[c0 + j]; w1[j] = cw[768 + c0 + j]; w2[j] = cw[1536 + c0 + j]; bb[j] = cb[c0 + j]; }
        float zm2[8], zm1[8];
#pragma unroll
        for (int j = 0; j < 8; ++j) { zm2[j] = 0.f; zm1[j] = 0.f; }
#pragma unroll 4
        for (int dt = -2; dt < 32; ++dt) {
            const int l = l0 + dt; if (l < 0) continue;
            const bf16_t* row = proj + (size_t)(tok0 + dt) * 1536;
            const u32x4 zw = *(const u32x4*)(row + c0);
            float z[8]; z[0] = bf_lo(zw.x); z[1] = bf_hi(zw.x); z[2] = bf_lo(zw.y); z[3] = bf_hi(zw.y); z[4] = bf_lo(zw.z); z[5] = bf_hi(zw.z); z[6] = bf_lo(zw.w); z[7] = bf_hi(zw.w);
            if (dt >= 0) { const u32x4 gb = *(const u32x4*)(row + 768 + c0); float gbf[8] = {bf_lo(gb.x), bf_hi(gb.x), bf_lo(gb.y), bf_hi(gb.y), bf_lo(gb.z), bf_hi(gb.z), bf_lo(gb.w), bf_hi(gb.w)};
                float y[8];
#pragma unroll
                for (int j = 0; j < 8; ++j) y[j] = gbf[j] * (w0[j] * zm2[j] + w1[j] * zm1[j] + w2[j] * z[j] + bb[j]);
                u32x4 o; o.x = cvt_pk_bf16(y[0], y[1]); o.y = cvt_pk_bf16(y[2], y[3]); o.z = cvt_pk_bf16(y[4], y[5]); o.w = cvt_pk_bf16(y[6], y[7]);
                *(u32x4*)(A2 + (size_t)(tok0 + dt) * DM + 256 + c0) = o; }
#pragma unroll
            for (int j = 0; j < 8; ++j) { zm2[j] = zm1[j]; zm1[j] = z[j]; }
        }
    }
}

__device__ __forceinline__ int pair_index(int a, int b) { return a == 0 ? (b - 1) : (a == 1 ? (b + 1) : 5); }
__device__ __forceinline__ void phase_moe_route(Ctx& C, const Params& prm, int layer) {
    const Params& P = prm; unsigned char* ws = P.ws;
    const bf16_t* hb = (const bf16_t*)(ws + WS_XN); const float* SS = (const float*)(ws + WS_SS); const float* g = P.in[I_MOENORM] + layer * DM;
    const float* wg = P.in[I_WGRP] + (size_t)layer * DM * 4; const float* we = P.in[I_WEXP] + (size_t)layer * DM * 16;
    const float* bg = P.in[I_BGRP] + layer * 4; const float* be = P.in[I_BEXP] + layer * 16;
    constexpr int RS = 1032;
    LAS bf16_t* Wh = (LAS bf16_t*)C.lds; LAS bf16_t* Wl = Wh + 20 * RS;
    LAS int* hist = (LAS int*)(C.lds + 2 * 20 * RS * 2);
    LAS int* tb = hist + 32;
    LAS int* tp = tb + 128;
    LAS int* gbase = tp + 128;
    LAS float* twa = (LAS float*)(gbase + 32); LAS float* twb = twa + 128; LAS float* trr = twb + 128;
    const int lane = C.lane;
    { const u32x4* src = (const u32x4*)(ws + WS_TOKI + (size_t)layer * (2 * 20 * RS * 2)); LAS u32x4* dst = (LAS u32x4*)C.lds;
      for (int i = C.tid; i < 2 * 20 * RS * 2 / 16; i += NTHREADS) dst[i] = src[i]; }
    if (C.tid < 32) hist[C.tid] = 0;
    __syncthreads();
    const int rows_per_block = T / C.G;
    const int row0 = C.bid * rows_per_block;
    const int fr = lane & 15, fq = lane >> 4;
    for (int rt0 = C.wave * 16; rt0 < rows_per_block; rt0 += NWAVES * 16) {
        const int lr = rt0 + fr, m = row0 + lr;
        const u32x4* xp = (const u32x4*)(hb + (size_t)m * DM) + fq;
        u32x4 xv[32];
#pragma unroll
        for (int kk = 0; kk < 32; ++kk) xv[kk] = xp[kk * 4];
        const f32x4 sq = *(const f32x4*)(SS + (size_t)m * 16 + fq * 4);
        const f32x4 bev = *(const f32x4*)(be + fq * 4);
        const LAS u32x4* whE = (const LAS u32x4*)(Wh + fr * RS) + fq; const LAS u32x4* wlE = (const LAS u32x4*)(Wl + fr * RS) + fq;
        const LAS u32x4* whG = (const LAS u32x4*)(Wh + (16 + (fr & 3)) * RS) + fq; const LAS u32x4* wlG = (const LAS u32x4*)(Wl + (16 + (fr & 3)) * RS) + fq;
        f32x4 aE = {0.f, 0.f, 0.f, 0.f}, aE2 = aE, aG = aE, aG2 = aE;
#pragma unroll
        for (int kk = 0; kk < 32; ++kk) { const bf16x8 xb = __builtin_bit_cast(bf16x8, xv[kk]);
            aE = __builtin_amdgcn_mfma_f32_16x16x32_bf16(__builtin_bit_cast(bf16x8, whE[kk * 4]), xb, aE, 0, 0, 0);
            aE2 = __builtin_amdgcn_mfma_f32_16x16x32_bf16(__builtin_bit_cast(bf16x8, wlE[kk * 4]), xb, aE2, 0, 0, 0);
            aG = __builtin_amdgcn_mfma_f32_16x16x32_bf16(__builtin_bit_cast(bf16x8, whG[kk * 4]), xb, aG, 0, 0, 0);
            aG2 = __builtin_amdgcn_mfma_f32_16x16x32_bf16(__builtin_bit_cast(bf16x8, wlG[kk * 4]), xb, aG2, 0, 0, 0); }
        float ssum = (sq[0] + sq[1]) + (sq[2] + sq[3]); ssum += __shfl_xor(ssum, 16); ssum += __shfl_xor(ssum, 32);
        const float r = rsqrtf(ssum * (1.f / DM) + 1e-6f);
        float gl[4], el[4];
#pragma unroll
        for (int n = 0; n < 4; ++n) { gl[n] = (aG[n] + aG2[n]) * r + bg[n]; el[n] = (aE[n] + aE2[n]) * r + bev[n]; }
        int gi = 0; float gm = gl[0];
#pragma unroll
        for (int n = 1; n < 4; ++n) if (gl[n] > gm) { gm = gl[n]; gi = n; }
        float gs = 0.f;
#pragma unroll
        for (int n = 0; n < 4; ++n) gs += __expf(gl[n] - gm);
        const float gwt = 1.f / gs;
        int e1 = 0; float v1 = el[0];
#pragma unroll
        for (int n = 1; n < 4; ++n) if (el[n] > v1) { v1 = el[n]; e1 = n; }
        int e2 = -1; float v2 = -3.0e38f;
#pragma unroll
        for (int n = 0; n < 4; ++n) if (n != e1 && (e2 < 0 || el[n] > v2)) { e2 = n; v2 = el[n]; }
        const float p2 = __expf(v2 - v1), w1 = gwt / (1.f + p2), w2 = gwt * p2 / (1.f + p2);
        const int ea = e1 < e2 ? e1 : e2, eb = e1 < e2 ? e2 : e1; const float wa = e1 < e2 ? w1 : w2, wb = e1 < e2 ? w2 : w1;
        if (fq == gi) {
            const int bucket = gi * 6 + pair_index(ea, eb);
            const int lp = __hip_atomic_fetch_add(&hist[bucket], 1, __ATOMIC_RELAXED, __HIP_MEMORY_SCOPE_WORKGROUP); tb[lr] = bucket; tp[lr] = lp;
            twa[lr] = wa; twb[lr] = wb; trr[lr] = r; }
    }
    __syncthreads();
    unsigned* cnt = (unsigned*)(ws + WS_CTL) + CW_MOECNT + layer * 32;
    if (C.tid < 24) gbase[C.tid] = (int)atomicAdd(&cnt[C.tid], (unsigned)hist[C.tid]);
    __syncthreads();
    { int* rt2 = (int*)(ws + WS_RT2); f32x4* wr2 = (f32x4*)(ws + WS_WR2);
      for (int lr = C.tid; lr < rows_per_block; lr += NTHREADS) { const int bk = tb[lr], pos = gbase[bk] + tp[lr];
          rt2[(size_t)bk * T + pos] = row0 + lr; wr2[(size_t)bk * T + pos] = (f32x4){twa[lr], twb[lr], trr[lr], 0.f}; } }
    __syncthreads();
}
struct MoeTab { int tiles_before[25]; };
__device__ __forceinline__ void moe_load_tab(const unsigned* cnt, LAS int* tabl, int tid) {
    if (tid < 64) { int tiles = 0; if (tid < 24) tiles = (int)((__hip_atomic_load(cnt + tid, __ATOMIC_RELAXED, __HIP_MEMORY_SCOPE_AGENT) + 255u) >> 8);
        int pre = tiles;
#pragma unroll
        for (int d = 1; d < 32; d <<= 1) { const int o = __shfl_up(pre, d); if ((tid & 63) >= d) pre += o; }
        if (tid < 24) tabl[tid] = pre - tiles;
        if (tid == 23) tabl[24] = pre; }
    if (tid < 24) tabl[40 + tid] = (int)__hip_atomic_load(cnt + tid, __ATOMIC_RELAXED, __HIP_MEMORY_SCOPE_AGENT);
}
namespace pg8 {
struct MoeSched {
    const LAS int* tabl; int G, c, mode; unsigned* ready;
    unsigned* q; LAS int* tk;
    __device__ bool decode(int L, Unit& u) const {
        const int tile = L >> 2, pn = L & 3; int b = 0;
        for (int qq = 1; qq < 24; ++qq) if (tile >= tabl[qq]) b = qq;
        const int grp = b / 6, pr = b % 6; const int ea = pr < 3 ? 0 : (pr < 5 ? 1 : 2), eb = pr < 3 ? pr + 1 : (pr < 5 ? pr - 1 : 3);
        u.arow = tile * 256; u.pn = pn; u.nt = mode == 0 ? 16 : 8;
        u.aux = b * T + (tile - tabl[b]) * 256;
        if (mode == 0) { const int e = grp * 4 + (pn < 2 ? ea : eb); u.b0 = (e * 512 + (pn & 1) * 256) * 1024 * 2; u.b1 = u.b0; }
        else { u.b0 = ((grp * 4 + ea) * 1024 + pn * 256) * 256 * 2; u.b1 = ((grp * 4 + eb) * 1024 + pn * 256) * 256 * 2 - 4 * 128; }
        return true;
    }
    __device__ bool next(int i, Unit& u) const {
        const int nun = tabl[24] * 4; int s;
        if (i == 0 && mode == 1) s = tk[1];
        else { if (threadIdx.x == 0) tk[0] = (int)atomicAdd(q, 1u);
               asm volatile("s_waitcnt lgkmcnt(0)" ::: "memory"); __builtin_amdgcn_s_barrier(); asm volatile("" ::: "memory"); s = tk[0]; }
        s = __builtin_amdgcn_readfirstlane(s);
        const int L = s - mode * nun;
        if (L >= nun) { if (threadIdx.x == 0) tk[1] = s; asm volatile("s_waitcnt lgkmcnt(0)" ::: "memory"); return false; }
        return decode(L, u);
    }
    __device__ __forceinline__ void done(const Unit& u) const {
        if (mode == 0) { asm volatile("s_waitcnt vmcnt(0)" ::: "memory");
            if ((threadIdx.x & 63) == 0) __hip_atomic_fetch_add(ready + (u.arow >> 8), 1u, __ATOMIC_RELAXED, __HIP_MEMORY_SCOPE_AGENT); } }
    __device__ __forceinline__ void a_ready(const Unit& u) const {
        if (mode == 1) {
            if (threadIdx.x < 64) {
                unsigned spins = 0;
                while ((unsigned)__builtin_amdgcn_readfirstlane((int)__hip_atomic_load(ready + (u.arow >> 8), __ATOMIC_RELAXED, __HIP_MEMORY_SCOPE_AGENT)) < 32u) { __builtin_amdgcn_s_sleep(2); if (++spins > (1u << 24)) break; }
                __builtin_amdgcn_fence(__ATOMIC_ACQUIRE, "agent");
                asm volatile("s_waitcnt vmcnt(0)" ::: "memory");
            }
            asm volatile("" ::: "memory"); __builtin_amdgcn_s_barrier(); asm volatile("" ::: "memory");
        } }
};
struct EpiSwiGLU {
    static constexpr bool PERM = true;
    bf16_t* H; const f32x4* wrow;
    __device__ __forceinline__ void operator()(const f32x4 (&acc)[2][2][4][2], const Unit& u, int wr, int wc, int fr, int fq) const {
        asm volatile("" : "+v"(fr), "+v"(fq));
        const int row0 = u.arow + wr * 64 + fr, slot = u.pn >> 1, col0 = slot * 256 + (u.pn & 1) * 128 + wc * 32 + 8 * fq;
        float wtv[2][4], rsv[2][4];
#pragma unroll
        for (int ai = 0; ai < 2; ++ai)
#pragma unroll
            for (int m = 0; m < 4; ++m) { const f32x4 w2 = wrow[u.aux + wr * 64 + fr + ai * HALF + m * 16]; wtv[ai][m] = slot ? w2.y : w2.x; rsv[ai][m] = w2.z; }
#pragma unroll
        for (int ai = 0; ai < 2; ++ai)
#pragma unroll
            for (int m = 0; m < 4; ++m) { const int row = row0 + ai * HALF + m * 16; const float wt = wtv[ai][m], rs = rsv[ai][m];
                float o[8];
#pragma unroll
                for (int n = 0; n < 2; ++n)
#pragma unroll
                    for (int j = 0; j < 4; ++j) { const float gv = acc[ai][0][m][n][j] * rs, uv = acc[ai][1][m][n][j] * rs; o[4 * n + j] = gv * sigmoidf_(gv) * uv * wt; }
                u32x4 w; w.x = cvt_pk_bf16(o[0], o[1]); w.y = cvt_pk_bf16(o[2], o[3]); w.z = cvt_pk_bf16(o[4], o[5]); w.w = cvt_pk_bf16(o[6], o[7]);
                unsigned long long* hp = (unsigned long long*)(H + (size_t)row * 512 + col0);
                __hip_atomic_store(hp, ((unsigned long long)w.y << 32) | w.x, __ATOMIC_RELAXED, __HIP_MEMORY_SCOPE_AGENT); __hip_atomic_store(hp + 1, ((unsigned long long)w.w << 32) | w.z, __ATOMIC_RELAXED, __HIP_MEMORY_SCOPE_AGENT); }
    }
};
template <bool FINAL> struct EpiScatterResB;
template <> struct EpiScatterResB<false> {
    static constexpr bool PERM = true;
    float* outf; bf16_t* hb; float* SS; const int* rowtok;
    __device__ __forceinline__ void operator()(const f32x4 (&acc)[2][2][4][2], const Unit& u, int wr, int wc, int fr, int fq) const {
        asm volatile("" : "+v"(fr), "+v"(fq));
        const int row0 = u.arow + wr * 64 + fr, col0 = u.pn * BM + wc * 32 + 8 * fq;
        int toks[2][4];
#pragma unroll
        for (int ai = 0; ai < 2; ++ai)
#pragma unroll
            for (int m = 0; m < 4; ++m) toks[ai][m] = rowtok[u.aux + wr * 64 + fr + ai * HALF + m * 16];
        u32x4 bw[2][4][2];
#pragma unroll
        for (int ai = 0; ai < 2; ++ai)
#pragma unroll
            for (int m = 0; m < 4; ++m) { const int tk = toks[ai][m] < 0 ? 0 : toks[ai][m]; const size_t off = (size_t)tk * DM + col0;
#pragma unroll
                for (int bj = 0; bj < 2; ++bj) bw[ai][m][bj] = *(const u32x4*)(hb + off + bj * HALF); }
#pragma unroll
        for (int ai = 0; ai < 2; ++ai)
#pragma unroll
            for (int m = 0; m < 4; ++m) { const int tok = toks[ai][m]; const int tk = tok < 0 ? 0 : tok; const size_t off = (size_t)tk * DM + col0; f32x4 v[2][2];
#pragma unroll
                for (int bj = 0; bj < 2; ++bj) { const u32x4 w = bw[ai][m][bj];
                    v[bj][0] = (f32x4){bf_lo(w.x), bf_hi(w.x), bf_lo(w.y), bf_hi(w.y)} + acc[ai][bj][m][0]; v[bj][1] = (f32x4){bf_lo(w.z), bf_hi(w.z), bf_lo(w.w), bf_hi(w.w)} + acc[ai][bj][m][1];
                    if (tok >= 0) { u32x4 o; o.x = cvt_pk_bf16(v[bj][0][0], v[bj][0][1]); o.y = cvt_pk_bf16(v[bj][0][2], v[bj][0][3]); o.z = cvt_pk_bf16(v[bj][1][0], v[bj][1][1]); o.w = cvt_pk_bf16(v[bj][1][2], v[bj][1][3]);
                        *(u32x4*)(hb + off + bj * HALF) = o; } }
                const float ss = row_sumsq16(v[0][0], v[0][1], v[1][0], v[1][1]); if (fq == 0 && tok >= 0) SS[(size_t)tok * 16 + u.pn * 4 + wc] = ss; }
    }
};
template <> struct EpiScatterResB<true> {
    static constexpr bool FINAL = true;
    static constexpr bool PERM = false;
    float* outf; bf16_t* hb; float* SS; const int* rowtok;
    __device__ __forceinline__ void operator()(const f32x4 (&acc)[2][2][4][2], const Unit& u, int wr, int wc, int fr, int fq) const {
        asm volatile("" : "+v"(fr), "+v"(fq));
        const int row0 = u.arow + wr * 64 + fr, col0 = u.pn * BM + wc * 32 + 4 * fq;
        int toks[2][4];
#pragma unroll
        for (int ai = 0; ai < 2; ++ai)
#pragma unroll
            for (int m = 0; m < 4; ++m) toks[ai][m] = rowtok[u.aux + wr * 64 + fr + ai * HALF + m * 16];
        u32x2 bw[2][4][2][2];
#pragma unroll
        for (int ai = 0; ai < 2; ++ai)
#pragma unroll
            for (int m = 0; m < 4; ++m) { const int tk = toks[ai][m] < 0 ? 0 : toks[ai][m]; const size_t off = (size_t)tk * DM + col0;
#pragma unroll
                for (int bj = 0; bj < 2; ++bj)
#pragma unroll
                    for (int n = 0; n < 2; ++n) bw[ai][m][bj][n] = *(const u32x2*)(hb + off + bj * HALF + n * 16); }
#pragma unroll
        for (int ai = 0; ai < 2; ++ai)
#pragma unroll
            for (int m = 0; m < 4; ++m) { const int tok = toks[ai][m]; const int tk = tok < 0 ? 0 : tok; const size_t off = (size_t)tk * DM + col0; f32x4 v[2][2];
#pragma unroll
                for (int bj = 0; bj < 2; ++bj)
#pragma unroll
                    for (int n = 0; n < 2; ++n) { const u32x2 w = bw[ai][m][bj][n]; v[bj][n] = (f32x4){bf_lo(w.x), bf_hi(w.x), bf_lo(w.y), bf_hi(w.y)} + acc[ai][bj][m][n];
                        if (tok >= 0) { if (FINAL) *(f32x4*)(outf + off + bj * HALF + n * 16) = v[bj][n];
                            else { u32x2 o; o.x = cvt_pk_bf16(v[bj][n][0], v[bj][n][1]); o.y = cvt_pk_bf16(v[bj][n][2], v[bj][n][3]); *(u32x2*)(hb + off + bj * HALF + n * 16) = o; } } }
                if (!FINAL) { const float ss = row_sumsq16(v[0][0], v[0][1], v[1][0], v[1][1]); if (fq == 0 && tok >= 0) SS[(size_t)tok * 16 + u.pn * 4 + wc] = ss; } }
    }
};
}
constexpr size_t HD_PLANE = (size_t)SEQ * 64 * 2;
constexpr size_t AT_QM   = WS_ATT;
constexpr size_t AT_KM   = AT_QM + 8 * HD_PLANE;
constexpr size_t AT_VM   = AT_KM + 8 * HD_PLANE;
constexpr size_t AT_KSEL = AT_VM + 8 * HD_PLANE;
constexpr size_t AT_VSEL = AT_KSEL + 4 * HD_PLANE;
constexpr size_t AT_KWIN = AT_VSEL + 4 * HD_PLANE;
constexpr size_t AT_VWIN = AT_KWIN + 4 * HD_PLANE;
constexpr size_t AT_KC   = AT_VWIN + 4 * HD_PLANE;
constexpr size_t AT_VC   = AT_KC + (size_t)(4096 + 8) * 2048;
constexpr size_t AT_GATES= AT_VC + (size_t)(4096 + 8) * 2048;
constexpr size_t AT_KMSUM= AT_GATES + (size_t)T * 36 * 4;
constexpr size_t AT_KMMEAN = AT_KMSUM + (size_t)NB * 4 * 256 * 64 * 4;
constexpr size_t AT_HC   = AT_KMMEAN + (size_t)NB * 4 * 64 * 64 * 4;
constexpr size_t AT_KCMP = AT_HC + (size_t)2 * (4096 + 8) * 512 * 2;
constexpr size_t AT_VCMP = AT_KCMP + (size_t)4 * 1024 * 64 * 2;
constexpr size_t AT_VMT  = AT_VCMP + (size_t)4 * 1024 * 64 * 2;
constexpr size_t AT_VSELT= AT_VMT + 8 * HD_PLANE;
constexpr size_t AT_VWINT= AT_VSELT + 4 * HD_PLANE;
constexpr size_t AT_VCMPT= AT_VWINT + 4 * HD_PLANE;
constexpr size_t AT_END  = AT_VCMPT + (size_t)4 * 16 * 64 * 64 * 2;
constexpr size_t AT_KMB    = AT_END;
constexpr size_t AT_SELIDX = AT_KMB + (size_t)NB * 4 * 64 * 64 * 2;
constexpr size_t AT_END2   = AT_SELIDX + (size_t)NB * 2 * SEQ * 8;
static_assert(AT_END2 <= WS_END, "workspace");
static_assert(AT_END <= WS_END, "attention tensors overflow the workspace plan");

__device__ __forceinline__ int odd_slice_mode(int s) { return s < 8 ? 2 : s < 12 ? 0 : s < 24 ? 2 : s < 28 ? 1 : s < 30 ? 2 : s < 32 ? 0 : s < 34 ? 2 : 0; }
namespace pg8 {
struct EpiOdd {
    static constexpr bool PERM = true;
    bf16_t* O; int ldc; const LAS float* rl; LAS float* xl; unsigned char* ws; unsigned char* outb;
    const float* gMQ; const float* gMK; const float* gNQ; const float* gKS; const float* gKW;
    __device__ __forceinline__ void operator()(const f32x4 (&acc)[2][2][4][2], const Unit& u, int wr, int wc, int fr, int fq) const {
        asm volatile("" : "+v"(fr), "+v"(fq));
        const int lr0 = wr * 64 + fr, c64 = (wc & 1) * 32 + 8 * fq; const LAS float* rp = rl + u.aux * 256 + lr0;
        const int b = u.arow / SEQ, lu = u.arow % SEQ;
#pragma unroll
        for (int bj = 0; bj < 2; ++bj) { const int s = u.pn * 4 + bj * 2 + (wc >> 1);
            if (odd_slice_mode(s) == 2) {
#pragma unroll
                for (int ai = 0; ai < 2; ++ai)
#pragma unroll
                    for (int m = 0; m < 4; ++m) { const int lrow = lr0 + ai * HALF + m * 16; const float r = rp[ai * HALF + m * 16]; const f32x4 v0 = acc[ai][bj][m][0] * r, v1 = acc[ai][bj][m][1] * r;
                        float ss = ((v0[0] * v0[0] + v0[1] * v0[1]) + (v0[2] * v0[2] + v0[3] * v0[3])) + ((v1[0] * v1[0] + v1[1] * v1[1]) + (v1[2] * v1[2] + v1[3] * v1[3]));
                        ss += __shfl_xor(ss, 16); ss += __shfl_xor(ss, 32);
                        if (fq == 0) xl[(lrow * 2 + bj) * 4 + wc] = ss; __builtin_amdgcn_sched_barrier(0); } } }
        asm volatile("s_waitcnt lgkmcnt(0)" ::: "memory"); __builtin_amdgcn_s_barrier(); asm volatile("" ::: "memory");
#pragma unroll
        for (int bj = 0; bj < 2; ++bj) { const int s = u.pn * 4 + bj * 2 + (wc >> 1), mode = odd_slice_mode(s);
            if (mode == 0) {
#pragma unroll
                for (int ai = 0; ai < 2; ++ai)
#pragma unroll
                    for (int m = 0; m < 4; ++m) { const int row = u.arow + lr0 + ai * HALF + m * 16; float r = rp[ai * HALF + m * 16]; asm volatile("" : "+v"(r)); const f32x4 v0 = acc[ai][bj][m][0] * r, v1 = acc[ai][bj][m][1] * r;
                        u32x4 w; w.x = cvt_pk_bf16(v0[0], v0[1]); w.y = cvt_pk_bf16(v0[2], v0[3]); w.z = cvt_pk_bf16(v1[0], v1[1]); w.w = cvt_pk_bf16(v1[2], v1[3]);
                        *(u32x4*)(O + (size_t)row * ldc + u.pn * BM + bj * HALF + wc * 32 + 8 * fq) = w; __builtin_amdgcn_sched_barrier(0); }
            } else {
                unsigned char* sbase; size_t pitch = 128; const float* gain = nullptr; float extra = 1.f;
                if (s < 4) { sbase = ws + AT_QM + ((size_t)(b * 4 + s) * SEQ + lu) * 128; gain = gMQ; extra = 0.125f * 1.4426950408889634f; }
                else if (s < 8) { sbase = ws + AT_KM + ((size_t)(b * 4 + (s - 4)) * SEQ + lu) * 128; gain = gMK; }
                else if (s < 24) { const int hg = s - 12, hk = hg / 6, g = hg % 6; sbase = outb + (((size_t)(b * 2 + hk) * SEQ + lu) * 6 + g) * 128; pitch = 768; gain = gNQ; extra = 0.125f * 1.4426950408889634f; }
                else { const int kind = (s - 24) >> 1, hk = (s - 24) & 1; const size_t po = ((size_t)(b * 2 + hk) * SEQ + lu) * 128;
                    sbase = ws + (kind == 0 ? AT_KC : kind == 1 ? AT_VC : kind == 2 ? AT_KSEL : AT_KWIN) + po; gain = kind == 2 ? gKS : kind == 4 ? gKW : nullptr; }
                f32x4 g0 = (f32x4){1.f, 1.f, 1.f, 1.f}, g1 = g0;
                if (mode == 2) { g0 = *(const f32x4*)(gain + c64) * extra; g1 = *(const f32x4*)(gain + c64 + 4) * extra; }
#pragma unroll
                for (int ai = 0; ai < 2; ++ai) { f32x4 cs0 = (f32x4){0.f, 0.f, 0.f, 0.f}, cs1 = cs0;
#pragma unroll
                    for (int m = 0; m < 4; ++m) { const int lrow = lr0 + ai * HALF + m * 16; float r = rp[ai * HALF + m * 16]; asm volatile("" : "+v"(r));
                        f32x4 v0 = acc[ai][bj][m][0] * r, v1 = acc[ai][bj][m][1] * r;
                        if (mode == 2) { const float tot = xl[(lrow * 2 + bj) * 4 + (wc & 2)] + xl[(lrow * 2 + bj) * 4 + (wc & 2) + 1]; const float rs = rsqrtf(tot * (1.f / 64.f) + 1e-6f);
                            v0 = v0 * rs * g0; v1 = v1 * rs * g1; }
                        u32x4 w; w.x = cvt_pk_bf16(v0[0], v0[1]); w.y = cvt_pk_bf16(v0[2], v0[3]); w.z = cvt_pk_bf16(v1[0], v1[1]); w.w = cvt_pk_bf16(v1[2], v1[3]);
                        *(u32x4*)(sbase + (size_t)lrow * pitch + c64 * 2) = w;
                        cs0 += v0; cs1 += v1; __builtin_amdgcn_sched_barrier(0); }
                    if (s >= 4 && s < 8) {
#pragma unroll
                        for (int e = 0; e < 4; ++e) { float a0 = cs0[e], a1 = cs1[e];
                            a0 += __shfl_xor(a0, 1); a0 += __shfl_xor(a0, 2); a0 += __shfl_xor(a0, 4); a0 += __shfl_xor(a0, 8);
                            a1 += __shfl_xor(a1, 1); a1 += __shfl_xor(a1, 2); a1 += __shfl_xor(a1, 4); a1 += __shfl_xor(a1, 8); cs0[e] = a0; cs1[e] = a1; }
                        if (fr == 0) { float* kp = (float*)(ws + AT_KMSUM) + ((size_t)(b * 4 + (s - 4)) * 256 + ((lu + wr * 64 + ai * HALF) >> 6)) * 64 + c64; *(f32x4*)kp = cs0; *(f32x4*)(kp + 4) = cs1; } } }
            } }
    }
};
}
__device__ __forceinline__ void load_slice(const bf16_t* p, float (&v)[64]) {
    const u32x4* s = (const u32x4*)p;
#pragma unroll
    for (int q = 0; q < 8; ++q) { const u32x4 w = s[q]; v[8 * q] = bf_lo(w.x); v[8 * q + 1] = bf_hi(w.x); v[8 * q + 2] = bf_lo(w.y); v[8 * q + 3] = bf_hi(w.y); v[8 * q + 4] = bf_lo(w.z); v[8 * q + 5] = bf_hi(w.z); v[8 * q + 6] = bf_lo(w.w); v[8 * q + 7] = bf_hi(w.w); }
}
__device__ __forceinline__ void store_slice(bf16_t* p, const float (&v)[64]) {
    u32x4* d = (u32x4*)p;
#pragma unroll
    for (int q = 0; q < 8; ++q) { u32x4 w; w.x = cvt_pk_bf16(v[8 * q], v[8 * q + 1]); w.y = cvt_pk_bf16(v[8 * q + 2], v[8 * q + 3]); w.z = cvt_pk_bf16(v[8 * q + 4], v[8 * q + 5]); w.w = cvt_pk_bf16(v[8 * q + 6], v[8 * q + 7]); d[q] = w; }
}
__device__ __forceinline__ void head_norm(float (&v)[64], const float* gain, float extra) {
    { int z = 0; asm volatile("" : "+v"(z)); gain += z; }
    float s = 0.f;
#pragma unroll
    for (int i = 0; i < 64; ++i) s += v[i] * v[i];
    const float r = rsqrtf(s * (1.f / 64.f) + 1e-6f) * extra;
#pragma unroll
    for (int i = 0; i < 64; ++i) v[i] = v[i] * r * gain[i];
}
__device__ __forceinline__ void phase_post1(Ctx& C, const Params& prm, int rank, int nranks) {
    unsigned char* ws = prm.ws; const bf16_t* proj = (const bf16_t*)(ws + WS_PROJ);
    const int gw = rank * NWAVES + C.wave, NGW = nranks * NWAVES, lane = C.lane, rr = lane >> 3, c = lane & 7;
    LAS bf16_t* tl = (LAS bf16_t*)(C.lds + C.wave * 9216);
    for (int it = gw; it < (T / 64) * 9; it += NGW) {
        const int q9 = it % 9, s = q9 < 4 ? 8 + q9 : (q9 < 6 ? 26 + q9 : (q9 < 8 ? 28 + q9 : 36)), ci = it / 9, tok0 = ci * 64, b = tok0 / SEQ, l0 = tok0 % SEQ;
        if (s == 36) {
            const int tok = tok0 + lane; const u32x4* gp = (const u32x4*)(proj + (size_t)tok * IN_ODD_P + 2304); float g[40];
#pragma unroll
            for (int q = 0; q < 5; ++q) { const u32x4 w = gp[q]; g[8 * q] = bf_lo(w.x); g[8 * q + 1] = bf_hi(w.x); g[8 * q + 2] = bf_lo(w.y); g[8 * q + 3] = bf_hi(w.y); g[8 * q + 4] = bf_lo(w.z); g[8 * q + 5] = bf_hi(w.z); g[8 * q + 6] = bf_lo(w.w); g[8 * q + 7] = bf_hi(w.w); }
            f32x4* o = (f32x4*)((float*)(ws + AT_GATES) + (size_t)tok * 36);
#pragma unroll
            for (int q = 0; q < 9; ++q) o[q] = (f32x4){sigmoidf_(g[4 * q]), sigmoidf_(g[4 * q + 1]), sigmoidf_(g[4 * q + 2]), sigmoidf_(g[4 * q + 3])};
            continue;
        }
        size_t dst = 0; size_t pitch = 128; const float* gain = nullptr; float extra = 1.f; bool qn = false, tr = false;
        if (s < 4) { dst = AT_QM + ((size_t)(b * 4 + s) * SEQ + l0) * 128; gain = prm.in[I_MQN]; extra = 0.125f * 1.4426950408889634f; }
        else if (s < 8) { dst = AT_KM + ((size_t)(b * 4 + (s - 4)) * SEQ + l0) * 128; gain = prm.in[I_MKN]; }
        else if (s < 12) { dst = AT_VMT + ((size_t)(b * 4 + (s - 8)) * 256 + (l0 >> 6)) * 8192; tr = true; }
        else if (s < 24) { const int hg = s - 12, hk = hg / 6, g = hg % 6; dst = (((size_t)(b * 2 + hk) * SEQ + l0) * 6 + g) * 128; pitch = 768; qn = true; gain = prm.in[I_NQN]; extra = 0.125f * 1.4426950408889634f; }
        else { const int kind = (s - 24) >> 1, hk = (s - 24) & 1; const size_t po = ((size_t)(b * 2 + hk) * SEQ + l0) * 128, tb = ((size_t)(b * 2 + hk) * 256 + (l0 >> 6)) * 8192;
            if (kind == 0) dst = AT_KC + po; else if (kind == 1) dst = AT_VC + po; else if (kind == 2) { dst = AT_KSEL + po; gain = prm.in[I_NKSN]; }
            else if (kind == 3) { dst = AT_VSELT + tb; tr = true; } else if (kind == 4) { dst = AT_KWIN + po; gain = prm.in[I_NKWN]; } else { dst = AT_VWINT + tb; tr = true; } }
        float v[8][8];
        { const bf16_t* src = proj + (size_t)(tok0 + rr) * IN_ODD_P + 64 * s + 8 * c;
#pragma unroll
          for (int i = 0; i < 8; ++i) { const u32x4 w = *(const u32x4*)(src + (size_t)i * 8 * IN_ODD_P);
              v[i][0] = bf_lo(w.x); v[i][1] = bf_hi(w.x); v[i][2] = bf_lo(w.y); v[i][3] = bf_hi(w.y); v[i][4] = bf_lo(w.z); v[i][5] = bf_hi(w.z); v[i][6] = bf_lo(w.w); v[i][7] = bf_hi(w.w); } }
        if (gain) { float gg[8];
#pragma unroll
            for (int e = 0; e < 8; ++e) gg[e] = gain[8 * c + e] * extra;
#pragma unroll
            for (int i = 0; i < 8; ++i) { float ss = 0.f;
#pragma unroll
                for (int e = 0; e < 8; ++e) ss += v[i][e] * v[i][e];
                ss += __shfl_xor(ss, 1); ss += __shfl_xor(ss, 2); ss += __shfl_xor(ss, 4);
                const float rs = rsqrtf(ss * (1.f / 64.f) + 1e-6f);
#pragma unroll
                for (int e = 0; e < 8; ++e) v[i][e] = v[i][e] * rs * gg[e]; } }
        unsigned char* obase = (qn ? (unsigned char*)prm.out : ws) + dst;
        if (!tr) {
#pragma unroll
            for (int i = 0; i < 8; ++i) { u32x4 w; w.x = cvt_pk_bf16(v[i][0], v[i][1]); w.y = cvt_pk_bf16(v[i][2], v[i][3]); w.z = cvt_pk_bf16(v[i][4], v[i][5]); w.w = cvt_pk_bf16(v[i][6], v[i][7]);
                *(u32x4*)(obase + (size_t)(i * 8 + rr) * pitch + 16 * c) = w; }
        } else {
            LDS_WAIT();
#pragma unroll
            for (int i = 0; i < 8; ++i)
#pragma unroll
                for (int e = 0; e < 8; ++e) tl[(8 * c + e) * 72 + i * 8 + rr] = f2bf(v[i][e]);
            LDS_WAIT();
#pragma unroll
            for (int i = 0; i < 8; ++i) { const int d = i * 8 + rr; const u32x4 w = *(const LAS u32x4*)(tl + d * 72 + 8 * c); *(u32x4*)(obase + (size_t)d * 128 + 16 * c) = w; }
        }
        if (s >= 4 && s < 8) {
            float cs[8];
#pragma unroll
            for (int e = 0; e < 8; ++e) { float a = 0.f;
#pragma unroll
                for (int i = 0; i < 8; ++i) a += v[i][e];
                a += __shfl_xor(a, 8); a += __shfl_xor(a, 16); a += __shfl_xor(a, 32); cs[e] = a; }
            if (rr == 0) { float* kp = (float*)(ws + AT_KMSUM) + ((size_t)(b * 4 + (s - 4)) * 256 + (l0 >> 6)) * 64 + 8 * c;
                *(f32x4*)kp = (f32x4){cs[0], cs[1], cs[2], cs[3]}; *(f32x4*)(kp + 4) = (f32x4){cs[4], cs[5], cs[6], cs[7]}; }
        }
    }
    for (int i = rank * NTHREADS + C.tid; i < 2 * 8 * 1024 / 2; i += nranks * NTHREADS) { const int kv = i / (8 * 512), o = i % (8 * 512);
        ((unsigned*)(ws + (kv ? AT_VC : AT_KC) + (size_t)4096 * 2048))[o] = 0u; }
}
__device__ __forceinline__ void kmmean_items(Ctx& C, const Params& prm) {
    unsigned char* ws = prm.ws; const float* ks = (const float*)(ws + AT_KMSUM); float* km = (float*)(ws + AT_KMMEAN);
    for (int i = C.bid * NTHREADS + C.tid; i < NB * 4 * 64 * 64; i += C.G * NTHREADS) { const int d = i & 63, j = (i >> 6) & 63, bh = i >> 12;
        const float* p = ks + ((size_t)bh * 256 + 4 * j) * 64 + d; const float mv = ((p[0] + p[64]) + (p[128] + p[192])) * (1.f / 256.f); km[i] = mv; ((bf16_t*)(ws + AT_KMB))[i] = f2bf(mv); }
}
namespace pg8 {
struct C1Sched { int G, c;
    __device__ bool next(int i, Unit& u) const { const int L = i * G + c; if (L >= 64) return false; const int kv = L >> 5, tile = (L >> 1) & 15, pn = L & 1;
        u.arow = kv * (4096 + 8) + tile * 256; u.pn = pn; u.b0 = (kv * 512 + pn * 256) * 1024 * 2; u.b1 = u.b0; u.nt = 16; return true; } };
}
__device__ __forceinline__ void phase_c2(Ctx& C, const Params& prm) {
    unsigned char* ws = prm.ws; const int lane = C.lane, fr = lane & 15, fq = lane >> 4, tile = C.bid * NWAVES + C.wave;
    if (C.bid >= 64) return;
    const int kv = C.bid >> 5;
    constexpr int WS2 = 264;
    LAS bf16_t* w2t = (LAS bf16_t*)C.lds;
    { const float* w2 = prm.in[kv ? I_W2V : I_W2K];
      for (int i = C.tid; i < 256 * 64; i += NTHREADS) { const int k = i >> 6, n = i & 63; w2t[n * WS2 + k] = f2bf(w2[i]); } }
    __syncthreads();
    const int r0 = tile * 16, rr0 = r0 & 4095, row = rr0 + fr, n = row & 1023;
    const bf16_t* p0 = (const bf16_t*)(ws + AT_HC) + ((size_t)kv * (4096 + 8) + row) * 512 + fq * 8; const bf16_t* p1 = p0 + 512 + 256;
    const float* b1 = (const float*)(ws + WS_C1B) + kv * 256 + fq * 8;
    u32x4 ha[8], hc[8];
#pragma unroll
    for (int kk = 0; kk < 8; ++kk) { ha[kk] = *(const u32x4*)(p0 + kk * 32); hc[kk] = *(const u32x4*)(p1 + kk * 32); }
    f32x4 acc[4];
#pragma unroll
    for (int nt = 0; nt < 4; ++nt) acc[nt] = (f32x4){0.f, 0.f, 0.f, 0.f};
#pragma unroll
    for (int kk = 0; kk < 8; ++kk) {
        const f32x4 ba = *(const f32x4*)(b1 + kk * 32), bb = *(const f32x4*)(b1 + kk * 32 + 4); const u32x4 a = ha[kk], c = hc[kk];
        u32x4 hw;
        hw.x = cvt_pk_bf16(gelu_tanh(bf_lo(a.x) + bf_lo(c.x) + ba.x), gelu_tanh(bf_hi(a.x) + bf_hi(c.x) + ba.y));
        hw.y = cvt_pk_bf16(gelu_tanh(bf_lo(a.y) + bf_lo(c.y) + ba.z), gelu_tanh(bf_hi(a.y) + bf_hi(c.y) + ba.w));
        hw.z = cvt_pk_bf16(gelu_tanh(bf_lo(a.z) + bf_lo(c.z) + bb.x), gelu_tanh(bf_hi(a.z) + bf_hi(c.z) + bb.y));
        hw.w = cvt_pk_bf16(gelu_tanh(bf_lo(a.w) + bf_lo(c.w) + bb.z), gelu_tanh(bf_hi(a.w) + bf_hi(c.w) + bb.w));
        const bf16x8 hb8 = __builtin_bit_cast(bf16x8, hw);
#pragma unroll
        for (int nt = 0; nt < 4; ++nt) { const bf16x8 wf = *(const LAS bf16x8*)(w2t + (nt * 16 + fr) * WS2 + kk * 32 + fq * 8);
            acc[nt] = __builtin_amdgcn_mfma_f32_16x16x32_bf16(wf, hb8, acc[nt], 0, 0, 0); }
    }
    if (n == 1023) return;
    if (kv == 0) { float ss = 0.f;
#pragma unroll
        for (int nt = 0; nt < 4; ++nt) ss += (acc[nt][0] * acc[nt][0] + acc[nt][1] * acc[nt][1]) + (acc[nt][2] * acc[nt][2] + acc[nt][3] * acc[nt][3]);
        ss += __shfl_xor(ss, 16); ss += __shfl_xor(ss, 32);
        const float rs = rsqrtf(ss * (1.f / 64.f) + 1e-6f);
#pragma unroll
        for (int nt = 0; nt < 4; ++nt) { const f32x4 gn = *(const f32x4*)(prm.in[I_NKCN] + nt * 16 + 4 * fq); const f32x4 v = acc[nt] * rs * gn;
            u32x2 o; o.x = cvt_pk_bf16(v[0], v[1]); o.y = cvt_pk_bf16(v[2], v[3]); *(u32x2*)((bf16_t*)(ws + AT_KCMP) + (size_t)row * 64 + nt * 16 + 4 * fq) = o; } }
    else { bf16_t* vt = (bf16_t*)(ws + AT_VCMPT) + (((size_t)(row >> 10) * 16 + (n >> 6)) * 64) * 64 + (n & 63);
#pragma unroll
        for (int nt = 0; nt < 4; ++nt)
#pragma unroll
            for (int j = 0; j < 4; ++j) vt[(size_t)(nt * 16 + 4 * fq + j) * 64] = f2bf(acc[nt][j]); }
}

__device__ __forceinline__ float exp2f_(float x) { return __builtin_amdgcn_exp2f(x); }
template <int NH> struct AttnState { float m[NH], l[NH], o[NH]; };
template <int NH> __device__ __forceinline__ void attn_init(AttnState<NH>& st) {
#pragma unroll
    for (int h = 0; h < NH; ++h) { st.m[h] = -1e30f; st.l[h] = 0.f; st.o[h] = 0.f; } }
template <int NH> __device__ __forceinline__ void qk_scores(const bf16_t* krow, const LAS float* q_, float (&s)[NH]) {
    unsigned qa = (unsigned)(size_t)q_;
    const u32x4* kp = (const u32x4*)krow; u32x4 kw[8];
#pragma unroll
    for (int i = 0; i < 8; ++i) kw[i] = kp[i];
#pragma unroll
    for (int h = 0; h < NH; ++h) s[h] = 0.f;
#pragma unroll
    for (int i = 0; i < 8; ++i) { const u32x4 w = kw[i];
        asm volatile("" : "+v"(qa), "+v"(s[0]));
        const LAS float* q = (const LAS float*)(size_t)qa;
        const float k0 = bf_lo(w.x), k1 = bf_hi(w.x), k2 = bf_lo(w.y), k3 = bf_hi(w.y), k4 = bf_lo(w.z), k5 = bf_hi(w.z), k6 = bf_lo(w.w), k7 = bf_hi(w.w);
#pragma unroll
        for (int h = 0; h < NH; ++h) { const LAS f32x4* qp = (const LAS f32x4*)(q + h * 64 + 8 * i); const f32x4 q0 = qp[0], q1 = qp[1];
            s[h] += k0 * q0.x + k1 * q0.y + k2 * q0.z + k3 * q0.w + k4 * q1.x + k5 * q1.y + k6 * q1.z + k7 * q1.w; } }
}
template <int NH> __device__ __forceinline__ void pv_accum(const bf16_t* Vbase, int vrow, int nk, const float (&p)[NH], float (&o)[NH], int lane) {
#pragma unroll 4
    for (int j = 0; j < nk; ++j) { const int r = __builtin_amdgcn_readlane(vrow, j); const float v = bf2f(Vbase[(size_t)r * 64 + lane]);
#pragma unroll
        for (int h = 0; h < NH; ++h) o[h] += __builtin_bit_cast(float, __builtin_amdgcn_readlane(__builtin_bit_cast(int, p[h]), j)) * v; }
}
template <int NH> __device__ __forceinline__ void attn_chunk(const bf16_t* Kbase, const bf16_t* Vbase, int row, bool valid, int nk, const LAS float* q, AttnState<NH>& st, int lane) {
    float s[NH]; qk_scores<NH>(Kbase + (size_t)row * 64, q, s);
    float p[NH];
#pragma unroll
    for (int h = 0; h < NH; ++h) { const float sv = valid ? s[h] : -1e30f; const float mn = fmaxf(st.m[h], wave_max(sv));
        const float alpha = exp2f_(st.m[h] - mn); p[h] = valid ? exp2f_(sv - mn) : 0.f;
        st.l[h] = st.l[h] * alpha + wave_sum(p[h]); st.o[h] *= alpha; st.m[h] = mn; }
    pv_accum<NH>(Vbase, row, nk, p, st.o, lane);
}
__device__ __forceinline__ void wave_argmax(float& v, int& i) {
#pragma unroll
    for (int o = 1; o < 64; o <<= 1) { const float ov = __shfl_xor(v, o); const int oi = __shfl_xor(i, o); if (ov > v || (ov == v && oi < i)) { v = ov; i = oi; } }
}

__device__ __forceinline__ void phase_attn_baseline(Ctx& C, const Params& prm) {
    unsigned char* ws = prm.ws; const int gw = C.bid * NWAVES + C.wave, NGW = C.G * NWAVES, lane = C.lane;
    LAS float* qs = (LAS float*)(C.lds + C.wave * 4096); LAS float* pslc = qs + 6 * 64;
    bf16_t* A2 = (bf16_t*)(ws + WS_A2);
    const float NEG = -1e30f;
    for (int it = gw; it < NB * 4 * SEQ; it += NGW) {
        const int l = it % SEQ, bh = it / SEQ, b = bh >> 2, h = bh & 3, tok = b * SEQ + l;
        { const bf16_t* qp = (const bf16_t*)(ws + AT_QM) + ((size_t)bh * SEQ + l) * 64; qs[lane] = bf2f(qp[lane]); }
        LDS_WAIT();
        const int cur = l >> 8;
        float gate = NEG;
        if (lane < cur) { const f32x4* mp = (const f32x4*)((const float*)(ws + AT_KMMEAN) + ((size_t)bh * 64 + lane) * 64); const LAS f32x4* qp = (const LAS f32x4*)qs; float a = 0.f;
#pragma unroll
            for (int i = 0; i < 16; ++i) { const f32x4 m = mp[i], q = qp[i]; a += m.x * q.x + m.y * q.y + m.z * q.z + m.w * q.w; }
            gate = a; }
        int sel[3]; bool selv[3];
#pragma unroll
        for (int r = 0; r < 3; ++r) { float bv = gate; int bi = lane; wave_argmax(bv, bi); sel[r] = bi; selv[r] = bv > -1e29f; if (lane == bi) gate = -3e38f; }
        AttnState<1> st; attn_init<1>(st);
        const bf16_t* Km = (const bf16_t*)(ws + AT_KM) + (size_t)bh * SEQ * 64; const bf16_t* Vm = (const bf16_t*)(ws + AT_VM) + (size_t)bh * SEQ * 64;
#pragma unroll 1
        for (int p0 = cur * 256; p0 <= l; p0 += 64) { const int pos = p0 + lane; const int nk = (l - p0 + 1) < 64 ? (l - p0 + 1) : 64;
            attn_chunk<1>(Km, Vm, pos <= l ? pos : l, pos <= l, nk, qs, st, lane); }
#pragma unroll 1
        for (int r = 0; r < 3; ++r) { int sj = sel[0]; bool sv = selv[0];
#pragma unroll
            for (int q = 1; q < 3; ++q) { sj = (r == q) ? sel[q] : sj; sv = (r == q) ? selv[q] : sv; }
            if (!sv) continue;
            for (int c = 0; c < 4; ++c) attn_chunk<1>(Km, Vm, sj * 256 + c * 64 + lane, true, 64, qs, st, lane); }
        A2[(size_t)tok * DM + h * 64 + lane] = f2bf(st.l[0] > 0.f ? st.o[0] / st.l[0] : 0.f);
        LDS_WAIT();
    }
}
typedef float f32x16 __attribute__((ext_vector_type(16)));
constexpr int KL_STRIDE = 144, VL_STRIDE = 136, KL_BYTES = 64 * KL_STRIDE, VL_BYTES = 64 * VL_STRIDE, KV_BYTES = KL_BYTES + VL_BYTES;
struct RowTile { f32x16 O[2]; float m, l; bf16x8 Q[4]; };
__device__ __forceinline__ void rt_init(RowTile& R) {
#pragma unroll
    for (int i = 0; i < 16; ++i) { R.O[0][i] = 0.f; R.O[1][i] = 0.f; }
    R.m = 0.f; R.l = 0.f;
}
__device__ __forceinline__ void rt_load_q(RowTile& R, const bf16_t* qrow, int lane) {
    const int h = lane >> 5;
#pragma unroll
    for (int ks = 0; ks < 4; ++ks) R.Q[ks] = *(const bf16x8*)(qrow + ks * 16 + h * 8);
}
__device__ __forceinline__ float max3f(float a, float b, float c) { float r; asm("v_max3_f32 %0, %1, %2, %3" : "=v"(r) : "v"(a), "v"(b), "v"(c)); return r; }
template <bool MASK, bool FIX>
__device__ __forceinline__ void flash_step_(RowTile& R, const LAS unsigned char* Kl, const LAS unsigned char* Vl, int kidx0, int lo, int hi, int lane) {
    const int r = lane & 31, h = lane >> 5;
    f32x16 S[2];
    const float nm = -R.m;
#pragma unroll
    for (int kt = 0; kt < 2; ++kt) {
#pragma unroll
        for (int i = 0; i < 16; ++i) S[kt][i] = nm;
#pragma unroll
        for (int ks = 0; ks < 4; ++ks) { const bf16x8 a = *(const LAS bf16x8*)(Kl + (kt * 32 + r) * KL_STRIDE + ks * 32 + h * 16);
            S[kt] = __builtin_amdgcn_mfma_f32_32x32x16_bf16(a, R.Q[ks], S[kt], 0, 0, 0); } }
    if (MASK) { int lo_o = lo; asm volatile("" : "+v"(lo_o));
        const int lo2 = lo_o - kidx0 - 4 * h, hi2 = hi - kidx0 - 4 * h;
#pragma unroll
        for (int kt = 0; kt < 2; ++kt)
#pragma unroll
            for (int i = 0; i < 16; ++i) { const int c = kt * 32 + (i & 3) + 8 * (i >> 2); S[kt][i] = (c > lo2 && c <= hi2) ? S[kt][i] : -1e30f; } }
    if (!FIX) {
    float mx = max3f(S[0][0], S[0][1], S[0][2]);
#pragma unroll
    for (int i = 3; i < 15; i += 2) mx = max3f(mx, S[0][i], S[0][i + 1]);
    mx = max3f(mx, S[0][15], S[1][0]);
#pragma unroll
    for (int i = 1; i < 15; i += 2) mx = max3f(mx, S[1][i], S[1][i + 1]);
    mx = fmaxf(mx, S[1][15]);
    mx = fmaxf(mx, __shfl_xor(mx, 32));
    const bool fresh = R.l == 0.f, live = mx > -1e29f;
    if (__any(live && (mx > 8.f || (fresh && mx < -8.f)))) {
        const float d = live ? (fresh ? mx : fmaxf(mx, 0.f)) : 0.f, alpha = exp2f_(-d);
        R.m += d; R.l *= alpha;
#pragma unroll
        for (int i = 0; i < 16; ++i) { R.O[0][i] *= alpha; R.O[1][i] *= alpha; S[0][i] -= d; S[1][i] -= d; } }
    }
    f32x2 sum2 = (f32x2){0.f, 0.f};
#pragma unroll
    for (int kt = 0; kt < 2; ++kt)
#pragma unroll
        for (int i = 0; i < 16; i += 2) { const float p0 = exp2f_(S[kt][i]), p1 = exp2f_(S[kt][i + 1]); S[kt][i] = p0; S[kt][i + 1] = p1; sum2 += (f32x2){p0, p1}; }
    float sum = sum2.x + sum2.y;
    sum += __shfl_xor(sum, 32);
    R.l += sum;
#pragma unroll
    for (int kt = 0; kt < 2; ++kt)
#pragma unroll
        for (int s = 0; s < 2; ++s) {
            u32x4 pw; pw.x = cvt_pk_bf16(S[kt][8 * s + 0], S[kt][8 * s + 1]); pw.y = cvt_pk_bf16(S[kt][8 * s + 2], S[kt][8 * s + 3]);
            pw.z = cvt_pk_bf16(S[kt][8 * s + 4], S[kt][8 * s + 5]); pw.w = cvt_pk_bf16(S[kt][8 * s + 6], S[kt][8 * s + 7]);
            const bf16x8 pb = __builtin_bit_cast(bf16x8, pw);
#pragma unroll
            for (int dt = 0; dt < 2; ++dt) { const LAS unsigned char* vp = Vl + (dt * 32 + r) * VL_STRIDE + (kt * 32 + 16 * s + 4 * h) * 2;
                const u32x2 v0 = *(const LAS u32x2*)vp, v1 = *(const LAS u32x2*)(vp + 16);
                u32x4 vw; vw.x = v0.x; vw.y = v0.y; vw.z = v1.x; vw.w = v1.y;
                R.O[dt] = __builtin_amdgcn_mfma_f32_32x32x16_bf16(__builtin_bit_cast(bf16x8, vw), pb, R.O[dt], 0, 0, 0); } }
}
template <bool MASK>
__device__ __forceinline__ void flash_step(RowTile& R, const LAS unsigned char* Kl, const LAS unsigned char* Vl, int kidx0, int lo, int hi, int lane, bool fix) {
    if (fix) {
        if (MASK) { if (__all((kidx0 > lo) && (kidx0 + 63 <= hi))) flash_step_<false, true>(R, Kl, Vl, kidx0, lo, hi, lane); else flash_step_<true, true>(R, Kl, Vl, kidx0, lo, hi, lane); }
        else flash_step_<false, true>(R, Kl, Vl, kidx0, lo, hi, lane);
    } else {
        if (MASK) { if (__all((kidx0 > lo) && (kidx0 + 63 <= hi))) flash_step_<false, false>(R, Kl, Vl, kidx0, lo, hi, lane); else flash_step_<true, false>(R, Kl, Vl, kidx0, lo, hi, lane); }
        else flash_step_<false, false>(R, Kl, Vl, kidx0, lo, hi, lane);
    }
}
constexpr float ATT_FIX_BOUND = 80.f;
__device__ __forceinline__ bool attn_fixed_ref(const float* gq, const float* gk, int lane) {
    const float mq = wave_max(fabsf(gq[lane])), mk = wave_max(fabsf(gk[lane]));
    const float bnd = 64.f * 0.125f * 1.4426950408889634f * mq * mk;
    return __builtin_amdgcn_readfirstlane((int)(bnd < ATT_FIX_BOUND)) != 0;
}
struct KVRegs { u32x4 k, v; };
template <int NT> __device__ __forceinline__ void kv_issue(KVRegs& g, const bf16_t* ktile, const bf16_t* vtile, int t) {
    g.k = *(const u32x4*)((const char*)ktile + t * 16); g.v = *(const u32x4*)((const char*)vtile + t * 16);
}
__device__ __forceinline__ void kv_commit(const KVRegs& g, LAS unsigned char* Kl, LAS unsigned char* Vl, int t) {
    const int row = t >> 3, c16 = t & 7;
    *(LAS u32x4*)(Kl + row * KL_STRIDE + c16 * 16) = g.k;
    LAS u32x2* vp = (LAS u32x2*)(Vl + row * VL_STRIDE + c16 * 16); vp[0] = (u32x2){g.v.x, g.v.y}; vp[1] = (u32x2){g.v.z, g.v.w};
}

constexpr size_t PS_O   = WS_PROJ;
constexpr size_t PS_LSE = PS_O + (size_t)NB * 2 * SEQ * 30 * 64;
static_assert(PS_LSE + (size_t)NB * 2 * SEQ * 30 * 4 <= WS_A2, "partials overflow the projection buffer");
__device__ __forceinline__ unsigned pack_fp8x4(float a, float b, float c, float d) { int w = __builtin_amdgcn_cvt_pk_fp8_f32(a, b, 0, false); w = __builtin_amdgcn_cvt_pk_fp8_f32(c, d, w, true); return (unsigned)w; }
__device__ __forceinline__ void unpack_fp8x4(unsigned w, float (&o)[4]) { const f32x2 lo = __builtin_amdgcn_cvt_pk_f32_fp8((int)w, false), hi = __builtin_amdgcn_cvt_pk_f32_fp8((int)w, true); o[0] = lo.x; o[1] = lo.y; o[2] = hi.x; o[3] = hi.y; }
__device__ __forceinline__ void store_partial(const RowTile& R, unsigned char* po, float* plse, size_t row, bool active, int lane) {
    const int h = lane >> 5; const float inv = 1.f / R.l;
    if (active) {
#pragma unroll
        for (int dt = 0; dt < 2; ++dt)
#pragma unroll
            for (int q4 = 0; q4 < 4; ++q4) *(unsigned*)(po + row * 64 + dt * 32 + 8 * q4 + 4 * h) = pack_fp8x4(R.O[dt][4 * q4] * inv, R.O[dt][4 * q4 + 1] * inv, R.O[dt][4 * q4 + 2] * inv, R.O[dt][4 * q4 + 3] * inv);
        if (h == 0) plse[row] = R.m + __builtin_amdgcn_logf(R.l); }
}
__device__ __forceinline__ void store_partial_lds(const RowTile& R, unsigned char* po, float* plse, int row, bool active, int lane, LAS unsigned char* scr) {
    const int r = lane & 31, h = lane >> 5; const float inv = 1.f / R.l;
#pragma unroll
    for (int dt = 0; dt < 2; ++dt)
#pragma unroll
        for (int q4 = 0; q4 < 4; ++q4) *(LAS unsigned*)(scr + r * 80 + dt * 32 + 8 * q4 + 4 * h) = pack_fp8x4(R.O[dt][4 * q4] * inv, R.O[dt][4 * q4 + 1] * inv, R.O[dt][4 * q4 + 2] * inv, R.O[dt][4 * q4 + 3] * inv);
    const int rid = active ? row : -1;
    asm volatile("s_waitcnt lgkmcnt(0)" ::: "memory");
#pragma unroll
    for (int j = 0; j < 2; ++j) { const int i = lane + 64 * j, rr = i >> 2, pc = i & 3; const int rrow = __shfl(rid, rr);
        const u32x4 w = *(const LAS u32x4*)(scr + rr * 80 + pc * 16);
        if (rrow >= 0) *(u32x4*)(po + (size_t)rrow * 64 + pc * 16) = w; }
    if (active && h == 0) plse[row] = R.m + __builtin_amdgcn_logf(R.l);
    asm volatile("" ::: "memory");
}
template <int NS>
__device__ __forceinline__ void merge_partials(RowTile& R, const unsigned char* po, const float* plse, size_t row0, size_t rstride, unsigned have, int lane) {
    const int h = lane >> 5; float lp[NS]; unsigned w[NS][8];
#pragma unroll
    for (int k = 0; k < NS; ++k) { const bool on = (have >> k) & 1u; const size_t row = row0 + (on ? (size_t)k * rstride : 0);
        lp[k] = on ? plse[row] : -1e30f;
#pragma unroll
        for (int dt = 0; dt < 2; ++dt)
#pragma unroll
            for (int q4 = 0; q4 < 4; ++q4) { const unsigned x = *(const unsigned*)(po + row * 64 + dt * 32 + 8 * q4 + 4 * h); w[k][dt * 4 + q4] = on ? x : 0u; } }
    float mn = R.m;
#pragma unroll
    for (int k = 0; k < NS; ++k) mn = fmaxf(mn, lp[k]);
    const float a = exp2f_(R.m - mn); R.l *= a; R.m = mn;
#pragma unroll
    for (int i = 0; i < 16; ++i) { R.O[0][i] *= a; R.O[1][i] *= a; }
#pragma unroll
    for (int k = 0; k < NS; ++k) { const float bsc = exp2f_(lp[k] - mn);
        R.l += bsc;
#pragma unroll
        for (int dt = 0; dt < 2; ++dt)
#pragma unroll
            for (int q4 = 0; q4 < 4; ++q4) { float v[4]; unpack_fp8x4(w[k][dt * 4 + q4], v);
#pragma unroll
                for (int j = 0; j < 4; ++j) R.O[dt][4 * q4 + j] += v[j] * bsc; } }
}

template <int NS>
__device__ __forceinline__ void merge_partials_lds(RowTile& R, const unsigned char* po, const float* plse, int row0, int rstride, unsigned have, int lane, LAS unsigned char* scr) {
    const int r = lane & 31, h = lane >> 5; float lp[NS]; u32x4 g[NS][2];
#pragma unroll
    for (int k = 0; k < NS; ++k) { const bool on = (have >> k) & 1u; const int row = row0 + k * rstride;
        lp[k] = on ? plse[on ? row : row0] : -1e30f;
        const int rid = on ? row : -1;
#pragma unroll
        for (int j = 0; j < 2; ++j) { const int i = lane + 64 * j, rr = i >> 2, pc = i & 3; const int rrow = __shfl(rid, rr);
            const unsigned off = (unsigned)(rrow < 0 ? 0 : rrow) * 64u + (unsigned)pc * 16u;
            g[k][j] = *(const u32x4*)(po + (size_t)off); } }
    float mn = R.m;
#pragma unroll
    for (int k = 0; k < NS; ++k) mn = fmaxf(mn, lp[k]);
    const float a = exp2f_(R.m - mn); R.l *= a; R.m = mn;
#pragma unroll
    for (int i = 0; i < 16; ++i) { R.O[0][i] *= a; R.O[1][i] *= a; }
#pragma unroll
    for (int k = 0; k < NS; ++k) { const bool on = (have >> k) & 1u; const float bsc = exp2f_(lp[k] - mn);
        R.l += bsc;
#pragma unroll
        for (int j = 0; j < 2; ++j) { const int i = lane + 64 * j; *(LAS u32x4*)(scr + (i >> 2) * 80 + (i & 3) * 16) = g[k][j]; }
        asm volatile("s_waitcnt lgkmcnt(0)" ::: "memory");
#pragma unroll
        for (int dt = 0; dt < 2; ++dt)
#pragma unroll
            for (int q4 = 0; q4 < 4; ++q4) { const unsigned x = *(const LAS unsigned*)(scr + r * 80 + dt * 32 + 8 * q4 + 4 * h); float v[4]; unpack_fp8x4(on ? x : 0u, v);
#pragma unroll
                for (int j = 0; j < 4; ++j) R.O[dt][4 * q4 + j] += v[j] * bsc; }
        asm volatile("s_waitcnt lgkmcnt(0)" ::: "memory"); }
}

__device__ __forceinline__ void nsa_gather_item(int it, int& bh, int& j, int& s0, int& tmin) {
    bh = it / 628; const int f = it - bh * 628;
    const int seg = (f >= 61) + (f >= 186) + (f >= 375);
    const int pre = seg == 0 ? 0 : seg == 1 ? 61 : seg == 2 ? 186 : 375;
    j = 1 + (f - pre); s0 = seg * 4096; tmin = 64 * (j + 2);
}
__device__ __forceinline__ void phase_nsa_gather(Ctx& C, const Params& prm) {
    unsigned char* ws = prm.ws; const int lane = C.lane, r = lane & 31, w = C.wave, tid = C.tid;
    const bool fix = attn_fixed_ref(prm.in[I_NQN], prm.in[I_NKSN], lane);
    constexpr int SLOT = KV_BYTES + 16384;
    LAS unsigned* cnts = (LAS unsigned*)(C.lds + 2 * SLOT);
    const int nit = 4 * 628;
    unsigned* qctr = (unsigned*)(ws + WS_CTL) + CW_Q15A; LAS int* tkt = (LAS int*)(cnts + 4);
    if (tid == 0) { tkt[0] = (int)atomicAdd(qctr, 1u); tkt[1] = (int)atomicAdd(qctr, 1u); }
    if (tid < 3) cnts[tid] = 0u;
    __syncthreads();
    int it = __builtin_amdgcn_readfirstlane(tkt[0]), itn = __builtin_amdgcn_readfirstlane(tkt[1]);
    KVRegs gr; unsigned long long pks[8]; int bh, j, s0, tmin;
#define NSG_ISSUE(it_) do { nsa_gather_item(it_, bh, j, s0, tmin); \
        kv_issue<512>(gr, (const bf16_t*)(ws + AT_KSEL) + ((size_t)bh * SEQ + (size_t)j * 64) * 64, (const bf16_t*)(ws + AT_VSELT) + ((size_t)bh * 256 + j) * 4096, tid); \
        const unsigned char* _sx = (const unsigned char*)(ws + AT_SELIDX) + (size_t)bh * SEQ * 8; \
        _Pragma("unroll") for (int k_ = 0; k_ < 8; ++k_) pks[k_] = *(const unsigned long long*)(_sx + (size_t)(s0 + tid + 512 * k_) * 8); } while (0)
    if (it < nit) NSG_ISSUE(it);
    __syncthreads();
    for (int kk = 0; it < nit; ++kk) {
        LAS unsigned char* slot = C.lds + (kk & 1) * SLOT; LAS unsigned* list = (LAS unsigned*)(slot + KV_BYTES); LAS unsigned* cnt = cnts + (kk % 3);
        const int cbh = bh, cj = j;
        int tnew = 0; if (tid == 0) tnew = (int)atomicAdd(qctr, 1u);
        kv_commit(gr, slot, slot + KL_BYTES, tid);
        { int sl8[8]; int mine = 0; unsigned long long mk[8];
#pragma unroll
          for (int k = 0; k < 8; ++k) { const int t = s0 + tid + 512 * k; int sl = -1;
              if (t >= tmin) {
#pragma unroll
                  for (int x = 0; x < 5; ++x) if ((int)((pks[k] >> (8 * x)) & 0xffull) == cj) sl = x; }
              sl8[k] = sl; mk[k] = __ballot(sl >= 0); mine += __popcll(mk[k]); }
          unsigned base = 0u;
          if (lane == 0 && mine > 0) base = __hip_atomic_fetch_add(cnt, (unsigned)mine, __ATOMIC_RELAXED, __HIP_MEMORY_SCOPE_WORKGROUP);
          base = (unsigned)__builtin_amdgcn_readfirstlane((int)base);
#pragma unroll
          for (int k = 0; k < 8; ++k) { if (sl8[k] >= 0) list[base + __popcll(mk[k] & ((1ull << lane) - 1ull))] = (unsigned)(s0 + tid + 512 * k) | ((unsigned)sl8[k] << 16); base += __popcll(mk[k]); } }
        if (itn < nit) NSG_ISSUE(itn);
        if (tid == 0) { cnts[(kk + 1) % 3] = 0u; tkt[(kk + 2) % 3] = tnew; }
        __syncthreads();
        const int n = (int)*cnt, ntile = (n + 4) / 5;
        for (int tile = w; tile < ntile; tile += NWAVES) {
            const int e5 = r / 6, gg = r - 6 * e5, e = tile * 5 + (e5 < 5 ? e5 : 0); const bool active = (r < 30) && (e < n);
            const unsigned ent = list[active ? e : tile * 5]; const int t = (int)(ent & 0xffffu), sl = (int)(ent >> 16), g = active ? gg : 0;
            RowTile R; rt_init(R); rt_load_q(R, (const bf16_t*)prm.out + (((size_t)cbh * SEQ + t) * 6 + g) * 64, lane);
            flash_step<false>(R, slot, slot + KL_BYTES, 0, 0, 0, lane, fix);
            store_partial_lds(R, ws + PS_O, (float*)(ws + PS_LSE), (cbh * SEQ + t) * 30 + sl * 6 + g, active, lane, C.lds + 2 * SLOT + 256 + w * 2560);
        }
        it = itn; itn = __builtin_amdgcn_readfirstlane(tkt[(kk + 2) % 3]);
    }
#undef NSG_ISSUE
}

__device__ __forceinline__ void nsa_out_add(const RowTile& R, bf16_t* orow, float scale, int h) {
#pragma unroll
    for (int dt = 0; dt < 2; ++dt)
#pragma unroll
        for (int q4 = 0; q4 < 4; ++q4) { u32x2* pp = (u32x2*)(orow + dt * 32 + 8 * q4 + 4 * h); const u32x2 old = *pp;
            u32x2 nw; nw.x = cvt_pk_bf16(bf_lo(old.x) + scale * R.O[dt][4 * q4 + 0], bf_hi(old.x) + scale * R.O[dt][4 * q4 + 1]);
            nw.y = cvt_pk_bf16(bf_lo(old.y) + scale * R.O[dt][4 * q4 + 2], bf_hi(old.y) + scale * R.O[dt][4 * q4 + 3]); *pp = nw; }
}
__device__ __forceinline__ void nsa_out_stash(const RowTile& R, LAS unsigned char* ot, float scale, int lane) {
    const int r = lane & 31, h = lane >> 5;
#pragma unroll
    for (int dt = 0; dt < 2; ++dt)
#pragma unroll
        for (int q4 = 0; q4 < 4; ++q4) { u32x2 nw; nw.x = cvt_pk_bf16(scale * R.O[dt][4 * q4 + 0], scale * R.O[dt][4 * q4 + 1]); nw.y = cvt_pk_bf16(scale * R.O[dt][4 * q4 + 2], scale * R.O[dt][4 * q4 + 3]);
            *(LAS u32x2*)(ot + r * 144 + (dt * 32 + 8 * q4 + 4 * h) * 2) = nw; }
}
__device__ __forceinline__ unsigned bf16x2_add(unsigned a, unsigned b) { return cvt_pk_bf16(bf_lo(a) + bf_lo(b), bf_hi(a) + bf_hi(b)); }
__device__ __forceinline__ void nsa_out_flush(const RowTile& R, LAS unsigned char* ot, bf16_t* orow0, float scale, int lane) {
    const int r = lane & 31, h = lane >> 5;
#pragma unroll
    for (int dt = 0; dt < 2; ++dt)
#pragma unroll
        for (int q4 = 0; q4 < 4; ++q4) { LAS u32x2* pp = (LAS u32x2*)(ot + r * 144 + (dt * 32 + 8 * q4 + 4 * h) * 2); const u32x2 old = *pp;
            u32x2 nw; nw.x = cvt_pk_bf16(bf_lo(old.x) + scale * R.O[dt][4 * q4 + 0], bf_hi(old.x) + scale * R.O[dt][4 * q4 + 1]);
            nw.y = cvt_pk_bf16(bf_lo(old.y) + scale * R.O[dt][4 * q4 + 2], bf_hi(old.y) + scale * R.O[dt][4 * q4 + 3]); *pp = nw; }
    asm volatile("s_waitcnt lgkmcnt(0)" ::: "memory");
    u32x4 gold[4];
#pragma unroll
    for (int j = 0; j < 4; ++j) { const int i = lane + 64 * j, rr = i >> 3, pc = i & 7; gold[j] = *(const u32x4*)((const char*)orow0 + (size_t)(unsigned)(rr * DM * 2 + pc * 16)); }
#pragma unroll
    for (int j = 0; j < 4; ++j) { const int i = lane + 64 * j, rr = i >> 3, pc = i & 7; const u32x4 t = *(const LAS u32x4*)(ot + rr * 144 + pc * 16);
        u32x4 o; o.x = bf16x2_add(gold[j].x, t.x); o.y = bf16x2_add(gold[j].y, t.y); o.z = bf16x2_add(gold[j].z, t.z); o.w = bf16x2_add(gold[j].w, t.w);
        *(u32x4*)((char*)orow0 + (size_t)(unsigned)(rr * DM * 2 + pc * 16)) = o; }
    asm volatile("s_waitcnt lgkmcnt(0)" ::: "memory");
}
__device__ __forceinline__ void rows_store_lds(const RowTile& R, float scale, LAS unsigned char* ot, bf16_t* orow0, int lane) {
    nsa_out_stash(R, ot, scale, lane);
    asm volatile("s_waitcnt lgkmcnt(0)" ::: "memory");
#pragma unroll
    for (int j = 0; j < 4; ++j) { const int i = lane + 64 * j, rr = i >> 3, pc = i & 7; const u32x4 t = *(const LAS u32x4*)(ot + rr * 144 + pc * 16);
        *(u32x4*)((char*)orow0 + (size_t)(unsigned)(rr * DM * 2 + pc * 16)) = t; }
    asm volatile("s_waitcnt lgkmcnt(0)" ::: "memory");
}
__device__ __forceinline__ void phase_nsa_dense(Ctx& C, const Params& prm) {
    unsigned char* ws = prm.ws; const int lane = C.lane, r = lane & 31, h = lane >> 5, w = C.wave, hk = w >> 2, wq = w & 3;
    const bool fix = attn_fixed_ref(prm.in[I_NQN], prm.in[I_NKWN], lane) && attn_fixed_ref(prm.in[I_NQN], prm.in[I_NKSN], lane);
    const int t256 = C.tid & 255, shk = C.tid >> 8;
    bf16_t* A2 = (bf16_t*)(ws + WS_A2);
    for (int u = C.bid; u < NB * (SEQ / 64); u += C.G) {
        const int b = u / (SEQ / 64), qi = u % (SEQ / 64), t0 = qi * 64;
        const int tile_lo = qi >= 8 ? qi - 8 : 0, nwin = qi - tile_lo + 1, nf = qi >= 2 ? 3 : qi + 1, nseq = nwin + nf;
        const size_t plane = (size_t)(b * 2 + shk) * SEQ * 64;
        const bf16_t* Kw = (const bf16_t*)(ws + AT_KWIN) + plane; const bf16_t* Vw = (const bf16_t*)(ws + AT_VWINT) + plane;
        const bf16_t* Ks = (const bf16_t*)(ws + AT_KSEL) + plane; const bf16_t* Vs = (const bf16_t*)(ws + AT_VSELT) + plane;
#define NSA_SEQ_TILE(i) ((i) < nwin ? tile_lo + (i) : ((i) == nwin ? 0 : ((i) == nseq - 1 ? qi : qi - 1)))
#define NSA_SEQ_ISSUE(i) do { const int _t = NSA_SEQ_TILE(i); const bf16_t* _k = ((i) < nwin ? Kw : Ks) + (size_t)_t * 4096; const bf16_t* _v = ((i) < nwin ? Vw : Vs) + (size_t)_t * 4096; \
            kv_issue<256>(g0, _k, _v, t256); kv_issue<256>(g1, _k, _v, t256 + 256); } while (0)
#pragma unroll 1
        for (int pass = 0; pass < 3; ++pass) {
            const int rt = wq * 3 + pass, g = rt >> 1, half = rt & 1, l = t0 + half * 32 + r, tok = b * SEQ + l;
            RowTile R; rt_init(R); rt_load_q(R, (const bf16_t*)prm.out + (((size_t)(b * 2 + hk) * SEQ + l) * 6 + g) * 64, lane);
            const float* gt = (const float*)(ws + AT_GATES) + (size_t)tok * 36 + hk * 6 + g;
            LAS unsigned char* otile = C.lds + 4 * KV_BYTES + 8 * 2560 + w * 4608;
            KVRegs g0, g1;
            __syncthreads();
            NSA_SEQ_ISSUE(0);
            { LAS unsigned char* base = C.lds + shk * KV_BYTES; kv_commit(g0, base, base + KL_BYTES, t256); kv_commit(g1, base, base + KL_BYTES, t256 + 256); }
            __syncthreads();
#pragma unroll 1
            for (int i = 0; i < nseq; ++i) {
                const bool more = i + 1 < nseq;
                if (more) NSA_SEQ_ISSUE(i + 1);
                const LAS unsigned char* cb = C.lds + ((i & 1) * 2 + hk) * KV_BYTES;
                if (i == nwin) { int ln = lane; asm volatile("" : "+v"(ln)); nsa_out_stash(R, otile, gt[24] / R.l, ln); rt_init(R); }
                const int tile = NSA_SEQ_TILE(i);
                flash_step<true>(R, cb, cb + KL_BYTES, tile * 64, i < nwin ? l - 512 : -(1 << 30), l, lane, fix);
                if (more) { LAS unsigned char* nb = C.lds + (((i + 1) & 1) * 2 + shk) * KV_BYTES; kv_commit(g0, nb, nb + KL_BYTES, t256); kv_commit(g1, nb, nb + KL_BYTES, t256 + 256); }
                __syncthreads();
            }
            { const unsigned long long pk = *(const unsigned long long*)((const unsigned char*)(ws + AT_SELIDX) + ((size_t)(b * 2 + hk) * SEQ + l) * 8); unsigned have = 0u;
#pragma unroll
              for (int sl = 0; sl < 5; ++sl) have |= (((pk >> (8 * sl)) & 0xffull) != 0ull) ? (1u << sl) : 0u;
              int ln = lane; asm volatile("" : "+v"(ln));
              merge_partials_lds<5>(R, ws + PS_O, (const float*)(ws + PS_LSE), ((b * 2 + hk) * SEQ + l) * 30 + g, 6, have, ln, C.lds + 4 * KV_BYTES + w * 2560); }
            { int ln = lane; asm volatile("" : "+v"(ln)); nsa_out_flush(R, otile, A2 + (size_t)(b * SEQ + t0 + half * 32) * DM + 256 + (hk * 6 + g) * 64, gt[12] / R.l, ln); }
        }
#undef NSA_SEQ_TILE
#undef NSA_SEQ_ISSUE
    }
}

constexpr int PSLC_LD = 257;
__device__ __forceinline__ void qk_tile(f32x16 (&S)[2], const RowTile& R, float init, const LAS unsigned char* Kl, int lane) {
    const int r = lane & 31, h = lane >> 5;
#pragma unroll
    for (int kt = 0; kt < 2; ++kt) {
#pragma unroll
        for (int i = 0; i < 16; ++i) S[kt][i] = init;
#pragma unroll
        for (int ks = 0; ks < 4; ++ks) { const bf16x8 a = *(const LAS bf16x8*)(Kl + (kt * 32 + r) * KL_STRIDE + ks * 32 + h * 16);
            S[kt] = __builtin_amdgcn_mfma_f32_32x32x16_bf16(a, R.Q[ks], S[kt], 0, 0, 0); } }
}
template <bool FIX>
__device__ __forceinline__ void cmp_stats_step(RowTile& R, const LAS unsigned char* Kl, int kidx0, int hi, int lane) {
    const int h = lane >> 5; f32x16 S[2]; qk_tile(S, R, -R.m, Kl, lane);
    const bool full = __all(kidx0 + 63 <= hi);
    if (!full) {
#pragma unroll
        for (int kt = 0; kt < 2; ++kt)
#pragma unroll
            for (int i = 0; i < 16; ++i) { const int kidx = kidx0 + kt * 32 + (i & 3) + 8 * (i >> 2) + 4 * h; S[kt][i] = kidx <= hi ? S[kt][i] : -1e30f; } }
    if (!FIX) {
    float mx = max3f(S[0][0], S[0][1], S[0][2]);
#pragma unroll
    for (int i = 3; i < 15; i += 2) mx = max3f(mx, S[0][i], S[0][i + 1]);
    mx = max3f(mx, S[0][15], S[1][0]);
#pragma unroll
    for (int i = 1; i < 15; i += 2) mx = max3f(mx, S[1][i], S[1][i + 1]);
    mx = fmaxf(mx, S[1][15]);
    mx = fmaxf(mx, __shfl_xor(mx, 32));
    const bool fresh = R.l == 0.f, live = mx > -1e29f;
    if (__any(live && (mx > 8.f || (fresh && mx < -8.f)))) {
        const float d = live ? (fresh ? mx : fmaxf(mx, 0.f)) : 0.f; R.m += d; R.l *= exp2f_(-d);
#pragma unroll
        for (int i = 0; i < 16; ++i) { S[0][i] -= d; S[1][i] -= d; } }
    }
    f32x2 sum2 = (f32x2){0.f, 0.f};
#pragma unroll
    for (int kt = 0; kt < 2; ++kt)
#pragma unroll
        for (int i = 0; i < 16; i += 2) sum2 += (f32x2){exp2f_(S[kt][i]), exp2f_(S[kt][i + 1])};
    float sum = sum2.x + sum2.y; sum += __shfl_xor(sum, 32);
    R.l += sum;
}
__device__ __forceinline__ void cmp_norm_step(RowTile& R, float inv_l, const LAS unsigned char* Kl, const LAS unsigned char* Vl, int kidx0, int hi, LAS unsigned* prow, int lane) {
    const int r = lane & 31, h = lane >> 5; f32x16 S[2]; qk_tile(S, R, -R.m, Kl, lane);
    const bool full = __all(kidx0 + 63 <= hi);
#pragma unroll
    for (int kt = 0; kt < 2; ++kt)
#pragma unroll
        for (int i = 0; i < 16; ++i) { const int kidx = kidx0 + kt * 32 + (i & 3) + 8 * (i >> 2) + 4 * h; S[kt][i] = (full || kidx <= hi) ? exp2f_(S[kt][i]) : 0.f; }
    const float fx = inv_l * 16777216.f;
#pragma unroll
    for (int kt = 0; kt < 2; ++kt)
#pragma unroll
        for (int c = 0; c < 4; ++c) { const int jb = (kidx0 >> 2) + kt * 8 + 2 * c + h; const float s4 = (S[kt][4 * c] + S[kt][4 * c + 1]) + (S[kt][4 * c + 2] + S[kt][4 * c + 3]);
            __hip_atomic_fetch_add(prow + jb, (unsigned)(s4 * fx + 0.5f), __ATOMIC_RELAXED, __HIP_MEMORY_SCOPE_WORKGROUP);
            if (jb + 1 < 256) __hip_atomic_fetch_add(prow + jb + 1, (unsigned)(S[kt][4 * c + 3] * fx + 0.5f), __ATOMIC_RELAXED, __HIP_MEMORY_SCOPE_WORKGROUP); }
#pragma unroll
    for (int kt = 0; kt < 2; ++kt)
#pragma unroll
        for (int s = 0; s < 2; ++s) {
            u32x4 pw; pw.x = cvt_pk_bf16(S[kt][8 * s + 0], S[kt][8 * s + 1]); pw.y = cvt_pk_bf16(S[kt][8 * s + 2], S[kt][8 * s + 3]);
            pw.z = cvt_pk_bf16(S[kt][8 * s + 4], S[kt][8 * s + 5]); pw.w = cvt_pk_bf16(S[kt][8 * s + 6], S[kt][8 * s + 7]);
            const bf16x8 pb = __builtin_bit_cast(bf16x8, pw);
#pragma unroll
            for (int dt = 0; dt < 2; ++dt) { const LAS unsigned char* vp = Vl + (dt * 32 + r) * VL_STRIDE + (kt * 32 + 16 * s + 4 * h) * 2;
                const u32x2 v0 = *(const LAS u32x2*)vp, v1 = *(const LAS u32x2*)(vp + 16);
                u32x4 vw; vw.x = v0.x; vw.y = v0.y; vw.z = v1.x; vw.w = v1.y;
                R.O[dt] = __builtin_amdgcn_mfma_f32_32x32x16_bf16(__builtin_bit_cast(bf16x8, vw), pb, R.O[dt], 0, 0, 0); } }
}
__device__ __forceinline__ float rowmax32(const f32x16 (&S)[2]) {
    float mx = max3f(S[0][0], S[0][1], S[0][2]);
#pragma unroll
    for (int i = 3; i < 15; i += 2) mx = max3f(mx, S[0][i], S[0][i + 1]);
    mx = max3f(mx, S[0][15], S[1][0]);
#pragma unroll
    for (int i = 1; i < 15; i += 2) mx = max3f(mx, S[1][i], S[1][i + 1]);
    return fmaxf(mx, S[1][15]);
}
template <bool FIX>
__device__ __forceinline__ void cmp_stats_step2(RowTile& Ra, RowTile& Rb, const LAS unsigned char* Kl, int kidx0, int hia, int hib, int lane) {
    const int r = lane & 31, h = lane >> 5; f32x16 Sa[2], Sb[2];
    const float nma = -Ra.m, nmb = -Rb.m;
#pragma unroll
    for (int kt = 0; kt < 2; ++kt) {
#pragma unroll
        for (int i = 0; i < 16; ++i) { Sa[kt][i] = nma; Sb[kt][i] = nmb; }
#pragma unroll
        for (int ks = 0; ks < 4; ++ks) { const bf16x8 a = *(const LAS bf16x8*)(Kl + (kt * 32 + r) * KL_STRIDE + ks * 32 + h * 16);
            Sa[kt] = __builtin_amdgcn_mfma_f32_32x32x16_bf16(a, Ra.Q[ks], Sa[kt], 0, 0, 0); Sb[kt] = __builtin_amdgcn_mfma_f32_32x32x16_bf16(a, Rb.Q[ks], Sb[kt], 0, 0, 0); } }
    if (!__all(kidx0 + 63 <= hia && kidx0 + 63 <= hib)) {
#pragma unroll
        for (int kt = 0; kt < 2; ++kt)
#pragma unroll
            for (int i = 0; i < 16; ++i) { const int kidx = kidx0 + kt * 32 + (i & 3) + 8 * (i >> 2) + 4 * h; Sa[kt][i] = kidx <= hia ? Sa[kt][i] : -1e30f; Sb[kt][i] = kidx <= hib ? Sb[kt][i] : -1e30f; } }
    if (!FIX) {
    float mxa = rowmax32(Sa), mxb = rowmax32(Sb);
    mxa = fmaxf(mxa, __shfl_xor(mxa, 32)); mxb = fmaxf(mxb, __shfl_xor(mxb, 32));
    const bool fa = Ra.l == 0.f, la = mxa > -1e29f, fb = Rb.l == 0.f, lb = mxb > -1e29f;
    if (__any((la && (mxa > 8.f || (fa && mxa < -8.f))) || (lb && (mxb > 8.f || (fb && mxb < -8.f))))) {
        const float da = la ? (fa ? mxa : fmaxf(mxa, 0.f)) : 0.f, db = lb ? (fb ? mxb : fmaxf(mxb, 0.f)) : 0.f;
        Ra.m += da; Ra.l *= exp2f_(-da); Rb.m += db; Rb.l *= exp2f_(-db);
#pragma unroll
        for (int i = 0; i < 16; ++i) { Sa[0][i] -= da; Sa[1][i] -= da; Sb[0][i] -= db; Sb[1][i] -= db; } }
    }
    f32x2 s2a = (f32x2){0.f, 0.f}, s2b = (f32x2){0.f, 0.f};
#pragma unroll
    for (int kt = 0; kt < 2; ++kt)
#pragma unroll
        for (int i = 0; i < 16; i += 2) { s2a += (f32x2){exp2f_(Sa[kt][i]), exp2f_(Sa[kt][i + 1])}; s2b += (f32x2){exp2f_(Sb[kt][i]), exp2f_(Sb[kt][i + 1])}; }
    float sa = s2a.x + s2a.y, sb = s2b.x + s2b.y; sa += __shfl_xor(sa, 32); sb += __shfl_xor(sb, 32);
    Ra.l += sa; Rb.l += sb;
}
__device__ __forceinline__ void phase_nsa_cmp(Ctx& C, const Params& prm) {
    unsigned char* ws = prm.ws; const int w = C.wave;
    const bool fix = attn_fixed_ref(prm.in[I_NQN], prm.in[I_NKCN], C.lane);
    LAS unsigned* pslc = (LAS unsigned*)(C.lds + 2 * KV_BYTES);
    bf16_t* A2 = (bf16_t*)(ws + WS_A2);
    for (int u = C.bid; u < NB * 2 * (SEQ / 64); u += C.G) {
        int tid = C.tid; asm volatile("" : "+v"(tid));
        const int lane = tid & 63, r = lane & 31, h = lane >> 5;
        const int bh = u / (SEQ / 64), qr = u % (SEQ / 64), qi = (bh & 1) ? (SEQ / 64 - 1 - qr) : qr, b = bh >> 1, hk = bh & 1, t0 = qi * 64;
        const int nt = ((4 * qi + 2) >> 6) + 1;
        const bf16_t* Kc = (const bf16_t*)(ws + AT_KCMP) + (size_t)bh * 1024 * 64; const bf16_t* Vc = (const bf16_t*)(ws + AT_VCMPT) + (size_t)bh * 16 * 4096;
        __syncthreads();
        for (int i = tid; i < 64 * PSLC_LD; i += NTHREADS) pslc[i] = 0u;
        const int gA = w % 6, hA = w / 6, gB = (2 + w) % 6;
        {
            RowTile R0, R1; R0.m = 0.f; R0.l = 0.f; R1.m = 0.f; R1.l = 0.f;
            const int l0 = t0 + hA * 32 + r, l1 = t0 + 32 + r;
            rt_load_q(R0, (const bf16_t*)prm.out + (((size_t)bh * SEQ + l0) * 6 + gA) * 64, lane);
            if (w < 4) rt_load_q(R1, (const bf16_t*)prm.out + (((size_t)bh * SEQ + l1) * 6 + gB) * 64, lane);
            {
                KVRegs gr;
                __syncthreads();
                kv_issue<512>(gr, Kc, Vc, tid); kv_commit(gr, C.lds, C.lds + KL_BYTES, tid);
                __syncthreads();
#pragma unroll 1
                for (int i = 0; i < nt; ++i) {
                    const bool more = i + 1 < nt;
                    if (more) kv_issue<512>(gr, Kc + (size_t)(i + 1) * 4096, Vc + (size_t)(i + 1) * 4096, tid);
                    const LAS unsigned char* cb = C.lds + (i & 1) * KV_BYTES;
                    if (fix) { if (w < 4) cmp_stats_step2<true>(R0, R1, cb, i * 64, (l0 - 31) >> 4, (l1 - 31) >> 4, lane); else cmp_stats_step<true>(R0, cb, i * 64, (l0 - 31) >> 4, lane); }
                    else { if (w < 4) cmp_stats_step2<false>(R0, R1, cb, i * 64, (l0 - 31) >> 4, (l1 - 31) >> 4, lane); else cmp_stats_step<false>(R0, cb, i * 64, (l0 - 31) >> 4, lane); }
                    if (more) { LAS unsigned char* nb = C.lds + ((i + 1) & 1) * KV_BYTES; kv_commit(gr, nb, nb + KL_BYTES, tid); }
                    __syncthreads();
                }
            }
#pragma unroll 1
            for (int half = 0; half < 2; ++half) {
                RowTile R; R.m = half ? R1.m : R0.m; R.l = 0.f;
#pragma unroll
                for (int q = 0; q < 4; ++q) R.Q[q] = half ? R1.Q[q] : R0.Q[q];
#pragma unroll
                for (int q = 0; q < 16; ++q) { R.O[0][q] = 0.f; R.O[1][q] = 0.f; }
                const float lsum = half ? R1.l : R0.l, il = lsum > 0.f ? 1.f / lsum : 0.f;
                const int l = half ? l1 : l0, tok = b * SEQ + l, hi = (l - 31) >> 4, g = half ? gB : gA; const bool act = half == 0 || w < 4;
                KVRegs gr;
                __syncthreads();
                kv_issue<512>(gr, Kc, Vc, tid); kv_commit(gr, C.lds, C.lds + KL_BYTES, tid);
                __syncthreads();
#pragma unroll 1
                for (int i = 0; i < nt; ++i) {
                    const bool more = i + 1 < nt;
                    if (more) kv_issue<512>(gr, Kc + (size_t)(i + 1) * 4096, Vc + (size_t)(i + 1) * 4096, tid);
                    const LAS unsigned char* cb = C.lds + (i & 1) * KV_BYTES;
                    if (act) cmp_norm_step(R, il, cb, cb + KL_BYTES, i * 64, hi, pslc + (l - t0) * PSLC_LD, lane);
                    if (more) { LAS unsigned char* nb = C.lds + ((i + 1) & 1) * KV_BYTES; kv_commit(gr, nb, nb + KL_BYTES, tid); }
                    __syncthreads();
                }
                if (act) {
                    const float gc = ((const float*)(ws + AT_GATES))[(size_t)tok * 36 + hk * 6 + g] * il;
                    int ln = lane; asm volatile("" : "+v"(ln));
                    rows_store_lds(R, gc, C.lds + 2 * KV_BYTES + 64 * PSLC_LD * 4 + 64 + w * 4608, A2 + (size_t)(b * SEQ + (l - r)) * DM + 256 + (hk * 6 + g) * 64, ln);
                }
            }
        }
        {
            LAS float* tk = (LAS float*)(C.lds);
            float v0 = -1e30f, v1 = -1e30f, v2 = -1e30f, v3 = -1e30f, v4 = -1e30f; int i0 = 0, i1 = 0, i2 = 0, i3 = 0, i4 = 0;
#define TOPK_INSERT(a_, j_) do { const float _a = (a_); const int _j = (j_);     \
            const bool _c0 = _a > v0, _c1 = _a > v1, _c2 = _a > v2, _c3 = _a > v3, _c4 = _a > v4; \
            v4 = _c3 ? v3 : (_c4 ? _a : v4); i4 = _c3 ? i3 : (_c4 ? _j : i4); v3 = _c2 ? v2 : (_c3 ? _a : v3); i3 = _c2 ? i2 : (_c3 ? _j : i3); \
            v2 = _c1 ? v1 : (_c2 ? _a : v2); i2 = _c1 ? i1 : (_c2 ? _j : i2); v1 = _c0 ? v0 : (_c1 ? _a : v1); i1 = _c0 ? i0 : (_c1 ? _j : i1); \
            v0 = _c0 ? _a : v0; i0 = _c0 ? _j : i0; } while (0)
            const int jlo = w * 32 < 1 ? 1 : w * 32, jhi = (w * 32 + 31) < (qi - 2) ? (w * 32 + 31) : (qi - 2);
            for (int j = jlo; j <= jhi; ++j) TOPK_INSERT((float)pslc[lane * PSLC_LD + j], j);
            __syncthreads();
            tk[((w * 5 + 0) * 2 + 0) * 64 + lane] = v0; tk[((w * 5 + 0) * 2 + 1) * 64 + lane] = __int_as_float(i0);
            tk[((w * 5 + 1) * 2 + 0) * 64 + lane] = v1; tk[((w * 5 + 1) * 2 + 1) * 64 + lane] = __int_as_float(i1);
            tk[((w * 5 + 2) * 2 + 0) * 64 + lane] = v2; tk[((w * 5 + 2) * 2 + 1) * 64 + lane] = __int_as_float(i2);
            tk[((w * 5 + 3) * 2 + 0) * 64 + lane] = v3; tk[((w * 5 + 3) * 2 + 1) * 64 + lane] = __int_as_float(i3);
            tk[((w * 5 + 4) * 2 + 0) * 64 + lane] = v4; tk[((w * 5 + 4) * 2 + 1) * 64 + lane] = __int_as_float(i4);
            __syncthreads();
            if (w == 0) {
                for (int ww = 1; ww < 8; ++ww)
#pragma unroll
                    for (int q = 0; q < 5; ++q) { const float a = tk[((ww * 5 + q) * 2 + 0) * 64 + lane]; const int j = __float_as_int(tk[((ww * 5 + q) * 2 + 1) * 64 + lane]); TOPK_INSERT(a, j); }
                unsigned long long packed = 0ull;
                if (v0 > -1e29f) packed |= (unsigned long long)(unsigned)i0;
                if (v1 > -1e29f) packed |= (unsigned long long)(unsigned)i1 << 8;
                if (v2 > -1e29f) packed |= (unsigned long long)(unsigned)i2 << 16;
                if (v3 > -1e29f) packed |= (unsigned long long)(unsigned)i3 << 24;
                if (v4 > -1e29f) packed |= (unsigned long long)(unsigned)i4 << 32;
                *(unsigned long long*)((unsigned char*)(ws + AT_SELIDX) + ((size_t)bh * SEQ + t0 + lane) * 8) = packed;
            }
#undef TOPK_INSERT
        }
    }
}

constexpr size_t PM_O     = PS_LSE + (size_t)NB * 2 * SEQ * 30 * 4;
static_assert(PM_O + (size_t)NB * 4 * SEQ * 3 * 64 <= WS_A2, "MoBA partials overflow the projection buffer");
constexpr size_t PM_LSE   = AT_END2;
constexpr size_t AT_MIDX  = PM_LSE + (size_t)NB * 4 * SEQ * 4 * 4;
constexpr size_t AT_END3  = AT_MIDX + (size_t)NB * 4 * SEQ * 4;
static_assert(AT_END3 <= WS_END, "workspace");
__device__ __forceinline__ void moba_gate_items(Ctx& C, const Params& prm) {
    unsigned char* ws = prm.ws; const int gw = C.bid * NWAVES + C.wave, NGW = C.G * NWAVES, lane = C.lane, r = lane & 31, h = lane >> 5;
    for (int it = gw; it < NB * 4 * (SEQ / 64); it += NGW) {
        const int c64 = it % (SEQ / 64), bh = it / (SEQ / 64), cur = (c64 * 64) >> 8;
        unsigned* out = (unsigned*)(ws + AT_MIDX) + (size_t)bh * SEQ + c64 * 64;
        if (cur == 0) { out[lane] = 0xffffffffu; continue; }
        const bf16_t* km = (const bf16_t*)(ws + AT_KMB) + (size_t)bh * 64 * 64;
#pragma unroll 1
        for (int tt = 0; tt < 2; ++tt) {
            const bf16_t* qrow = (const bf16_t*)(ws + AT_QM) + ((size_t)bh * SEQ + c64 * 64 + tt * 32 + r) * 64;
            bf16x8 qf[4];
#pragma unroll
            for (int ks = 0; ks < 4; ++ks) qf[ks] = *(const bf16x8*)(qrow + ks * 16 + h * 8);
            float v0 = -3e38f, v1 = -3e38f, v2 = -3e38f; int i0 = 255, i1 = 255, i2 = 255;
#define GATE_INS(a_, j_) do { const float _a = (a_); const int _j = (j_);     \
            const bool _c0 = _a > v0 || (_a == v0 && _j < i0), _c1 = _a > v1 || (_a == v1 && _j < i1), _c2 = _a > v2 || (_a == v2 && _j < i2); \
            v2 = _c1 ? v1 : (_c2 ? _a : v2); i2 = _c1 ? i1 : (_c2 ? _j : i2); v1 = _c0 ? v0 : (_c1 ? _a : v1); i1 = _c0 ? i0 : (_c1 ? _j : i1); v0 = _c0 ? _a : v0; i0 = _c0 ? _j : i0; } while (0)
#pragma unroll
            for (int jt = 0; jt < 2; ++jt) {
                if (jt * 32 < cur) {
                    f32x16 S;
#pragma unroll
                    for (int i = 0; i < 16; ++i) S[i] = 0.f;
#pragma unroll
                    for (int ks = 0; ks < 4; ++ks) { const bf16x8 a = *(const bf16x8*)(km + (size_t)(jt * 32 + r) * 64 + ks * 16 + h * 8);
                        S = __builtin_amdgcn_mfma_f32_32x32x16_bf16(a, qf[ks], S, 0, 0, 0); }
#pragma unroll
                    for (int i = 0; i < 16; ++i) { const int j = jt * 32 + (i & 3) + 8 * (i >> 2) + 4 * h; if (j < cur) GATE_INS(S[i], j); }
                }
            }
            { const float pv0 = __shfl_xor(v0, 32), pv1 = __shfl_xor(v1, 32), pv2 = __shfl_xor(v2, 32); const int pi0 = __shfl_xor(i0, 32), pi1 = __shfl_xor(i1, 32), pi2 = __shfl_xor(i2, 32);
              if (pi0 != 255) GATE_INS(pv0, pi0); if (pi1 != 255) GATE_INS(pv1, pi1); if (pi2 != 255) GATE_INS(pv2, pi2); }
            if (h == 0) out[tt * 32 + r] = (unsigned)i0 | ((unsigned)i1 << 8) | ((unsigned)i2 << 16) | 0xff000000u;
#undef GATE_INS
        }
    }
}
__device__ __forceinline__ void moba_gather_item(int it, int& bh, int& j, int& s0, int& tmin) {
    bh = it / 280; const int f = it - bh * 280;
    const int seg = (f >= 7) + (f >= 22) + (f >= 45) + (f >= 76) + (f >= 115) + (f >= 162) + (f >= 217);
    const int pre = seg == 0 ? 0 : seg == 1 ? 7 : seg == 2 ? 22 : seg == 3 ? 45 : seg == 4 ? 76 : seg == 5 ? 115 : seg == 6 ? 162 : 217;
    j = f - pre; s0 = seg * 2048; tmin = 256 * (j + 1);
}
__device__ __forceinline__ void phase_moba_gather(Ctx& C, const Params& prm) {
    unsigned char* ws = prm.ws; const int lane = C.lane, r = lane & 31, w = C.wave, tid = C.tid;
    const bool fix = attn_fixed_ref(prm.in[I_MQN], prm.in[I_MKN], lane);
    constexpr int MKV = 4 * KV_BYTES, SLOT = MKV + 8192;
    LAS unsigned* cnts = (LAS unsigned*)(C.lds + 2 * SLOT); LAS int* tkt = (LAS int*)(cnts + 4);
    const int nit = 8 * 280;
    unsigned* qctr = (unsigned*)(ws + WS_CTL) + CW_Q15B;
    if (tid == 0) { tkt[0] = (int)atomicAdd(qctr, 1u); tkt[1] = (int)atomicAdd(qctr, 1u); }
    if (tid < 3) cnts[tid] = 0u;
    __syncthreads();
    int it = __builtin_amdgcn_readfirstlane(tkt[0]), itn = __builtin_amdgcn_readfirstlane(tkt[1]);
    KVRegs g0, g1, g2, g3; unsigned pks[4]; int bh, j, s0, tmin;
#define MBG_ISSUE(it_) do { moba_gather_item(it_, bh, j, s0, tmin); \
        const bf16_t* _km = (const bf16_t*)(ws + AT_KM) + ((size_t)bh * SEQ + (size_t)(4 * j) * 64) * 64; const bf16_t* _vm = (const bf16_t*)(ws + AT_VMT) + ((size_t)bh * 256 + 4 * j) * 4096; \
        kv_issue<512>(g0, _km, _vm, tid); kv_issue<512>(g1, _km + 4096, _vm + 4096, tid); kv_issue<512>(g2, _km + 2 * 4096, _vm + 2 * 4096, tid); kv_issue<512>(g3, _km + 3 * 4096, _vm + 3 * 4096, tid); \
        const unsigned* _mx = (const unsigned*)(ws + AT_MIDX) + (size_t)bh * SEQ; \
        _Pragma("unroll") for (int k_ = 0; k_ < 4; ++k_) pks[k_] = _mx[s0 + tid + 512 * k_]; } while (0)
    if (it < nit) MBG_ISSUE(it);
    __syncthreads();
    for (int kk = 0; it < nit; ++kk) {
        LAS unsigned char* slot = C.lds + (kk & 1) * SLOT; LAS unsigned* list = (LAS unsigned*)(slot + MKV); LAS unsigned* cnt = cnts + (kk % 3);
        const int cbh = bh, cj = j;
        int tnew = 0; if (tid == 0) tnew = (int)atomicAdd(qctr, 1u);
        kv_commit(g0, slot, slot + KL_BYTES, tid); kv_commit(g1, slot + KV_BYTES, slot + KV_BYTES + KL_BYTES, tid);
        kv_commit(g2, slot + 2 * KV_BYTES, slot + 2 * KV_BYTES + KL_BYTES, tid); kv_commit(g3, slot + 3 * KV_BYTES, slot + 3 * KV_BYTES + KL_BYTES, tid);
#pragma unroll
        for (int k = 0; k < 4; ++k) { const int t = s0 + tid + 512 * k;
            if (t >= tmin) {
#pragma unroll
                for (int sl = 0; sl < 3; ++sl) if ((int)((pks[k] >> (8 * sl)) & 0xffu) == cj) { const unsigned pos = __hip_atomic_fetch_add(cnt, 1u, __ATOMIC_RELAXED, __HIP_MEMORY_SCOPE_WORKGROUP); list[pos] = (unsigned)t | ((unsigned)sl << 16); } } }
        if (itn < nit) MBG_ISSUE(itn);
        if (tid == 0) { cnts[(kk + 1) % 3] = 0u; tkt[(kk + 2) % 3] = tnew; }
        __syncthreads();
        const int n = (int)*cnt, ntile = (n + 31) >> 5;
        for (int tile = w; tile < ntile; tile += NWAVES) {
            const int e = tile * 32 + r; const bool active = e < n;
            const unsigned ent = list[active ? e : tile * 32]; const int t = (int)(ent & 0xffffu), sl = (int)(ent >> 16);
            RowTile R; rt_init(R); rt_load_q(R, (const bf16_t*)(ws + AT_QM) + ((size_t)cbh * SEQ + t) * 64, lane);
#pragma unroll 1
            for (int kt = 0; kt < 4; ++kt) flash_step<false>(R, slot + kt * KV_BYTES, slot + kt * KV_BYTES + KL_BYTES, 0, 0, 0, lane, fix);
            store_partial(R, ws + PM_O, (float*)(ws + PM_LSE), ((size_t)cbh * SEQ + t) * 3 + sl, active, lane);
        }
        it = itn; itn = __builtin_amdgcn_readfirstlane(tkt[(kk + 2) % 3]);
    }
#undef MBG_ISSUE
}
__device__ __forceinline__ void phase_moba_dense(Ctx& C, const Params& prm) {
    unsigned char* ws = prm.ws; const int lane = C.lane, r = lane & 31, h = lane >> 5, w = C.wave, tid = C.tid;
    const bool fix = attn_fixed_ref(prm.in[I_MQN], prm.in[I_MKN], lane);
    bf16_t* A2 = (bf16_t*)(ws + WS_A2);
    for (int u = C.bid; u < NB * 4 * 64; u += C.G) {
        const int blk = u & 63, bh = u >> 6, b = bh >> 2, hd = bh & 3, l = blk * 256 + w * 32 + r, tok = b * SEQ + l;
        const bf16_t* Km = (const bf16_t*)(ws + AT_KM) + ((size_t)bh * SEQ + (size_t)blk * 256) * 64; const bf16_t* Vm = (const bf16_t*)(ws + AT_VMT) + ((size_t)bh * 256 + 4 * blk) * 4096;
        RowTile R; rt_init(R); rt_load_q(R, (const bf16_t*)(ws + AT_QM) + ((size_t)bh * SEQ + l) * 64, lane);
        KVRegs gr;
        __syncthreads();
        kv_issue<512>(gr, Km, Vm, tid); kv_commit(gr, C.lds, C.lds + KL_BYTES, tid);
        __syncthreads();
#pragma unroll 1
        for (int i = 0; i < 4; ++i) {
            const bool more = i + 1 < 4;
            if (more) kv_issue<512>(gr, Km + (size_t)(i + 1) * 4096, Vm + (size_t)(i + 1) * 4096, tid);
            const LAS unsigned char* cb = C.lds + (i & 1) * KV_BYTES;
            if (i <= (w >> 1)) flash_step<true>(R, cb, cb + KL_BYTES, blk * 256 + i * 64, -(1 << 30), l, lane, fix);
            if (more) { LAS unsigned char* nb = C.lds + ((i + 1) & 1) * KV_BYTES; kv_commit(gr, nb, nb + KL_BYTES, tid); }
            __syncthreads();
        }
        { const unsigned pk = ((const unsigned*)(ws + AT_MIDX))[(size_t)bh * SEQ + l]; unsigned have = 0u;
#pragma unroll
          for (int sl = 0; sl < 3; ++sl) have |= (((pk >> (8 * sl)) & 0xffu) != 0xffu) ? (1u << sl) : 0u;
          int ln = lane; asm volatile("" : "+v"(ln));
          merge_partials_lds<3>(R, ws + PM_O, (const float*)(ws + PM_LSE), (bh * SEQ + l) * 3, 1, have, ln, C.lds + 4 * KV_BYTES + w * 2560); }
        { int ln = lane; asm volatile("" : "+v"(ln));
          rows_store_lds(R, 1.f / R.l, C.lds + 4 * KV_BYTES + 8 * 2560 + w * 4608, A2 + (size_t)(b * SEQ + blk * 256 + w * 32) * DM + hd * 64, ln); }
    }
}
__device__ __forceinline__ void s5_mtable_items(Ctx& C, const Params& prm) {
    unsigned char* ws = prm.ws; const float* cre = prm.in[I_CRE]; const float* cim = prm.in[I_CIM];
    const f32x2* AP = (const f32x2*)(ws + S5_AP); const float* BB = (const float*)(ws + WS_S5BB); float* MT = (float*)(ws + S5_MT);
    LAS f32x2* cl = (LAS f32x2*)C.lds;
    LAS f32x2* bl = cl + 1024;
    LAS f32x2* al = bl + 1024;
    for (int it = C.bid; it < 16 * 16; it += C.G) { const int g = it >> 4, k0 = (it & 15) * 4;
        __syncthreads();
        for (int i = C.tid; i < 1024; i += NTHREADS) { cl[i] = (f32x2){cre[(size_t)g * 1024 + i], cim[(size_t)g * 1024 + i]};
            const int p = i >> 4, hi = i & 15; bl[i] = (f32x2){BB[(size_t)(g * 64 + p) * 32 + hi], BB[(size_t)(g * 64 + p) * 32 + 16 + hi]}; }
        if (C.tid < 256) al[C.tid] = AP[(g * 65 + k0 + (C.tid >> 6)) * 64 + (C.tid & 63)];
        __syncthreads();
#pragma unroll
        for (int q = 0; q < 2; ++q) { const int o = C.tid + q * NTHREADS, hi = o & 15, ho = (o >> 4) & 15, kk = o >> 8;
            float acc = 0.f;
#pragma unroll 8
            for (int p = 0; p < 64; ++p) { const f32x2 a = al[kk * 64 + p], bb = bl[p * 16 + hi], cc = cl[ho * 64 + p];
                const float wr = a.x * bb.x - a.y * bb.y, wi = a.x * bb.y + a.y * bb.x; acc += cc.x * wr - cc.y * wi; }
            MT[((size_t)(g * 64 + k0 + kk) * 16 + ho) * 16 + hi] = acc; }
    }
    __syncthreads();
}
__device__ __forceinline__ void s5_bg_items(Ctx& C, const Params& prm, int rank, int nranks) {
    unsigned char* ws = prm.ws; const float* cre = prm.in[I_CRE]; const float* cim = prm.in[I_CIM];
    const f32x2* AP = (const f32x2*)(ws + S5_AP); const float* MT = (const float*)(ws + S5_MT); bf16_t* BG = (bf16_t*)(ws + S5_BG);
    for (int i = rank * NTHREADS + C.tid; i < 16 * 1024 * 144; i += nranks * NTHREADS) { const int kc = i % 144, n = (i / 144) & 1023, g = i / (144 * 1024), t = n >> 4, ho = n & 15;
        float v[8];
        if (kc < 16) { const int p0 = (kc & 7) * 8; const bool imag = kc >= 8;
            const f32x4* ap = (const f32x4*)(AP + (g * 65 + t + 1) * 64 + p0); const f32x4* crp = (const f32x4*)(cre + (size_t)g * 1024 + ho * 64 + p0); const f32x4* cip = (const f32x4*)(cim + (size_t)g * 1024 + ho * 64 + p0);
            const f32x4 a0 = ap[0], a1 = ap[1], a2 = ap[2], a3 = ap[3], cr0 = crp[0], cr1 = crp[1], ci0 = cip[0], ci1 = cip[1];
            const float ar[8] = {a0[0], a0[2], a1[0], a1[2], a2[0], a2[2], a3[0], a3[2]}, ai[8] = {a0[1], a0[3], a1[1], a1[3], a2[1], a2[3], a3[1], a3[3]};
            const float cr[8] = {cr0[0], cr0[1], cr0[2], cr0[3], cr1[0], cr1[1], cr1[2], cr1[3]}, ci[8] = {ci0[0], ci0[1], ci0[2], ci0[3], ci1[0], ci1[1], ci1[2], ci1[3]};
#pragma unroll
            for (int j = 0; j < 8; ++j) v[j] = imag ? -(cr[j] * ai[j] + ci[j] * ar[j]) : (cr[j] * ar[j] - ci[j] * ai[j]); }
        else { const int kk = (kc - 16) * 8, s = kk >> 4, hi0 = kk & 15;
            if (s <= t) { const f32x4* mp = (const f32x4*)(MT + ((g * 64 + (t - s)) * 16 + ho) * 16 + hi0); const f32x4 m0 = mp[0], m1 = mp[1];
                v[0] = m0[0]; v[1] = m0[1]; v[2] = m0[2]; v[3] = m0[3]; v[4] = m1[0]; v[5] = m1[1]; v[6] = m1[2]; v[7] = m1[3]; }
            else {
#pragma unroll
                for (int j = 0; j < 8; ++j) v[j] = 0.f; } }
        u32x4 o; o.x = cvt_pk_bf16(v[0], v[1]); o.y = cvt_pk_bf16(v[2], v[3]); o.z = cvt_pk_bf16(v[4], v[5]); o.w = cvt_pk_bf16(v[6], v[7]);
        *(u32x4*)(BG + ((size_t)(g * 1024 + n) * 1152 + kc * 8)) = o; }
}
__device__ __forceinline__ void s5_sg_items(Ctx& C, const Params& prm) {
    unsigned char* ws = prm.ws; const f32x2* AP = (const f32x2*)(ws + S5_AP); const float* BB = (const float*)(ws + WS_S5BB); bf16_t* SG = (bf16_t*)(ws + S5_SG);
    for (int i = C.bid * NTHREADS + C.tid; i < 16 * 128 * 128; i += C.G * NTHREADS) { const int kc = i & 127, n = (i >> 7) & 127, g = i >> 14, p = n & 63, s = kc >> 1, hi0 = (kc & 1) * 8;
        const f32x2 a = AP[(g * 65 + (63 - s)) * 64 + p]; const float* bb = BB + (size_t)(g * 64 + p) * 32 + hi0; float v[8];
#pragma unroll
        for (int j = 0; j < 8; ++j) { const float br = bb[j], bi = bb[16 + j]; v[j] = n < 64 ? (a.x * br - a.y * bi) : (a.x * bi + a.y * br); }
        u32x4 o; o.x = cvt_pk_bf16(v[0], v[1]); o.y = cvt_pk_bf16(v[2], v[3]); o.z = cvt_pk_bf16(v[4], v[5]); o.w = cvt_pk_bf16(v[6], v[7]);
        *(u32x4*)(SG + ((size_t)(g * 256 + n) * 1024 + kc * 8)) = o; }
}
__device__ __forceinline__ void s5_chunkscan_wave(Ctx& C, const Params& prm, int b, int g) {
    unsigned char* ws = prm.ws; const int lane = C.lane;
    const f32x2 aL = ((const f32x2*)(ws + S5_AP))[(g * 65 + 64) * 64 + lane];
    const f32x2* E = (const f32x2*)(ws + WS_S5E) + ((size_t)(b * S5_NCH) * 16 + g) * 64 + lane;
    bf16_t* ag = (bf16_t*)(ws + S5_AG) + (size_t)(g * 512 + b * 256) * 1152 + lane;
    float xr = 0.f, xi = 0.f;
    for (int c = 0; c < S5_NCH; c += 32) { f32x2 e[32];
#pragma unroll
        for (int q = 0; q < 32; ++q) e[q] = E[(size_t)(c + q) * 16 * 64];
#pragma unroll
        for (int q = 0; q < 32; ++q) { ag[(size_t)(c + q) * 1152] = f2bf(xr); ag[(size_t)(c + q) * 1152 + 64] = f2bf(xi);
            const float nr = aL.x * xr - aL.y * xi + e[q].x, ni = aL.x * xi + aL.y * xr + e[q].y; xr = nr; xi = ni; } }
}
namespace pg8 {
struct EpiProj0 {
    static constexpr bool PERM = true;
    bf16_t* O; int ldc; bf16_t* AG; const float* R0;
    __device__ __forceinline__ void operator()(const f32x4 (&acc)[2][2][4][2], const Unit& u, int wr, int wc, int fr, int fq) const {
        const int row0 = u.arow + wr * 64 + fr, cw = wc * 32 + 8 * fq;
        float rsv[2][4];
#pragma unroll
        for (int ai = 0; ai < 2; ++ai)
#pragma unroll
            for (int m = 0; m < 4; ++m) rsv[ai][m] = R0[row0 + ai * HALF + m * 16];
#pragma unroll
        for (int ai = 0; ai < 2; ++ai)
#pragma unroll
            for (int m = 0; m < 4; ++m) { const int row = row0 + ai * HALF + m * 16; const float rs = rsv[ai][m];
                if (u.pn >= 1 && u.pn <= 6) { const float r2 = rs * rs; const f32x4 v0 = acc[ai][0][m][0] * acc[ai][1][m][0] * r2, v1 = acc[ai][0][m][1] * acc[ai][1][m][1] * r2;
                    u32x4 w; w.x = cvt_pk_bf16(v0[0], v0[1]); w.y = cvt_pk_bf16(v0[2], v0[3]); w.z = cvt_pk_bf16(v1[0], v1[1]); w.w = cvt_pk_bf16(v1[2], v1[3]);
                    *(u32x4*)(O + (size_t)row * ldc + (u.pn - 1) * 128 + cw) = w; }
                else {
#pragma unroll
                    for (int bj = 0; bj < 2; ++bj) { const f32x4 v0 = acc[ai][bj][m][0] * rs, v1 = acc[ai][bj][m][1] * rs;
                        u32x4 w; w.x = cvt_pk_bf16(v0[0], v0[1]); w.y = cvt_pk_bf16(v0[2], v0[3]); w.z = cvt_pk_bf16(v1[0], v1[1]); w.w = cvt_pk_bf16(v1[2], v1[3]);
                        if (u.pn == 0) { const int ch = cw + bj * HALF, g = ch >> 4, b = row / SEQ, l = row % SEQ;
                            *(u32x4*)(AG + ((size_t)(g * 512 + b * 256 + (l >> 6)) * 1152 + 128 + (l & 63) * 16 + (ch & 15))) = w; }
                        else *(u32x4*)(O + (size_t)row * ldc + 768 + (u.pn - 7) * 256 + bj * HALF + cw) = w; } } }
    }
};
struct S5ESched { int G, c;
    __device__ bool next(int i, Unit& u) const { const int L = i * G + c; if (L >= 32) return false; const int g = L >> 1, mt = L & 1;
        u.arow = g * 512 + mt * 256; u.pn = 0; u.b0 = g * 256 * 1024 * 2; u.b1 = u.b0; u.nt = 16; return true; } };
struct EpiS5E {
    static constexpr bool PERM = true;
    float* E;
    __device__ __forceinline__ void operator()(const f32x4 (&acc)[2][2][4][2], const Unit& u, int wr, int wc, int fr, int fq) const {
        const int g = u.arow >> 9, row0 = (u.arow & 511) + wr * 64 + fr, n0 = wc * 32 + 8 * fq, im = n0 >> 6, p0 = n0 & 63;
#pragma unroll
        for (int ai = 0; ai < 2; ++ai)
#pragma unroll
            for (int m = 0; m < 4; ++m) { const int rg = row0 + ai * HALF + m * 16; float* e = E + (((size_t)rg * 16 + g) * 64 + p0) * 2 + im;
                const f32x4 v0 = acc[ai][0][m][0], v1 = acc[ai][0][m][1];
                e[0] = v0[0]; e[2] = v0[1]; e[4] = v0[2]; e[6] = v0[3]; e[8] = v1[0]; e[10] = v1[1]; e[12] = v1[2]; e[14] = v1[3]; }
    }
};
struct S5Sched { int G, c;
    __device__ bool next(int i, Unit& u) const { const int L = i * G + c; if (L >= 128) return false; const int g = L >> 3, mt = (L >> 2) & 1, pn = L & 3;
        u.arow = g * 512 + mt * 256; u.pn = pn; u.b0 = (g * 1024 + pn * 256) * 1152 * 2; u.b1 = u.b0; u.nt = 2 + 4 * (pn + 1); return true; } };
struct EpiS5 {
    static constexpr bool PERM = true;
    const bf16_t* AG; bf16_t* YB; const float* dvec;
    __device__ __forceinline__ void operator()(const f32x4 (&acc)[2][2][4][2], const Unit& u, int wr, int wc, int fr, int fq) const {
        const int g = u.arow >> 9, row0 = u.arow + wr * 64 + fr, col0 = u.pn * BM + wc * 32 + 8 * fq;
        f32x4 dd[2][2];
#pragma unroll
        for (int bj = 0; bj < 2; ++bj) { const int ho = (col0 + bj * HALF) & 15; dd[bj][0] = *(const f32x4*)(dvec + g * 16 + ho); dd[bj][1] = *(const f32x4*)(dvec + g * 16 + ho + 4); }
#pragma unroll
        for (int ai = 0; ai < 2; ++ai) { u32x4 uw[4][2];
#pragma unroll
            for (int m = 0; m < 4; ++m)
#pragma unroll
                for (int bj = 0; bj < 2; ++bj) uw[m][bj] = *(const u32x4*)(AG + (size_t)(row0 + ai * HALF + m * 16) * 1152 + 128 + col0 + bj * HALF);
#pragma unroll
            for (int m = 0; m < 4; ++m) { const int row = row0 + ai * HALF + m * 16, rg = row & 511;
#pragma unroll
                for (int bj = 0; bj < 2; ++bj) { const int col = col0 + bj * HALF, t = col >> 4, ho = col & 15; const size_t tok = (size_t)(rg >> 8) * SEQ + (size_t)(rg & 255) * 64 + t;
                    const u32x4 w4 = uw[m][bj]; const f32x4 d0 = dd[bj][0], d1 = dd[bj][1], v0 = acc[ai][bj][m][0], v1 = acc[ai][bj][m][1];
                    float y[8]; y[0] = v0[0] + d0[0] * bf_lo(w4.x); y[1] = v0[1] + d0[1] * bf_hi(w4.x); y[2] = v0[2] + d0[2] * bf_lo(w4.y); y[3] = v0[3] + d0[3] * bf_hi(w4.y);
                    y[4] = v1[0] + d1[0] * bf_lo(w4.z); y[5] = v1[1] + d1[1] * bf_hi(w4.z); y[6] = v1[2] + d1[2] * bf_lo(w4.w); y[7] = v1[3] + d1[3] * bf_hi(w4.w);
#pragma unroll
                    for (int j = 0; j < 8; ++j) y[j] = gelu_tanh(y[j]);
                    u32x4 w; w.x = cvt_pk_bf16(y[0], y[1]); w.y = cvt_pk_bf16(y[2], y[3]); w.z = cvt_pk_bf16(y[4], y[5]); w.w = cvt_pk_bf16(y[6], y[7]);
                    *(u32x4*)(YB + tok * 256 + g * 16 + ho) = w; } }
            asm volatile("" ::: "memory"); }
    }
};
struct EpiGLU {
    static constexpr bool PERM = true;
    const bf16_t* YB; bf16_t* O;
    __device__ __forceinline__ void operator()(const f32x4 (&acc)[2][2][4][2], const Unit& u, int wr, int wc, int fr, int fq) const {
        const int row0 = u.arow + wr * 64 + fr, col0 = wc * 32 + 8 * fq;
#pragma unroll
        for (int ai = 0; ai < 2; ++ai) { u32x4 yv[4][2];
#pragma unroll
            for (int m = 0; m < 4; ++m)
#pragma unroll
                for (int bj = 0; bj < 2; ++bj) yv[m][bj] = *(const u32x4*)(YB + (size_t)(row0 + ai * HALF + m * 16) * 256 + col0 + bj * HALF);
#pragma unroll
            for (int m = 0; m < 4; ++m) { const size_t row = (size_t)(row0 + ai * HALF + m * 16);
#pragma unroll
                for (int bj = 0; bj < 2; ++bj) { const int col = col0 + bj * HALF; const u32x4 yw = yv[m][bj]; const f32x4 v0 = acc[ai][bj][m][0], v1 = acc[ai][bj][m][1];
                    u32x4 w; w.x = cvt_pk_bf16(bf_lo(yw.x) * sigmoidf_(v0[0]), bf_hi(yw.x) * sigmoidf_(v0[1])); w.y = cvt_pk_bf16(bf_lo(yw.y) * sigmoidf_(v0[2]), bf_hi(yw.y) * sigmoidf_(v0[3]));
                    w.z = cvt_pk_bf16(bf_lo(yw.z) * sigmoidf_(v1[0]), bf_hi(yw.z) * sigmoidf_(v1[1])); w.w = cvt_pk_bf16(bf_lo(yw.w) * sigmoidf_(v1[2]), bf_hi(yw.w) * sigmoidf_(v1[3]));
                    *(u32x4*)(O + row * DM + col) = w; } }
            asm volatile("" ::: "memory"); }
    }
};
}
constexpr int LDS_BYTES = 160 * 1024;
constexpr int N_PHASES_A = 17;
#ifndef ONLY
#define ONLY -1
#endif
constexpr bool ph_on(int k) { return ONLY < 0 || ONLY == k; }
__global__ void __launch_bounds__(NTHREADS, 2) fwd_kernel(Params prm_) {
    extern __shared__ __attribute__((aligned(16))) unsigned char lds_raw[];
    cg::grid_group grid = cg::this_grid();
    const int ph_lo = prm_.ph_lo, ph_hi = prm_.ph_hi;
    volatile LAS unsigned* bst = (volatile LAS unsigned*)((LAS unsigned char*)lds_raw + LDS_BYTES - 16);
    if (threadIdx.x < 4) bst[threadIdx.x] = 0u;
    __syncthreads();
    XcdBarrier bar = xcd_barrier_post((unsigned*)(prm_.ws + WS_BAR), bst);
    if (ph_hi < 0) grid.sync();
#ifndef PROBE_MASK
#define PROBE_MASK 0u
#endif
    for (int pi = ph_lo; pi < ph_hi; ++pi) {
      const int ph = pi < 3 ? pi : (pi == 3 ? 22 : (pi == 4 ? 23 : (pi <= 6 ? pi - 1 : (pi == 7 ? 7 : (pi == 8 ? 10 : (pi <= 15 ? pi + 3 : 20))))));
      const int nrep = ((PROBE_MASK >> ph) & 1u) ? 2 : 1;
      for (int rep = 0; rep < nrep; ++rep) {
        const __attribute__((address_space(4))) Params* kp = (const __attribute__((address_space(4))) Params*)__builtin_amdgcn_kernarg_segment_ptr();
        asm volatile("" : "+s"(kp));
        const Params& prm = *(const Params*)kp;
        int tid_ = threadIdx.x, bid_ = blockIdx.x, G_ = gridDim.x; asm volatile("" : "+v"(tid_)); asm volatile("" : "+s"(bid_), "+s"(G_));
        Ctx C; C.lds = (LAS unsigned char*)lds_raw; C.tid = tid_; C.lane = tid_ & 63; C.wave = __builtin_amdgcn_readfirstlane(tid_ >> 6); C.G = G_; C.bid = bid_;
        unsigned char* ws = prm.ws;
        switch (ph) {
        case 0: if constexpr (ph_on(0)) { phase_prep(C, prm); } break;
        case 1: if constexpr (ph_on(1)) { pg8::Gemm g{(const bf16_t*)(ws + WS_XN), (const char*)(ws + WS_WIN0T), DM, DM, DM, 1 << 30, nullptr}; pg8::DenseSched S; S.init(T, IN_EVEN, C.G, C.bid, DM, DM);
                  s5_mtable_items(C, prm); s5_sg_items(C, prm);
                  pg8::EpiProj0 E{(bf16_t*)(ws + WS_PROJ), 1536, (bf16_t*)(ws + S5_AG), (const float*)(ws + WS_R0)}; pg8::gemm_phase<pg8::EpiProj0, pg8::DenseSched, false>(C.lds, g, S, E); } break;
        case 2: if constexpr (ph_on(2)) {
                  if (C.G > 64 && C.bid < 32) { pg8::Gemm g{(const bf16_t*)(ws + S5_AG) + 128, (const char*)(ws + S5_SG), 1152, 1024, 1024, 1 << 30, nullptr}; pg8::S5ESched S{32, C.bid};
                      pg8::EpiS5E E{(float*)(ws + WS_S5E)}; pg8::gemm_phase<pg8::EpiS5E, pg8::S5ESched, false>(C.lds, g, S, E);
                      asm volatile("s_waitcnt vmcnt(0)" ::: "memory"); __syncthreads(); if (C.wave == 0) { __builtin_amdgcn_fence(__ATOMIC_ACQUIRE, "agent"); s5_chunkscan_wave(C, prm, C.bid & 1, C.bid >> 1); } }
                  else if (C.G > 64) { phase_s5a_conv(C, prm, C.bid - 32, C.G - 32); s5_bg_items(C, prm, C.bid - 32, C.G - 32); }
                  else { pg8::Gemm g{(const bf16_t*)(ws + S5_AG) + 128, (const char*)(ws + S5_SG), 1152, 1024, 1024, 1 << 30, nullptr}; pg8::S5ESched S{C.G, C.bid};
                      pg8::EpiS5E E{(float*)(ws + WS_S5E)}; pg8::gemm_phase<pg8::EpiS5E, pg8::S5ESched, false>(C.lds, g, S, E); __syncthreads(); phase_s5a_conv(C, prm, C.bid, C.G); s5_bg_items(C, prm, C.bid, C.G); } } break;
        case 3: if constexpr (ph_on(3)) { if (C.G <= 64) { const int gw = C.bid * NWAVES + C.wave; if (gw < NB * 16) s5_chunkscan_wave(C, prm, gw >> 4, gw & 15); } } break;
        case 22: if constexpr (ph_on(22)) { pg8::Gemm g{(const bf16_t*)(ws + S5_AG), (const char*)(ws + S5_BG), 1152, 1152, 1152, 1 << 30, nullptr}; pg8::S5Sched S{C.G, C.bid};
                  pg8::EpiS5 E{(const bf16_t*)(ws + S5_AG), (bf16_t*)(ws + S5_YB), prm.in[I_S5D]}; pg8::gemm_phase<pg8::EpiS5, pg8::S5Sched, false>(C.lds, g, S, E);
                  if (C.G > 128) { if (C.bid >= 128) late_weight_items(C, prm, C.bid - 128, C.G - 128); } else { __syncthreads(); late_weight_items(C, prm, C.bid, C.G); } } break;
        case 23: if constexpr (ph_on(23)) { pg8::Gemm g{(const bf16_t*)(ws + S5_YB), (const char*)(ws + S5_GLUT), 256, 256, 256, 1 << 30, nullptr}; pg8::DenseSched S; S.init(T, 256, C.G, C.bid, 256, 256);
                  pg8::EpiGLU E{(const bf16_t*)(ws + S5_YB), (bf16_t*)(ws + WS_A2)}; pg8::gemm_phase<pg8::EpiGLU, pg8::DenseSched, false>(C.lds, g, S, E); } break;
        case 4: if constexpr (ph_on(4)) { pg8::Gemm g{(const bf16_t*)(ws + WS_A2), (const char*)(ws + WS_WOUT0T), DM, DM, DM, 1 << 30, nullptr}; pg8::DenseSched S; S.init(T, DM, C.G, C.bid, DM, DM);
                  pg8::EpiResidualB<false> E{nullptr, (bf16_t*)(ws + WS_XN), (float*)(ws + WS_SS)}; pg8::gemm_phase<pg8::EpiResidualB<false>, pg8::DenseSched, false>(C.lds, g, S, E); } break;
#define MOE_PHASES(P0, LAYER) \
        case P0: if constexpr (ph_on(P0)) { phase_moe_route(C, prm, LAYER); } break; \
        case P0 + 1: break;     \
        case P0 + 2: if constexpr (ph_on(P0 + 2)) { LAS int* tabl = (LAS int*)(C.lds + 131072); moe_load_tab((const unsigned*)(ws + WS_CTL) + CW_MOECNT + LAYER * 32, tabl, C.tid); __syncthreads(); \
                    \
                  { int* rt2 = (int*)(ws + WS_RT2); for (int i = C.tid; i < 24 * 256; i += NTHREADS) { const int bk = i >> 8, cn = tabl[40 + bk], pos = cn + (i & 255); if (pos < ((cn + 255) & ~255)) rt2[(size_t)bk * T + pos] = -1; } } \
                  __syncthreads(); \
                  unsigned* rdy = (unsigned*)(ws + WS_CTL) + CW_MOERDY + LAYER * 256; unsigned* qctr = (unsigned*)(ws + WS_CTL) + CW_MOEQ + LAYER; LAS int* tk = tabl + 32; \
                  { pg8::Gemm g{(const bf16_t*)(ws + WS_XN), (const char*)(ws + WS_MW1T) + (size_t)LAYER * 16 * 512 * 1024 * 2, DM, DM, DM, 1 << 30, (const int*)(ws + WS_RT2)}; \
                    pg8::MoeSched S{tabl, C.G, C.bid, 0, rdy, qctr, tk}; \
                    pg8::EpiSwiGLU E{(bf16_t*)(ws + WS_PROJ), (const f32x4*)(ws + WS_WR2)}; pg8::gemm_phase<pg8::EpiSwiGLU, pg8::MoeSched, true, true>(C.lds, g, S, E); } \
                  __syncthreads(); \
                    \
                  { pg8::Gemm g{(const bf16_t*)(ws + WS_PROJ), (const char*)(ws + WS_MWDT) + (size_t)LAYER * 16 * 1024 * 256 * 2, 512, 256, 512, 4, nullptr}; \
                    pg8::MoeSched S{tabl, C.G, C.bid, 1, rdy, qctr, tk}; \
                    pg8::EpiScatterResB<(LAYER == 1)> E{prm.out, (bf16_t*)(ws + WS_XN), (float*)(ws + WS_SS), (const int*)(ws + WS_RT2)}; pg8::gemm_phase<pg8::EpiScatterResB<(LAYER == 1)>, pg8::MoeSched, false, true>(C.lds, g, S, E); } \
                  if (LAYER == 0) {   \
                      __syncthreads(); LAS float* scr = (LAS float*)(C.lds + C.wave * 16384); const int nun = tabl[24] * 4; \
                      for (int s = __builtin_amdgcn_readfirstlane(tk[1]);;) { const int cg = s - 2 * nun; if (cg >= 768) break; \
                          const int it = cg * NWAVES + C.wave; moe_weight_item(prm, ws, 16 + it / 384, it % 384, scr, C.lane); \
                          __syncthreads(); if (C.tid == 0) tk[0] = (int)atomicAdd(qctr, 1u); __syncthreads(); s = __builtin_amdgcn_readfirstlane(tk[0]); } } } break; \
        case P0 + 3: break;
        MOE_PHASES(5, 0)
        case 9: break;
        case 10: if constexpr (ph_on(10)) { pg8::Gemm g{(const bf16_t*)(ws + WS_XN), (const char*)(ws + WS_WIN1T), DM, DM, DM, 1 << 30, nullptr};
                  LAS float* rl = (LAS float*)(C.lds + 131072 + 16384);
                  pg8::RowScaleSched S; S.init(T, IN_ODD_P, C.G, C.bid, DM, DM); S.SS = (const float*)(ws + WS_SS); S.rl = rl;
                  pg8::EpiOdd E{(bf16_t*)(ws + WS_PROJ), IN_ODD_P, rl, (LAS float*)(C.lds + 131072 + 20480), ws, (unsigned char*)prm.out, prm.in[I_MQN], prm.in[I_MKN], prm.in[I_NQN], prm.in[I_NKSN], prm.in[I_NKWN]};
                  pg8::gemm_phase<pg8::EpiOdd, pg8::RowScaleSched, false, true>(C.lds, g, S, E); } break;
        case 12: if constexpr (ph_on(12)) { kmmean_items(C, prm);
                  if (C.G > 64 && C.bid >= 64) phase_post1(C, prm, C.bid - 64, C.G - 64);
                  else { pg8::Gemm g{(const bf16_t*)(ws + AT_KC), (const char*)(ws + WS_C1T), 1024, 1024, 1024, 1 << 30, nullptr}; pg8::C1Sched S{C.G, C.bid};
                      pg8::EpiBf16Plain E{(bf16_t*)(ws + AT_HC), 512}; pg8::gemm_phase<pg8::EpiBf16Plain, pg8::C1Sched, false>(C.lds, g, S, E);
                      if (C.G <= 64) { __syncthreads(); phase_post1(C, prm, C.bid, C.G); } } } break;
        case 13: if constexpr (ph_on(13)) { phase_c2(C, prm); moba_gate_items(C, prm); } break;
        case 14: if constexpr (ph_on(14)) { phase_nsa_cmp(C, prm); } break;
        case 15: if constexpr (ph_on(15)) {
#ifdef REP_NSAG
                  phase_nsa_gather(C, prm); __syncthreads();
#endif
#ifdef REP_MOBAG
                  phase_moba_gather(C, prm); __syncthreads();
#endif
                  phase_nsa_gather(C, prm); __syncthreads(); phase_moba_gather(C, prm); } break;
        case 16: if constexpr (ph_on(16)) {
#ifdef REP_MOBAD
                  phase_moba_dense(C, prm); __syncthreads();
#endif
                  phase_nsa_dense(C, prm); __syncthreads(); phase_moba_dense(C, prm); } break;
        case 17: if constexpr (ph_on(17)) { pg8::Gemm g{(const bf16_t*)(ws + WS_A2), (const char*)(ws + WS_WOUT1T), DM, DM, DM, 1 << 30, nullptr}; pg8::DenseSched S; S.init(T, DM, C.G, C.bid, DM, DM);
                  pg8::EpiResidualB<false> E{nullptr, (bf16_t*)(ws + WS_XN), (float*)(ws + WS_SS)}; pg8::gemm_phase<pg8::EpiResidualB<false>, pg8::DenseSched, false>(C.lds, g, S, E); } break;
        MOE_PHASES(18, 1)
        default: break;
        }
        if (pi + 1 < ph_hi || rep + 1 < nrep) xcd_barrier(bar);
      }
    }
}

extern "C" void kernel_launch(void* const* d_in, const int* in_sizes, int n_in, void* d_out, int out_size, void* d_ws, size_t ws_size, hipStream_t stream) {
    static int grid_blocks = 0;
    if (!grid_blocks) {
        int dev = 0, cus = 0, per_cu = 0;
        (void)hipGetDevice(&dev);
        (void)hipDeviceGetAttribute(&cus, hipDeviceAttributeMultiprocessorCount, dev);
        (void)hipFuncSetAttribute((const void*)fwd_kernel, hipFuncAttributeMaxDynamicSharedMemorySize, LDS_BYTES);
        (void)hipOccupancyMaxActiveBlocksPerMultiprocessor(&per_cu, fwd_kernel, NTHREADS, LDS_BYTES);
        if (per_cu < 1) fprintf(stderr, "occupancy query says %d blocks/CU\n", per_cu);
        grid_blocks = cus;
        fprintf(stderr, "cus=%d per_cu=%d grid=%d ws=%zu need=%zu\n", cus, per_cu, grid_blocks, ws_size, (size_t)WS_TOTAL);
    }
    (void)hipMemsetAsync((char*)d_ws + WS_BAR, 0, XCD_BAR_WORDS * 4, stream);
    Params p{};
    for (int i = 0; i < 38; ++i) p.in[i] = (const float*)d_in[i];
    p.out = (float*)d_out; p.ws = (unsigned char*)d_ws; p.ph_lo = 0; p.ph_hi = N_PHASES_A;
    void* args[] = {&p};
    hipError_t e = hipLaunchCooperativeKernel((void*)fwd_kernel, dim3(grid_blocks), dim3(NTHREADS), args, LDS_BYTES, stream);
    if (e != hipSuccess) fprintf(stderr, "cooperative launch failed: %s (grid %d)\n", hipGetErrorString(e), grid_blocks);
}
```
